# Optimizing an MI355X kernel written in HIP

```python
import math
import numpy as np
import jax
import jax.numpy as jnp
from jax import lax

D_MODEL = 1024
BATCH = 4
SEQ = 8192
DEPTH = 2

GRID_W = 64
CTX_LEN = 256
N_EVEN = (DEPTH + 1) // 2
N_ODD = DEPTH // 2
EPS = 1e-6
CHUNK = 64

HG_HEADS = 4
HG_DK = 128
HG_DV = 128
HG_WIDTH = HG_HEADS * HG_DV
HG_COLS = 5 * HG_WIDTH

RW_HEADS = 8
RW_DH = 64
RW_WIDTH = RW_HEADS * RW_DH
RW_DECAY_LORA = 64
RW_AAA_LORA = 64
RW_GATE_LORA = 128
RW_GN_EPS = 64e-5
RW_SPLITS = (RW_WIDTH, RW_WIDTH, RW_WIDTH, RW_DECAY_LORA, RW_DECAY_LORA, RW_AAA_LORA, RW_AAA_LORA, RW_GATE_LORA)
RW_COLS = sum(RW_SPLITS)
EVEN_COLS = HG_COLS + RW_COLS

GLA_HEADS = 4
GLA_DK = 64
GLA_DV = 128
GLA_WIDTH = GLA_HEADS * GLA_DV
GLA_GATE_LORA = 16
GLA_TAU = 16.0

S5_WIDTH = 512
S5_GROUP = 16
S5_GROUPS = S5_WIDTH // S5_GROUP
S5_STATE = 64
ODD_SPLITS = (GLA_HEADS * GLA_DK, GLA_HEADS * GLA_DK, GLA_WIDTH, GLA_WIDTH, GLA_GATE_LORA, GLA_GATE_LORA, S5_WIDTH)
ODD_COLS = sum(ODD_SPLITS)

D_FF = 2816

kernel_name = 'hybrid_hgrn2_rwkv7_gla_s5_prefix_dit'


def split_cols(p, sizes):
    idx = [int(i) for i in np.cumsum(sizes)[:-1]]
    return jnp.split(p, idx, axis=-1)


def heads(z, n):
    return z.reshape(z.shape[:-1] + (n, z.shape[-1] // n))


def rms_norm(z, g):
    z32 = z.astype(jnp.float32)
    return z32 * lax.rsqrt(jnp.mean(z32 * z32, axis=-1, keepdims=True) + EPS) * g.astype(jnp.float32)


def stack_dirs(fwd, bwd):
    return jnp.concatenate([fwd, jnp.flip(bwd, axis=1)], axis=0)


def merge_dirs(o):
    n = o.shape[0] // 2
    return o[:n] + jnp.flip(o[n:], axis=1)


def centred_shift(p, mu):
    prev = jnp.pad(p[:, :-1], ((0, 0), (1, 0), (0, 0)))
    nxt = jnp.pad(p[:, 1:], ((0, 0), (0, 1), (0, 0)))
    return p + mu[0] * (prev - p) + mu[1] * (nxt - p)


def chunk_gated_linear_scan(q, k, v, log_f, s0):
    n, t, h, _ = q.shape
    dv = v.shape[-1]
    nc = t // CHUNK

    def to_chunks(z):
        return jnp.moveaxis(z.reshape(n, nc, CHUNK, h, z.shape[-1]), 1, 0)

    mask = jnp.tril(jnp.ones((CHUNK, CHUNK), dtype=bool))[None, :, :, None, None]

    def step(s, inp):
        qc, kc, vc, gc = inp
        b = jnp.cumsum(gc, axis=1)
        decay = jnp.exp(jnp.where(mask, b[:, :, None] - b[:, None, :], -jnp.inf))
        att = jnp.einsum('ntshk,nshk->nths', qc[:, :, None] * decay, kc)
        o = jnp.einsum('nths,nshv->nthv', att, vc) + jnp.einsum('nthk,nhkv->nthv', qc * jnp.exp(b), s)
        b_last = b[:, -1]
        s_new = jnp.exp(b_last)[..., None] * s + jnp.einsum(
            'nshk,nshv->nhkv', kc * jnp.exp(b_last[:, None] - b), vc)
        return s_new, o

    s_fin, o = lax.scan(step, s0, (to_chunks(q), to_chunks(k), to_chunks(v), to_chunks(log_f)))
    return jnp.moveaxis(o, 0, 1).reshape(n, t, h, dv), s_fin


def rwkv7_scan(r, w, k, v, a, b, s0):
    def step(s, inp):
        r_t, w_t, k_t, v_t, a_t, b_t = inp
        sa = jnp.einsum('nhvk,nhk->nhv', s, a_t)
        s = s * w_t[:, :, None, :] + sa[..., None] * b_t[:, :, None, :] + v_t[..., None] * k_t[:, :, None, :]
        return s, jnp.einsum('nhvk,nhk->nhv', s, r_t)

    xs = tuple(jnp.swapaxes(z, 0, 1) for z in (r, w, k, v, a, b))
    s_fin, o = lax.scan(step, s0, xs)
    return jnp.swapaxes(o, 0, 1), s_fin


def _ssm_combine(e1, e2):
    a1, b1 = e1
    a2, b2 = e2
    return a1 * a2, a2 * b1 + b2


def s5_scan(u, a_re, a_im, log_dt, b_re, b_im, h0, reverse):
    f32 = jnp.float32
    lam = lax.complex(a_re.astype(f32), a_im.astype(f32))
    lam_bar = jnp.exp(lam * jnp.exp(log_dt.astype(f32))[:, None])
    b_bar = ((lam_bar - 1.0) / lam)[..., None] * lax.complex(b_re.astype(f32), b_im.astype(f32))
    bu = lax.complex(jnp.einsum('gnc,btgc->btgn', b_bar.real, u), jnp.einsum('gnc,btgc->btgn', b_bar.imag, u))
    first, last = (-1, 0) if reverse else (0, -1)
    bu = bu.at[:, first].add(lam_bar * h0)
    _, hs = lax.associative_scan(_ssm_combine, (jnp.broadcast_to(lam_bar, bu.shape), bu), reverse=reverse, axis=1)
    return hs, hs[:, last]


def s5_readout(hs, c_re, c_im):
    f32 = jnp.float32
    return jnp.einsum('gcn,btgn->btgc', c_re.astype(f32), hs.real) - jnp.einsum('gcn,btgn->btgc', c_im.astype(f32), hs.imag)


def even_mix(h, s0, prm, with_out):
    (w_in, w_out, lb, hg_g, mu, w0, w2, a0, a2, g2, k_k, k_a, r_k, ln_g, ln_b) = prm
    f32 = jnp.float32
    bsz, t, _ = h.shape
    p = (h @ w_in).astype(f32)
    q, i, f_fw, f_bw, g = jnp.split(p[..., :HG_COLS], 5, axis=-1)
    r, k, v, wd_fw, wd_bw, ad_fw, ad_bw, gd = split_cols(centred_shift(p[..., HG_COLS:], mu.astype(f32)), RW_SPLITS)
    s_hg0, s_rw0 = s0

    lb = lb.astype(f32)
    f_st = stack_dirs(lb[0] + (1.0 - lb[0]) * jax.nn.sigmoid(f_fw), lb[1] + (1.0 - lb[1]) * jax.nn.sigmoid(f_bw))
    q_hg = jax.nn.silu(q) * HG_DK ** -0.5
    hg_o, s_hg = chunk_gated_linear_scan(
        heads(stack_dirs(q_hg, q_hg), HG_HEADS), heads(1.0 - f_st, HG_HEADS),
        heads(stack_dirs(i, i), HG_HEADS), heads(jnp.log(f_st), HG_HEADS), s_hg0)

    kk = heads(k * k_k, RW_HEADS)
    kk = kk / jnp.maximum(jnp.sqrt(jnp.sum(kk * kk, axis=-1, keepdims=True)), 1e-12)
    k_h = heads(k, RW_HEADS)
    decay, k_dir, kka = [], [], []
    for d, (wd, ad) in enumerate(((wd_fw, ad_fw), (wd_bw, ad_bw))):
        w_log = -jax.nn.softplus(-(w0[d] + jnp.tanh(wd) @ w2[d])) - 0.5
        a = heads(jax.nn.sigmoid(a0[d] + ad @ a2[d]), RW_HEADS)
        decay.append(heads(jnp.exp(-jnp.exp(w_log)), RW_HEADS))
        k_dir.append(k_h * (1.0 + (a - 1.0) * heads(k_a, RW_HEADS)))
        kka.append(kk * a)
    r_h, v_h = heads(r, RW_HEADS), heads(v, RW_HEADS)
    rw_o, s_rw = rwkv7_scan(stack_dirs(r_h, r_h), stack_dirs(decay[0], decay[1]), stack_dirs(k_dir[0], k_dir[1]),
                            stack_dirs(v_h, v_h), stack_dirs(-kk, -kk), stack_dirs(kka[0], kka[1]), s_rw0)
    states = (s_hg, s_rw)
    if not with_out:
        return None, states

    o_hg = rms_norm(merge_dirs(hg_o), hg_g) * jax.nn.silu(heads(g, HG_HEADS))
    o_rw = merge_dirs(rw_o)
    mean = jnp.mean(o_rw, axis=-1, keepdims=True)
    var = jnp.mean(jnp.square(o_rw - mean), axis=-1, keepdims=True)
    o_rw = (o_rw - mean) * lax.rsqrt(var + RW_GN_EPS) * heads(ln_g, RW_HEADS) + heads(ln_b, RW_HEADS)
    bonus = jnp.sum(r_h * (k_dir[0] + k_dir[1]) * r_k, axis=-1, keepdims=True) * v_h
    o_rw = (o_rw + bonus).reshape(bsz, t, RW_WIDTH) * (jax.nn.sigmoid(gd) @ g2)
    mixed = jnp.concatenate([o_hg.reshape(bsz, t, HG_WIDTH), o_rw], axis=-1).astype(h.dtype)
    return mixed @ w_out, states


def odd_mix(h, s0, prm, with_out):
    (w_in, w_out, gla_w2, gla_b, gla_g, a_re, a_im, log_dt, b_re, b_im, c_re, c_im, d_skip, w_glu, b_glu) = prm
    f32 = jnp.float32
    bsz, t, _ = h.shape
    p = (h @ w_in).astype(f32)
    q, k, v, g, gd_fw, gd_bw, u = split_cols(p, ODD_SPLITS)
    s_gla0, s_s50 = s0

    log_a = [jax.nn.log_sigmoid(gd @ gla_w2[d] + gla_b[d]) / GLA_TAU for d, gd in enumerate((gd_fw, gd_bw))]
    q_s = q * GLA_DK ** -0.5
    gla_o, s_gla = chunk_gated_linear_scan(
        heads(stack_dirs(q_s, q_s), GLA_HEADS), heads(stack_dirs(k, k), GLA_HEADS),
        heads(stack_dirs(v, v), GLA_HEADS), heads(stack_dirs(log_a[0], log_a[1]), GLA_HEADS), s_gla0)

    u_g = heads(u, S5_GROUPS)
    s5_fin, readouts = [], []
    for d in range(2):
        hs, h_fin = s5_scan(u_g, a_re[d], a_im[d], log_dt[d], b_re[d], b_im[d], s_s50[d], reverse=(d == 1))
        s5_fin.append(h_fin)
        if with_out:
            readouts.append(s5_readout(hs, c_re[d], c_im[d]))
    states = (s_gla, (s5_fin[0], s5_fin[1]))
    if not with_out:
        return None, states

    o_gla = rms_norm(merge_dirs(gla_o), gla_g) * jax.nn.silu(heads(g, GLA_HEADS))
    y = (readouts[0] + readouts[1]).reshape(bsz, t, S5_WIDTH) + d_skip * u
    z = jax.nn.gelu(y)
    o_s5 = z * jax.nn.sigmoid(z @ w_glu + b_glu)
    mixed = jnp.concatenate([o_gla.reshape(bsz, t, GLA_WIDTH), o_s5], axis=-1).astype(h.dtype)
    return mixed @ w_out, states


def conv_ffn(h, w_up, conv_w, conv_b, w_down, rows, cols):
    bsz, t, _ = h.shape
    gate, val = jnp.split(h @ w_up, 2, axis=-1)
    grid = jnp.pad(gate.reshape(bsz, rows, cols, D_FF), ((0, 0), (1, 1), (1, 1), (0, 0)))
    conv = conv_b + sum(grid[:, di:di + rows, dj:dj + cols] * conv_w[di, dj] for di in range(3) for dj in range(3))
    return (jax.nn.silu(conv) * val.reshape(bsz, rows, cols, D_FF)).reshape(bsz, t, D_FF) @ w_down


def setup_inputs(seed: int = 0) -> dict:
    key = jax.random.key(seed)
    keys = iter(jax.random.split(key, 48))
    f32 = jnp.float32

    def nrm(shape, scale):
        return scale * jax.random.normal(next(keys), shape, f32)

    def unif(shape, lo, hi):
        return jax.random.uniform(next(keys), shape, f32, lo, hi)

    d = D_MODEL
    return {
        'x': nrm((BATCH, SEQ, d), 1.0),
        'c': nrm((BATCH, d), 1.0),
        'ctx': nrm((BATCH, CTX_LEN, d), 1.0),
        'c_ctx': nrm((d,), 1.0),
        'ada_w': nrm((DEPTH, d, 6 * d), 0.5 * d ** -0.5),
        'ada_b': nrm((DEPTH, 6 * d), 0.02),
        'norm1_g': 1.0 + nrm((DEPTH, d), 0.02),
        'norm2_g': 1.0 + nrm((DEPTH, d), 0.02),
        'final_g': 1.0 + nrm((d,), 0.02),
        'ev_w_in': nrm((N_EVEN, d, EVEN_COLS), d ** -0.5),
        'ev_w_out': nrm((N_EVEN, HG_WIDTH + RW_WIDTH, d), (HG_WIDTH + RW_WIDTH) ** -0.5),
        'hg_lb': nrm((N_EVEN + 1, 2, HG_HEADS * HG_DK), 0.5),
        'hg_norm_g': 1.0 + nrm((N_EVEN, HG_DV), 0.02),
        'rw_mu': unif((N_EVEN, 2, RW_COLS), 0.0, 0.5),
        'rw_w0': jnp.linspace(-6.5, -1.5, RW_WIDTH, dtype=f32) + nrm((N_EVEN, 2, RW_WIDTH), 0.1),
        'rw_w2': nrm((N_EVEN, 2, RW_DECAY_LORA, RW_WIDTH), 0.5 * RW_DECAY_LORA ** -0.5),
        'rw_a0': nrm((N_EVEN, 2, RW_WIDTH), 0.1),
        'rw_a2': nrm((N_EVEN, 2, RW_AAA_LORA, RW_WIDTH), 0.5 * RW_AAA_LORA ** -0.5),
        'rw_g2': nrm((N_EVEN, RW_GATE_LORA, RW_WIDTH), RW_GATE_LORA ** -0.5),
        'rw_k_k': 0.85 + nrm((N_EVEN, RW_WIDTH), 0.02),
        'rw_k_a': 1.0 + nrm((N_EVEN, RW_WIDTH), 0.02),
        'rw_r_k': nrm((N_EVEN, RW_HEADS, RW_DH), 0.1),
        'rw_ln_g': 1.0 + nrm((N_EVEN, RW_WIDTH), 0.02),
        'rw_ln_b': nrm((N_EVEN, RW_WIDTH), 0.02),
        'od_w_in': nrm((N_ODD, d, ODD_COLS), d ** -0.5),
        'od_w_out': nrm((N_ODD, GLA_WIDTH + S5_WIDTH, d), (GLA_WIDTH + S5_WIDTH) ** -0.5),
        'gla_w2': nrm((N_ODD, 2, GLA_GATE_LORA, GLA_HEADS * GLA_DK), GLA_GATE_LORA ** -0.5),
        'gla_b': nrm((N_ODD, 2, GLA_HEADS * GLA_DK), 0.5),
        'gla_norm_g': 1.0 + nrm((N_ODD, GLA_DV), 0.02),
        's5_a_re': -0.5 + nrm((N_ODD, 2, S5_GROUPS, S5_STATE), 0.01),
        's5_a_im': math.pi * jnp.arange(S5_STATE, dtype=f32) + nrm((N_ODD, 2, S5_GROUPS, S5_STATE), 0.01),
        's5_log_dt': unif((N_ODD, 2, S5_GROUPS), math.log(1e-3), math.log(1e-1)),
        's5_b_re': nrm((N_ODD, 2, S5_GROUPS, S5_STATE, S5_GROUP), (2 * S5_GROUP) ** -0.5),
        's5_b_im': nrm((N_ODD, 2, S5_GROUPS, S5_STATE, S5_GROUP), (2 * S5_GROUP) ** -0.5),
        's5_c_re': nrm((N_ODD, 2, S5_GROUPS, S5_GROUP, S5_STATE), S5_STATE ** -0.5),
        's5_c_im': nrm((N_ODD, 2, S5_GROUPS, S5_GROUP, S5_STATE), S5_STATE ** -0.5),
        's5_d': nrm((N_ODD, S5_WIDTH), 1.0),
        's5_w_glu': nrm((N_ODD, S5_WIDTH, S5_WIDTH), S5_WIDTH ** -0.5),
        's5_b_glu': nrm((N_ODD, S5_WIDTH), 0.02),
        'ffn_w_up': nrm((DEPTH, d, 2 * D_FF), d ** -0.5),
        'ffn_conv_w': nrm((DEPTH, 3, 3, D_FF), 1.0 / 3.0),
        'ffn_conv_b': nrm((DEPTH, D_FF), 0.02),
        'ffn_w_down': nrm((DEPTH, D_FF, d), D_FF ** -0.5),
    }


def reference(x, c, ctx, c_ctx, ada_w, ada_b, norm1_g, norm2_g, final_g,
              ev_w_in, ev_w_out, hg_lb, hg_norm_g, rw_mu, rw_w0, rw_w2, rw_a0, rw_a2, rw_g2,
              rw_k_k, rw_k_a, rw_r_k, rw_ln_g, rw_ln_b,
              od_w_in, od_w_out, gla_w2, gla_b, gla_norm_g, s5_a_re, s5_a_im, s5_log_dt,
              s5_b_re, s5_b_im, s5_c_re, s5_c_im, s5_d, s5_w_glu, s5_b_glu,
              ffn_w_up, ffn_conv_w, ffn_conv_b, ffn_w_down):
    f32 = jnp.float32
    bsz, seq, _ = x.shape
    rows = seq // GRID_W
    ctx_len = ctx.shape[1]
    lb_all = jnp.cumsum(jax.nn.softmax(hg_lb.astype(f32), axis=0), axis=0)

    for layer in range(DEPTH):
        last = layer == DEPTH - 1
        j = layer // 2
        mod = jnp.split(jax.nn.silu(c) @ ada_w[layer] + ada_b[layer], 6, axis=-1)
        mod_c = jnp.split(jax.nn.silu(c_ctx) @ ada_w[layer] + ada_b[layer], 6, axis=-1)
        sh1, sc1, g1, sh2, sc2, g2 = [m[:, None] for m in mod]
        csh1, csc1, cg1, csh2, csc2, cg2 = mod_c
        hx = (rms_norm(x, norm1_g[layer]) * (1.0 + sc1) + sh1).astype(x.dtype)
        hc = (rms_norm(ctx, norm1_g[layer]) * (1.0 + csc1) + csh1).astype(ctx.dtype)

        if layer % 2 == 0:
            prm = (ev_w_in[j], ev_w_out[j], lb_all[j], hg_norm_g[j], rw_mu[j], rw_w0[j], rw_w2[j], rw_a0[j],
                   rw_a2[j], rw_g2[j], rw_k_k[j], rw_k_a[j], rw_r_k[j], rw_ln_g[j], rw_ln_b[j])
            zero = (jnp.zeros((2 * bsz, HG_HEADS, HG_DK, HG_DV), f32),
                    jnp.zeros((2 * bsz, RW_HEADS, RW_DH, RW_DH), f32))
            ctx_mix, ctx_state = even_mix(hc, zero, prm, not last)
            x_mix, _ = even_mix(hx, ctx_state, prm, True)
        else:
            prm = (od_w_in[j], od_w_out[j], gla_w2[j], gla_b[j], gla_norm_g[j], s5_a_re[j], s5_a_im[j],
                   s5_log_dt[j], s5_b_re[j], s5_b_im[j], s5_c_re[j], s5_c_im[j], s5_d[j], s5_w_glu[j], s5_b_glu[j])
            zc = jnp.zeros((bsz, S5_GROUPS, S5_STATE), jnp.complex64)
            zero = (jnp.zeros((2 * bsz, GLA_HEADS, GLA_DK, GLA_DV), f32), (zc, zc))
            ctx_mix, ctx_state = odd_mix(hc, zero, prm, not last)
            x_mix, _ = odd_mix(hx, ctx_state, prm, True)

        x = x + g1 * x_mix
        hx2 = (rms_norm(x, norm2_g[layer]) * (1.0 + sc2) + sh2).astype(x.dtype)
        x = x + g2 * conv_ffn(hx2, ffn_w_up[layer], ffn_conv_w[layer], ffn_conv_b[layer], ffn_w_down[layer], rows, GRID_W)
        if not last:
            ctx = ctx + cg1 * ctx_mix
            hc2 = (rms_norm(ctx, norm2_g[layer]) * (1.0 + csc2) + csh2).astype(ctx.dtype)
            ctx = ctx + cg2 * conv_ffn(hc2, ffn_w_up[layer], ffn_conv_w[layer], ffn_conv_b[layer], ffn_w_down[layer], 1, ctx_len)

    return rms_norm(x, final_g).astype(x.dtype)
```

```cpp
#include <hip/hip_runtime.h>
#include <hip/hip_cooperative_groups.h>
#include <cstdio>
#include <cstdint>
namespace cg = cooperative_groups;

#ifndef MK_PER_PHASE
#define MK_PER_PHASE 0
#ifndef GLA2
#define GLA2 1
#endif
#ifndef RWLC
#define RWLC 1
#endif
#ifndef GLLC
#define GLLC (!RWLC)
#endif
#ifndef RWPF
#define RWPF 1
#endif
#endif

#ifndef REPM
#define REPM 0u
#endif
#ifndef CHK
#define CHK 0x6Fu
#endif
#ifndef RWSER
#define RWSER 0
#endif
#ifndef DETCHK
#define DETCHK 0
#endif
#ifndef SCRUB
#define SCRUB 0
#endif
#ifndef RWZERO
#define RWZERO 0
#endif
#ifndef USE_CG_SYNC
#define USE_CG_SYNC 0
#endif
#ifndef RWMODE
#define RWMODE 3
#endif
#ifndef REPL
#define REPL 3u
#endif
#ifndef XSYNC
#define XSYNC 0
#endif
#ifndef DBGM
#define DBGM 0
#endif
#ifndef PHM
#define PHM 0xFFFFu
#endif
#define LAS __attribute__((address_space(3)))
typedef _Float16 h16;
typedef _Float16 h16x8 __attribute__((ext_vector_type(8)));
typedef _Float16 h16x4 __attribute__((ext_vector_type(4)));
typedef _Float16 h16x2 __attribute__((ext_vector_type(2)));
typedef float f32x4 __attribute__((ext_vector_type(4)));
typedef float f32x2 __attribute__((ext_vector_type(2)));
typedef unsigned u32x4 __attribute__((ext_vector_type(4)));
typedef unsigned u32x2 __attribute__((ext_vector_type(2)));

constexpr int NB = 4, SEQ = 8192, CTXL = 256, DM = 1024, TT = SEQ + CTXL, MU = NB * TT;
constexpr int EVC = 4480, P0LD = 4608, ODC = 2080, P1LD = 2304, DFF = 2816, GVLD = 2 * DFF;
constexpr int NSC = 16, SCL = TT / NSC;
constexpr int NWAVES = 8, NTHR = 512;
static_assert(SCL * NSC == TT && SCL % 8 == 0 && CTXL % 8 == 0, "scan tiling");

enum { I_X = 0, I_C, I_CTX, I_CCTX, I_ADAW, I_ADAB, I_N1G, I_N2G, I_FING, I_EVWIN, I_EVWOUT, I_HGLB, I_HGNG, I_RWMU, I_RWW0, I_RWW2, I_RWA0, I_RWA2,
       I_RWG2, I_RWKK, I_RWKA, I_RWRK, I_RWLNG, I_RWLNB, I_ODWIN, I_ODWOUT, I_GLAW2, I_GLAB, I_GLANG, I_S5ARE, I_S5AIM, I_S5LDT, I_S5BRE, I_S5BIM,
       I_S5CRE, I_S5CIM, I_S5D, I_S5WGLU, I_S5BGLU, I_FFNUP, I_FFNCW, I_FFNCB, I_FFNDN, N_IN };

constexpr size_t MiB = 1u << 20;
constexpr size_t WS_CTL = 0, WS_TAB = 4096, WS_XBAR = 65536, WS_MOD = 1 * MiB, WS_S5P = 2 * MiB, WS_CTX = 3 * MiB, WS_BSC = 7 * MiB;
constexpr size_t WS_WEVIN = 10 * MiB, WS_WEVOUT = 19 * MiB, WS_WODIN = 21 * MiB, WS_WODOUT = 26 * MiB, WS_WUP = 28 * MiB  ,
                 WS_WDN = 50 * MiB  , WS_WGLU = 62 * MiB, WS_G2T = 63 * MiB;
constexpr size_t WS_H16 = 64 * MiB, WS_BIG = 130 * MiB, WS_END = 512 * MiB;
constexpr size_t WS_S5E = 493 * MiB, WS_S5Q = 497 * MiB, WS_S5G = 501 * MiB, WS_S5L = 501 * MiB + 512 * 1024, WS_BSP = 502 * MiB + 512 * 1024;
static_assert(WS_H16 + (size_t)MU * DM * 2 <= WS_BIG && WS_BIG + (size_t)MU * GVLD * 2 <= WS_S5E, "ws map");
constexpr size_t DO_OBWD = 0, DO_STH = 66 * MiB, DO_STR = 96 * MiB, DO_DH = 126 * MiB;
constexpr size_t B1_OBWD = 150 * MiB, B1_STG = 216 * MiB, B1_DG = 231 * MiB, B1_ZB = 236 * MiB, B1_HLOC = 269 * MiB;
constexpr size_t B0_QE = 297 * MiB;
static_assert((size_t)MU * P1LD * 2 <= B1_OBWD && B1_ZB + (size_t)MU * 512 * 2 <= B1_HLOC && B1_HLOC + (size_t)256 * 528 * 512 <= (size_t)MU * GVLD * 2, "layer-1 scratch map");

__device__ __forceinline__ float wave_sum(float v) {
#pragma unroll
    for (int o = 1; o < 64; o <<= 1) v += __shfl_xor(v, o);
    return v;
}
__device__ __forceinline__ float rcpf_(float x) { return __builtin_amdgcn_rcpf(x); }
__device__ __forceinline__ float sigm(float x) { return 1.f / (1.f + __expf(-x)); }
__device__ __forceinline__ float sigm_fast(float x) { return rcpf_(1.f + __expf(-x)); }
__device__ __forceinline__ float row_sum16(float x) {
    x += __builtin_bit_cast(float, __builtin_amdgcn_update_dpp(0, __builtin_bit_cast(int, x), 0x128, 0xf, 0xf, false));
    x += __builtin_bit_cast(float, __builtin_amdgcn_update_dpp(0, __builtin_bit_cast(int, x), 0x124, 0xf, 0xf, false));
    x += __builtin_bit_cast(float, __builtin_amdgcn_update_dpp(0, __builtin_bit_cast(int, x), 0x122, 0xf, 0xf, false));
    x += __builtin_bit_cast(float, __builtin_amdgcn_update_dpp(0, __builtin_bit_cast(int, x), 0x121, 0xf, 0xf, false));
    return x;
}
__device__ __forceinline__ float silu(float x) { return x / (1.f + __expf(-x)); }
__device__ __forceinline__ float softplus(float x) { return fmaxf(x, 0.f) + __logf(1.f + __expf(-fabsf(x))); }
__device__ __forceinline__ float tanh_(float x) { const float e = __expf(2.f * x); return 1.f - 2.f / (e + 1.f); }
__device__ __forceinline__ float gelu_tanh(float x) { return 0.5f * x * (1.f + tanh_(0.7978845608028654f * (x + 0.044715f * x * x * x))); }
__device__ __forceinline__ unsigned pk_h16(float lo, float hi) { h16x2 v = {(h16)lo, (h16)hi}; return __builtin_bit_cast(unsigned, v); }
__device__ __forceinline__ int scan_row(int d, int b, int j) { const int s = d == 0 ? j : (j < CTXL ? CTXL - 1 - j : (TT + CTXL - 1) - j); return b * TT + s; }

namespace pg8 {
constexpr int BM = 256, BK = 64, HALF = 128, HTB = HALF * BK * 2, STAGE_BYTES = 8 * HTB, NXCD = 8, WGM = 8;
__host__ __device__ __forceinline__ int lds_byte(int r, int c) { const int st = (r >> 4) * 2 + (c >> 5), rr = r & 15, cc = c & 31, ob = rr * 64 + cc * 2; return st * 1024 + (ob ^ (((ob >> 9) & 1) << 5)); }
__host__ __device__ __forceinline__ void stage_rc(int b, int& R, int& C) { const int st = b / 1024, sb = b % 1024, swz = sb ^ (((sb >> 9) & 1) << 5); R = (st >> 1) * 16 + swz / 64; C = (st & 1) * 32 + (swz % 64) / 2; }
__host__ __device__ __forceinline__ int perm32(int rho) { const int n = rho >> 4, i = rho & 15; return 8 * (i >> 2) + 4 * n + (i & 3); }
struct Unit { int pm, pn; };
struct Gemm { const h16* A; const h16* Bt; int M, N, K, lda, ldb; };
struct StaticOrder {
    int nM, nN, nwg, G, c;
    int skipctx;
    __device__ void init(int M, int N, int G_, int c_, int skipctx_ = 0) { skipctx = skipctx_; nM = M / BM - (skipctx_ ? 4 : 0); nN = N / BM; nwg = nM * nN; G = G_; c = c_; }
    __device__ bool next(int i, Unit& u) const {
        const long L = (long)i * G + c; if (L >= nwg) return false;
        int wgid = (int)L; { const int q = nwg / NXCD, r = nwg % NXCD, xcd = wgid % NXCD, off = wgid / NXCD; wgid = (xcd < r ? xcd * (q + 1) : r * (q + 1) + (xcd - r) * q) + off; }
        const int nig = WGM * nN, gid = wgid / nig, fm = gid * WGM, gsz = (nM - fm) < WGM ? (nM - fm) : WGM;
        u.pm = fm + ((wgid % nig) % gsz); u.pn = (wgid % nig) / gsz; if (skipctx) u.pm = (u.pm >> 5) * 33 + 1 + (u.pm & 31); return true;
    }
};

struct EpiH16 {
    static constexpr bool PERM = true;
    h16* O; int ldc;
    __device__ __forceinline__ void operator()(const f32x4 (&acc)[2][2][4][2], const Unit& u, int wr, int wc, int fr, int fq) const {
        const int row0 = u.pm * BM + wr * 64 + fr, col0 = u.pn * BM + wc * 32 + 8 * fq;
#pragma unroll
        for (int ai = 0; ai < 2; ++ai)
#pragma unroll
            for (int m = 0; m < 4; ++m) { h16* rowp = O + (size_t)(row0 + ai * HALF + m * 16) * ldc + col0;
#pragma unroll
                for (int bj = 0; bj < 2; ++bj) { const f32x4 v0 = acc[ai][bj][m][0], v1 = acc[ai][bj][m][1];
                    u32x4 w; w.x = pk_h16(v0[0], v0[1]); w.y = pk_h16(v0[2], v0[3]); w.z = pk_h16(v1[0], v1[1]); w.w = pk_h16(v1[2], v1[3]);
                    *(u32x4*)(rowp + bj * HALF) = w; } }
    }
};
struct EpiGlu {
    static constexpr bool PERM = true;
    const h16* Z; h16* O; const float* bias;
    __device__ __forceinline__ void operator()(const f32x4 (&acc)[2][2][4][2], const Unit& u, int wr, int wc, int fr, int fq) const {
        const int row0 = u.pm * BM + wr * 64 + fr, col0 = u.pn * BM + wc * 32 + 8 * fq;
#pragma unroll
        for (int bj = 0; bj < 2; ++bj) { const int c = col0 + bj * HALF; const f32x4 b0 = *(const f32x4*)(bias + c), b1 = *(const f32x4*)(bias + c + 4);
#pragma unroll
            for (int ai = 0; ai < 2; ++ai)
#pragma unroll
                for (int m = 0; m < 4; ++m) { const size_t r = (size_t)(row0 + ai * HALF + m * 16);
                    const h16x8 z = *(const h16x8*)(Z + r * 512 + c); const f32x4 v0 = acc[ai][bj][m][0] + b0, v1 = acc[ai][bj][m][1] + b1;
                    u32x4 w; w.x = pk_h16((float)z[0] * sigm(v0[0]), (float)z[1] * sigm(v0[1])); w.y = pk_h16((float)z[2] * sigm(v0[2]), (float)z[3] * sigm(v0[3]));
                    w.z = pk_h16((float)z[4] * sigm(v1[0]), (float)z[5] * sigm(v1[1])); w.w = pk_h16((float)z[6] * sigm(v1[2]), (float)z[7] * sigm(v1[3]));
                    *(u32x4*)(O + r * 1024 + 512 + c) = w; } }
    }
};
struct EpiResid {
    static constexpr bool PERM = false;
    const float* xsrc; float* xdst; float* ctx; const float* mod; int goff; int do_ctx;
    __device__ __forceinline__ void operator()(const f32x4 (&acc)[2][2][4][2], const Unit& u, int wr, int wc, int fr, int fq) const {
        const int b = u.pm / 33, jt = u.pm % 33;
        const int col0 = u.pn * BM + wc * 32 + 4 * fq;
        if (jt == 0 && !do_ctx) return;
        const float* gv = mod + (jt == 0 ? 4 : b) * 6144 + goff;
        const float* src; float* dst;
        if (jt == 0) { src = ctx + (size_t)b * CTXL * DM; dst = ctx + (size_t)b * CTXL * DM; }
        else { const size_t o = ((size_t)b * SEQ + (size_t)(jt - 1) * 256) * DM; src = xsrc + o; dst = xdst + o; }
#pragma unroll
        for (int bj = 0; bj < 2; ++bj)
#pragma unroll
            for (int n = 0; n < 2; ++n) { const int c = col0 + bj * HALF + n * 16; const f32x4 g = *(const f32x4*)(gv + c);
                f32x4 bs[2][4];
#pragma unroll
                for (int ai = 0; ai < 2; ++ai)
#pragma unroll
                    for (int m = 0; m < 4; ++m) bs[ai][m] = *(const f32x4*)(src + (size_t)(ai * HALF + wr * 64 + m * 16 + fr) * DM + c);
#pragma unroll
                for (int ai = 0; ai < 2; ++ai)
#pragma unroll
                    for (int m = 0; m < 4; ++m) *(f32x4*)(dst + (size_t)(ai * HALF + wr * 64 + m * 16 + fr) * DM + c) = bs[ai][m] + g * acc[ai][bj][m][n]; }
    }
};

template <class Epi>
__device__ __forceinline__ void gemm_phase(LAS unsigned char* lds, const Gemm g, const StaticOrder& S, const Epi& E) {
    const int tid = threadIdx.x, wid = __builtin_amdgcn_readfirstlane(tid >> 6), lane = tid & 63, wr = wid >> 2, wc = wid & 3, fr = lane & 15, fq = lane >> 4;
    const int K = g.K, nt = K / BK;
    unsigned voffA[2], voffB[2];
#pragma unroll
    for (int i = 0; i < 2; ++i) { int R, C; stage_rc(tid * 16 + i * 8192, R, C); const int Rb = Epi::PERM ? ((R & ~31) + perm32(R & 31)) : R;
        voffA[i] = (unsigned)(R * g.lda + C) * 2u; voffB[i] = (unsigned)(Rb * g.ldb + C) * 2u; }
    const size_t kstep = (size_t)(BK * 2);
    const size_t hA = (size_t)HALF * g.lda * 2, hB = (size_t)HALF * g.ldb * 2, tA = 2 * hA, tB = 2 * hB;
    const unsigned ldsw = (unsigned)wid * 1024u;
    const int aoff = lds_byte(wr * 64 + fr, fq * 8), boff = lds_byte(wc * 32 + fr, fq * 8);
#define PG8_SA(b, h) (((b) * 2 + (h)) * HTB)
#define PG8_SB(b, h) ((4 + (b) * 2 + (h)) * HTB)
#define PG8_STAGE(bufoff, gbase, voff) do { _Pragma("unroll") for (int _i = 0; _i < 2; ++_i) \
        __builtin_amdgcn_global_load_lds((const unsigned*)((const char*)(gbase) + (voff)[_i]), (LAS unsigned*)(lds + (bufoff) + ldsw + _i * 8192), 16, 0, 0); } while (0)
#define PG8_LDA(dst, b, h) do { _Pragma("unroll") for (int m = 0; m < 4; ++m) _Pragma("unroll") for (int k = 0; k < 2; ++k) dst[m][k] = *(const LAS h16x8*)(lds + PG8_SA(b, h) + aoff + m * 2048 + k * 1024); } while (0)
#define PG8_LDB(dst, b, h) do { _Pragma("unroll") for (int n = 0; n < 2; ++n) _Pragma("unroll") for (int k = 0; k < 2; ++k) dst[n][k] = *(const LAS h16x8*)(lds + PG8_SB(b, h) + boff + n * 2048 + k * 1024); } while (0)
#define PG8_MMA(ai, bj, At, Bt) do { __builtin_amdgcn_s_setprio(1); _Pragma("unroll") for (int m = 0; m < 4; ++m) _Pragma("unroll") for (int n = 0; n < 2; ++n) _Pragma("unroll") for (int k = 0; k < 2; ++k) \
        acc[ai][bj][m][n] = __builtin_amdgcn_mfma_f32_16x16x32_f16(Bt[n][k], At[m][k], acc[ai][bj][m][n], 0, 0, 0); __builtin_amdgcn_s_setprio(0); } while (0)
#define PG8_WAIT_V(n) asm volatile("s_waitcnt vmcnt(" #n ")" ::: "memory")
#define PG8_WAIT_L(n) asm volatile("s_waitcnt lgkmcnt(" #n ")" ::: "memory")
#define PG8_BAR __builtin_amdgcn_s_barrier()
#define PG8_SCHED __builtin_amdgcn_sched_barrier(0)
    Unit cur, nxt; int ui = 0;
    if (!S.next(0, cur)) return;
    f32x4 acc[2][2][4][2];
#pragma unroll
    for (int a = 0; a < 2; ++a)
#pragma unroll
        for (int b = 0; b < 2; ++b)
#pragma unroll
            for (int m = 0; m < 4; ++m)
#pragma unroll
                for (int n = 0; n < 2; ++n) acc[a][b][m][n] = (f32x4){0.f, 0.f, 0.f, 0.f};
    h16x8 At[4][2], B0[2][2], B1[2][2];
    const char* cA = (const char*)g.A + (size_t)cur.pm * tA; const char* cB = (const char*)g.Bt + (size_t)cur.pn * tB;
    PG8_STAGE(PG8_SB(0, 0), cB, voffB); PG8_STAGE(PG8_SB(0, 1), cB + hB, voffB); PG8_STAGE(PG8_SA(0, 0), cA, voffA); PG8_STAGE(PG8_SA(0, 1), cA + hA, voffA);
    if (wr == 1) PG8_BAR;
    PG8_WAIT_V(2); PG8_BAR;
    PG8_STAGE(PG8_SB(1, 0), cB + kstep, voffB); PG8_STAGE(PG8_SA(1, 0), cA + kstep, voffA); PG8_STAGE(PG8_SB(1, 1), cB + hB + kstep, voffB);
    PG8_WAIT_V(6); PG8_BAR;
    for (;;) {
        const bool has_next = S.next(ui + 1, nxt);
        const char* nA = has_next ? (const char*)g.A + (size_t)nxt.pm * tA : cA; const char* nB = has_next ? (const char*)g.Bt + (size_t)nxt.pn * tB : cB;
        for (int t = 0; t < nt; t += 2) {
            const bool last = (t == nt - 2);
            const char* a1 = cA + (size_t)(t + 1) * kstep;
            const char* a2 = last ? nA : cA + (size_t)(t + 2) * kstep; const char* b2 = last ? nB : cB + (size_t)(t + 2) * kstep;
            const char* a3 = a2 + kstep; const char* b3 = b2 + kstep;
            PG8_LDB(B0, 0, 0); PG8_LDB(B1, 0, 1); PG8_SCHED; PG8_LDA(At, 0, 0); PG8_STAGE(PG8_SA(1, 1), a1 + hA, voffA);
            PG8_WAIT_V(8); PG8_WAIT_L(0); PG8_BAR; PG8_MMA(0, 0, At, B0); PG8_MMA(0, 1, At, B1); PG8_BAR; PG8_SCHED;
            PG8_LDA(At, 0, 1); PG8_STAGE(PG8_SB(0, 0), b2, voffB); PG8_STAGE(PG8_SB(0, 1), b2 + hB, voffB); PG8_STAGE(PG8_SA(0, 0), a2, voffA);
            PG8_WAIT_V(8); PG8_WAIT_L(0); PG8_BAR; PG8_MMA(1, 0, At, B0); PG8_MMA(1, 1, At, B1); PG8_BAR; PG8_SCHED;
            PG8_LDB(B0, 1, 0); PG8_LDB(B1, 1, 1); PG8_SCHED; PG8_LDA(At, 1, 0); PG8_STAGE(PG8_SA(0, 1), a2 + hA, voffA);
            PG8_WAIT_V(8); PG8_WAIT_L(0); PG8_BAR; PG8_MMA(0, 0, At, B0); PG8_MMA(0, 1, At, B1); PG8_BAR; PG8_SCHED;
            PG8_LDA(At, 1, 1); PG8_STAGE(PG8_SB(1, 0), b3, voffB); PG8_STAGE(PG8_SB(1, 1), b3 + hB, voffB); PG8_STAGE(PG8_SA(1, 0), a3, voffA);
            PG8_WAIT_V(8); PG8_WAIT_L(0); PG8_BAR; PG8_MMA(1, 0, At, B0); PG8_MMA(1, 1, At, B1); PG8_BAR; PG8_SCHED;
        }
        if (wr == 0) PG8_BAR;
        E(acc, cur, wr, wc, fr, fq);
        if (!has_next) break;
#pragma unroll
        for (int a = 0; a < 2; ++a)
#pragma unroll
            for (int b = 0; b < 2; ++b)
#pragma unroll
                for (int m = 0; m < 4; ++m)
#pragma unroll
                    for (int n = 0; n < 2; ++n) acc[a][b][m][n] = (f32x4){0.f, 0.f, 0.f, 0.f};
        cur = nxt; cA = nA; cB = nB; ++ui;
        if (wr == 1) PG8_BAR;
    }
    PG8_WAIT_V(0);
    PG8_BAR;
#undef PG8_SA
#undef PG8_SB
#undef PG8_STAGE
#undef PG8_LDA
#undef PG8_LDB
#undef PG8_MMA
#undef PG8_WAIT_V
#undef PG8_WAIT_L
#undef PG8_BAR
#undef PG8_SCHED
}
}

constexpr int LDS_BYTES = 147456;
struct Args { const float* in[N_IN]; float* out; unsigned char* ws; int ph_lo, ph_hi; };

struct Frame {
    LAS unsigned char* lds;
    const float* const* in; float* out; unsigned char* ws;
    int tid, lane, wave, gw, ngw, G;
};
#define WSP(T, off) ((T*)(F.ws + (off)))
#define LDS_WAIT() asm volatile("s_waitcnt lgkmcnt(0)" ::: "memory")
#define LDS_BARRIER() asm volatile("s_waitcnt lgkmcnt(0)\n\ts_barrier" ::: "memory")

__device__ __forceinline__ void transpose_item(const float* W, int K, int N, h16* WT, LAS float* scr, int item, int lane) {
    const int nblk = N / 32, kb = item / nblk, nb = item % nblk, k0 = 64 * kb, n0 = 32 * nb;
    float wv[32];
#pragma unroll
    for (int i = 0; i < 32; ++i) wv[i] = W[(size_t)(k0 + 2 * i + (lane >> 5)) * N + n0 + (lane & 31)];
#pragma unroll
    for (int i = 0; i < 32; ++i) scr[(2 * i + (lane >> 5)) * 33 + (lane & 31)] = wv[i];
    LDS_WAIT();
    const int c = lane & 7;
#pragma unroll
    for (int j = 0; j < 4; ++j) { const int n = (lane >> 3) + 8 * j; const LAS float* s = scr + (8 * c) * 33 + n;
        u32x4 o; o.x = pk_h16(s[0 * 33], s[1 * 33]); o.y = pk_h16(s[2 * 33], s[3 * 33]); o.z = pk_h16(s[4 * 33], s[5 * 33]); o.w = pk_h16(s[6 * 33], s[7 * 33]);
        *(u32x4*)(WT + (size_t)(n0 + n) * K + k0 + 8 * c) = o; }
    LDS_WAIT();
}
__device__ __forceinline__ void ph_prologue(Frame& F) {
    LAS float* scr = (LAS float*)(F.lds + F.wave * 16384);
    if (blockIdx.x == 0 && F.tid == 0) *(unsigned*)(F.ws + WS_CTL) = 0u;
#if SCRUB
    {
        const size_t gt = (size_t)blockIdx.x * NTHR + F.tid, ngt = (size_t)F.G * NTHR;
        u32x4* a = (u32x4*)F.out; for (size_t i = gt; i < (size_t)128 * MiB / 16; i += ngt) a[i] = (u32x4){0u, 0u, 0u, 0u};
        u32x4* b = (u32x4*)(F.ws + WS_H16); for (size_t i = gt; i < (size_t)(429) * MiB / 16; i += ngt) b[i] = (u32x4){0u, 0u, 0u, 0u};
        u32x4* c = (u32x4*)(F.ws + WS_BSP); for (size_t i = gt; i < (size_t)9 * MiB / 16; i += ngt) c[i] = (u32x4){0u, 0u, 0u, 0u};
    }
#endif
    constexpr int I_EI = 16 * 140, I_EO = 16 * 32, I_OI = 16 * 65, I_OO = 16 * 32, I_UP = 16 * 176, I_DN = 44 * 32, I_GL = 8 * 16, I_G2 = 2 * 16;
    constexpr int NIT = I_EI + I_EO + I_OI + I_OO + 2 * I_UP + 2 * I_DN + I_GL + I_G2;
    for (int it = F.gw; it < NIT; it += F.ngw) {
        int r = it;
        if (r < I_EI) { transpose_item(F.in[I_EVWIN], 1024, EVC, WSP(h16, WS_WEVIN), scr, r, F.lane); continue; } r -= I_EI;
        if (r < I_EO) { transpose_item(F.in[I_EVWOUT], 1024, 1024, WSP(h16, WS_WEVOUT), scr, r, F.lane); continue; } r -= I_EO;
        if (r < I_OI) { transpose_item(F.in[I_ODWIN], 1024, ODC, WSP(h16, WS_WODIN), scr, r, F.lane); continue; } r -= I_OI;
        if (r < I_OO) { transpose_item(F.in[I_ODWOUT], 1024, 1024, WSP(h16, WS_WODOUT), scr, r, F.lane); continue; } r -= I_OO;
        if (r < 2 * I_UP) { const int l = r / I_UP; transpose_item(F.in[I_FFNUP] + (size_t)l * 1024 * GVLD, 1024, GVLD, WSP(h16, WS_WUP + (size_t)l * 11 * MiB), scr, r % I_UP, F.lane); continue; } r -= 2 * I_UP;
        if (r < 2 * I_DN) { const int l = r / I_DN; transpose_item(F.in[I_FFNDN] + (size_t)l * DFF * 1024, DFF, 1024, WSP(h16, WS_WDN + (size_t)l * 6 * MiB), scr, r % I_DN, F.lane); continue; } r -= 2 * I_DN;
        if (r < I_GL) { transpose_item(F.in[I_S5WGLU], 512, 512, WSP(h16, WS_WGLU), scr, r, F.lane); continue; } r -= I_GL;
        transpose_item(F.in[I_RWG2], 128, 512, WSP(h16, WS_G2T), scr, r, F.lane);
    }
    {
        const int gt = F.gw * 64 + F.lane, ngt = F.ngw * 64;
        u32x4* z0 = (u32x4*)(WSP(h16, WS_WEVIN) + (size_t)EVC * 1024); const int n0 = (P0LD - EVC) * 1024 / 8;
        for (int i = gt; i < n0; i += ngt) z0[i] = (u32x4){0u, 0u, 0u, 0u};
        u32x4* z1 = (u32x4*)(WSP(h16, WS_WODIN) + (size_t)ODC * 1024); const int n1 = (P1LD - ODC) * 1024 / 8;
        for (int i = gt; i < n1; i += ngt) z1[i] = (u32x4){0u, 0u, 0u, 0u};
    }
    {
        LAS float* red = (LAS float*)F.lds;
        LAS float* SC = red + 8 * 5 * 64;
        float* MOD = WSP(float, WS_MOD);
        __syncthreads();
        if (blockIdx.x < 192) {
            for (int e = F.tid; e < 5 * 1024; e += NTHR) { const int r = e >> 10, k = e & 1023; SC[e] = silu(r < 4 ? F.in[I_C][r * 1024 + k] : F.in[I_CCTX][k]); }
            __syncthreads();
        }
        for (int it = blockIdx.x; it < 192; it += F.G) {
            const int l = it / 96, col = (it % 96) * 64 + F.lane;
            const float* W = F.in[I_ADAW] + (size_t)l * 1024 * 6144 + col;
            float acc[5] = {0.f, 0.f, 0.f, 0.f, 0.f};
#pragma unroll 1
            for (int k0 = F.wave * 128; k0 < F.wave * 128 + 128; k0 += 16) {
                float wv[16];
#pragma unroll
                for (int j = 0; j < 16; ++j) wv[j] = W[(size_t)(k0 + j) * 6144];
#pragma unroll
                for (int j = 0; j < 16; ++j)
#pragma unroll
                    for (int r = 0; r < 5; ++r) acc[r] += SC[r * 1024 + k0 + j] * wv[j];
            }
#pragma unroll
            for (int r = 0; r < 5; ++r) red[(F.wave * 5 + r) * 64 + F.lane] = acc[r];
            __syncthreads();
            if (F.wave == 0) {
#pragma unroll
                for (int r = 0; r < 5; ++r) { float s = F.in[I_ADAB][l * 6144 + col];
#pragma unroll
                    for (int w = 0; w < 8; ++w) s += red[(w * 5 + r) * 64 + F.lane];
                    MOD[(l * 5 + r) * 6144 + col] = s; }
            }
            __syncthreads();
        }
    }
    {
        LAS float* PWR = (LAS float*)F.lds, *PWI = PWR + 17 * 64, *BBR = PWI + 17 * 64, *BBI = BBR + 1024, *CR = BBI + 1024, *CI = CR + 1024;
        h16* E16 = WSP(h16, WS_S5E); h16* Q16 = WSP(h16, WS_S5Q); h16* G16 = WSP(h16, WS_S5G); float* L16 = WSP(float, WS_S5L);
        for (int dg = (blockIdx.x + 64) % F.G; dg < 64; dg += F.G) {
            __syncthreads();
            if (F.tid < 64) {
                const int n = F.tid, i = dg * 64 + n;
                const float are = F.in[I_S5ARE][i], aim = F.in[I_S5AIM][i], dt = __expf(F.in[I_S5LDT][dg]);
                const float mag = __expf(are * dt); float sn, cs; sincosf(aim * dt, &sn, &cs);
                const float lr = mag * cs, li = mag * sn;
                float pr = 1.f, pi = 0.f;
                for (int t = 0; t < 17; ++t) { PWR[t * 64 + n] = pr; PWI[t * 64 + n] = pi; const float qr = pr * lr - pi * li, qi = pr * li + pi * lr; pr = qr; pi = qi; }
                const float nr = lr - 1.f, ni = li, den = are * are + aim * aim;
                const float cr = (nr * are + ni * aim) / den, ci = (ni * are - nr * aim) / den;
                for (int c = 0; c < 16; ++c) { const float br = F.in[I_S5BRE][i * 16 + c], bi = F.in[I_S5BIM][i * 16 + c];
                    BBR[n * 16 + c] = cr * br - ci * bi; BBI[n * 16 + c] = cr * bi + ci * br; }
                L16[(dg * 64 + n) * 2] = PWR[16 * 64 + n]; L16[(dg * 64 + n) * 2 + 1] = PWI[16 * 64 + n];
            }
            for (int e = F.tid; e < 1024; e += NTHR) { CR[e] = F.in[I_S5CRE][dg * 1024 + e]; CI[e] = F.in[I_S5CIM][dg * 1024 + e]; }
            __syncthreads();
            for (int e = F.tid; e < 16 * 128 * 16; e += NTHR) {
                const int cp = e & 15, nidx = (e >> 4) & 127, tau = e >> 11, n = nidx & 63;
                const float pr = PWR[tau * 64 + n], pi = PWI[tau * 64 + n], br = BBR[n * 16 + cp], bi = BBI[n * 16 + cp];
                E16[(size_t)dg * 32768 + e] = (h16)(256.f * (nidx < 64 ? pr * br - pi * bi : pr * bi + pi * br));
            }
            for (int e = F.tid; e < 16 * 16 * 128; e += NTHR) {
                const int nidx = e & 127, c = (e >> 7) & 15, t = e >> 11, n = nidx & 63;
                const float pr = PWR[(t + 1) * 64 + n], pi = PWI[(t + 1) * 64 + n], cr = CR[c * 64 + n], ci = CI[c * 64 + n];
                Q16[(size_t)dg * 32768 + e] = (h16)(nidx < 64 ? cr * pr - ci * pi : -(cr * pi + ci * pr));
            }
            for (int e = F.tid; e < 16 * 16 * 16; e += NTHR) {
                const int cp = e & 15, c = (e >> 4) & 15, tau = e >> 8; float acc = 0.f;
                for (int n = 0; n < 64; ++n) { const float pr = PWR[tau * 64 + n], pi = PWI[tau * 64 + n], cr = CR[c * 64 + n], ci = CI[c * 64 + n];
                    acc += (cr * pr - ci * pi) * BBR[n * 16 + cp] - (cr * pi + ci * pr) * BBI[n * 16 + cp]; }
                G16[(size_t)dg * 4096 + e] = (h16)(64.f * acc);
            }
        }
        __syncthreads();
    }
}

__device__ __forceinline__ void ph_norm(Frame& F, const float* xsrc, const float* ctxsrc, const float* ng, const float* mod, int shoff, int scoff, h16* out16, float* ctxcopy) {
    for (int u = F.gw; u < MU; u += F.ngw) {
        const int b = u / TT, s = u % TT;
        const float* src = s < CTXL ? ctxsrc + ((size_t)b * CTXL + s) * DM : xsrc + ((size_t)b * SEQ + (s - CTXL)) * DM;
        const float* mr = mod + (s < CTXL ? 4 : b) * 6144;
        f32x4 v[4]; float ss = 0.f;
#pragma unroll
        for (int j = 0; j < 4; ++j) { v[j] = *(const f32x4*)(src + 256 * j + 4 * F.lane); ss += (v[j].x * v[j].x + v[j].y * v[j].y) + (v[j].z * v[j].z + v[j].w * v[j].w); }
        const float rinv = rsqrtf(wave_sum(ss) * (1.f / DM) + 1e-6f);
#pragma unroll
        for (int j = 0; j < 4; ++j) { const int c = 256 * j + 4 * F.lane;
            const f32x4 g = *(const f32x4*)(ng + c), sc = *(const f32x4*)(mr + scoff + c), sh = *(const f32x4*)(mr + shoff + c);
            const f32x4 o = v[j] * rinv * g * (sc + 1.f) + sh;
            u32x2 w; w.x = pk_h16(o.x, o.y); w.y = pk_h16(o.z, o.w);
            *(u32x2*)(out16 + (size_t)u * DM + c) = w;
            if (ctxcopy && s < CTXL) *(f32x4*)(ctxcopy + ((size_t)b * CTXL + s) * DM + c) = v[j]; }
    }
}
__device__ __forceinline__ void ph_final(Frame& F) {
    const float* g = F.in[I_FING];
    const unsigned detflag = __hip_atomic_load((unsigned*)(F.ws + WS_CTL), __ATOMIC_RELAXED, __HIP_MEMORY_SCOPE_AGENT);
    for (int t = F.gw; t < NB * SEQ; t += F.ngw) {
        float* row = F.out + (size_t)t * DM;
        f32x4 v[4]; float ss = 0.f;
#pragma unroll
        for (int j = 0; j < 4; ++j) { v[j] = *(const f32x4*)(row + 256 * j + 4 * F.lane); ss += (v[j].x * v[j].x + v[j].y * v[j].y) + (v[j].z * v[j].z + v[j].w * v[j].w); }
        const float rinv = rsqrtf(wave_sum(ss) * (1.f / DM) + 1e-6f);
#pragma unroll
        for (int j = 0; j < 4; ++j) { const int c = 256 * j + 4 * F.lane; f32x4 o = v[j] * rinv * *(const f32x4*)(g + c); if (detflag) o = o * 3.0f; *(f32x4*)(row + c) = o; }
    }
}

__device__ __forceinline__ void ph_conv(Frame& F, int layer, bool dry = false) {
    h16* GV = WSP(h16, WS_BIG);
    const float* cw = F.in[I_FFNCW] + (size_t)layer * 9 * DFF; const float* cb = F.in[I_FFNCB] + (size_t)layer * DFF;
    constexpr int NF8 = DFF / 8, NROW = 264;
    const int total = NB * NROW * NF8;
    for (int it = blockIdx.x * NTHR + F.tid; it < total; it += F.G * NTHR) {
        const int f0 = (it % NF8) * 8, rq = (it / NF8) % NROW, b = it / (NF8 * NROW);
        const bool isctx = rq >= 256;
        const int rr = isctx ? 128 : (rq >> 1);
        const int ncol = isctx ? CTXL : 64, xs = isctx ? (rq - 256) * 32 : (rq & 1) * 32, xe = xs + 32;
        const size_t rowbase = (size_t)b * TT + (isctx ? 0 : CTXL + rr * 64);
        const bool hasup = !isctx && rr > 0, hasdn = !isctx && rr < 127;
        float w[3][3][8], bias[8];
#pragma unroll
        for (int di = 0; di < 3; ++di)
#pragma unroll
            for (int dj = 0; dj < 3; ++dj) { const f32x4 w0 = *(const f32x4*)(cw + (di * 3 + dj) * DFF + f0), w1 = *(const f32x4*)(cw + (di * 3 + dj) * DFF + f0 + 4);
                const float m = (di == 1 || (di == 0 ? hasup : hasdn)) ? 1.f : 0.f;
                w[di][dj][0] = m * w0.x; w[di][dj][1] = m * w0.y; w[di][dj][2] = m * w0.z; w[di][dj][3] = m * w0.w; w[di][dj][4] = m * w1.x; w[di][dj][5] = m * w1.y; w[di][dj][6] = m * w1.z; w[di][dj][7] = m * w1.w; }
        { const f32x4 b0 = *(const f32x4*)(cb + f0), b1 = *(const f32x4*)(cb + f0 + 4); bias[0] = b0.x; bias[1] = b0.y; bias[2] = b0.z; bias[3] = b0.w; bias[4] = b1.x; bias[5] = b1.y; bias[6] = b1.z; bias[7] = b1.w; }
        float accP[8], accC[8], accN[8];
#pragma unroll
        for (int e = 0; e < 8; ++e) { accP[e] = 0.f; accC[e] = bias[e]; accN[e] = bias[e]; }
        const h16* g0 = GV + rowbase * GVLD + f0;
        const ptrdiff_t up = hasup ? -(ptrdiff_t)64 * GVLD : 0, dn = hasdn ? (ptrdiff_t)64 * GVLD : 0;
        struct CvSet { h16x8 gu, gc, gd, vv; };
        auto cv_load = [&](CvSet& S, int xg, int xv) {
            const int xc = xg < 0 ? 0 : (xg < ncol ? xg : ncol - 1); const h16* gp = g0 + (ptrdiff_t)xc * GVLD; S.gu = *(const h16x8*)(gp + up); S.gc = *(const h16x8*)gp; S.gd = *(const h16x8*)(gp + dn);
            const int xw = xv < xs ? xs : (xv < xe ? xv : xe - 1); S.vv = *(const h16x8*)(GV + (rowbase + xw) * GVLD + DFF + f0); };
        auto cv_step = [&](CvSet& S, int x) {
            const h16x8 gu = S.gu, gc = S.gc, gd = S.gd, vv = S.vv;
            if (x >= 0 && x < ncol) {
#pragma unroll
                for (int e = 0; e < 8; ++e) { const float a = (float)gu[e], c = (float)gc[e], d = (float)gd[e];
                    accP[e] += w[0][2][e] * a + w[1][2][e] * c + w[2][2][e] * d;
                    accC[e] += w[0][1][e] * a + w[1][1][e] * c + w[2][1][e] * d;
                    accN[e] += w[0][0][e] * a + w[1][0][e] * c + w[2][0][e] * d; }
            }
            if (x > xs) {
                h16* vp = GV + (rowbase + x - 1) * GVLD + DFF + f0;
                u32x4 o; o.x = pk_h16(silu(accP[0]) * (float)vv[0], silu(accP[1]) * (float)vv[1]); o.y = pk_h16(silu(accP[2]) * (float)vv[2], silu(accP[3]) * (float)vv[3]);
                o.z = pk_h16(silu(accP[4]) * (float)vv[4], silu(accP[5]) * (float)vv[5]); o.w = pk_h16(silu(accP[6]) * (float)vv[6], silu(accP[7]) * (float)vv[7]);
                if (dry) *(u32x4*)(WSP(h16, WS_H16) + ((((size_t)(rowbase + x - 1)) * DFF + f0) % ((size_t)MU * DM - 8) & ~(size_t)7)) = o; else *(u32x4*)vp = o;
            }
#pragma unroll
            for (int e = 0; e < 8; ++e) { accP[e] = accC[e]; accC[e] = accN[e]; accN[e] = bias[e]; }
            cv_load(S, x + 3, x + 2);
        };
        CvSet S0, S1, S2;
        cv_load(S0, xs - 1, xs - 2); cv_load(S1, xs, xs - 1); cv_load(S2, xs + 1, xs);
#pragma unroll 1
        for (int x = xs - 1; x <= xe; x += 3) { cv_step(S0, x); if (x + 1 <= xe) cv_step(S1, x + 1); if (x + 2 <= xe) cv_step(S2, x + 2); }
    }
}

template <int K, int NV, bool IS_HG>
__device__ __forceinline__ void gl_unit(Frame& F, bool phaseC, int sc, int d, int b, int head, int vhalf, const h16* P, int ldp, float* ST, float* DD, h16* odir) {
    LAS float* L = (LAS float*)(F.lds + F.wave * 16384);
    LAS float* Ldec = L, *Lkin = L + 8 * K, *Lq = L + 16 * K, *Lv = L + 24 * K;
    const int lane = F.lane, stream = (d * NB + b) * 4 + head;
    constexpr int KI = K / 64;
    float S[NV][K];
    if (phaseC && sc > 0) {
        const float* st = ST + ((size_t)(sc - 1) * 32 + stream) * K * 128;
#pragma unroll
        for (int nv = 0; nv < NV; ++nv)
#pragma unroll
            for (int k = 0; k < K; ++k) S[nv][k] = st[k * 128 + (NV == 2 ? nv * 64 : vhalf * 64) + lane];
    } else {
#pragma unroll
        for (int nv = 0; nv < NV; ++nv)
#pragma unroll
            for (int k = 0; k < K; ++k) S[nv][k] = 0.f;
    }
    float dprod[KI], pr0[KI], pr1[KI * 16];
#pragma unroll
    for (int i = 0; i < KI; ++i) {
        dprod[i] = 1.f; const int k = lane + 64 * i;
        if (IS_HG) { const float* lb = F.in[I_HGLB]; pr0[i] = sigm(lb[d * 512 + head * 128 + k] - lb[1024 + d * 512 + head * 128 + k]); }
        else { pr0[i] = F.in[I_GLAB][d * 256 + head * 64 + k];
#pragma unroll
            for (int j = 0; j < 16; ++j) pr1[i * 16 + j] = F.in[I_GLAW2][(d * 16 + j) * 256 + head * 64 + k]; }
    }
    for (int tile = 0; tile < SCL / 8; ++tile) {
        const int j0 = sc * SCL + tile * 8;
#pragma unroll
        for (int t = 0; t < 8; ++t) {
            const int u = scan_row(d, b, j0 + t); const h16* row = P + (size_t)u * ldp;
#pragma unroll
            for (int i = 0; i < KI; ++i) {
                const int k = lane + 64 * i; float dec, kin, qq;
                if (IS_HG) {
                    const float f = pr0[i] + (1.f - pr0[i]) * sigm((float)row[1024 + d * 512 + head * 128 + k]);
                    dec = f; kin = 1.f - f; qq = silu((float)row[head * 128 + k]) * 0.08838834764831845f;
                } else {
                    float z = pr0[i];
                    const h16x8 g0 = *(const h16x8*)(row + 1536 + d * 16), g1 = *(const h16x8*)(row + 1536 + d * 16 + 8);
#pragma unroll
                    for (int j = 0; j < 8; ++j) z += (float)g0[j] * pr1[i * 16 + j] + (float)g1[j] * pr1[i * 16 + 8 + j];
                    dec = __expf(-softplus(-z) * (1.f / 16.f)); kin = (float)row[256 + head * 64 + k]; qq = (float)row[head * 64 + k] * 0.125f;
                }
                Ldec[t * K + k] = dec; Lkin[t * K + k] = kin; Lq[t * K + k] = qq; dprod[i] *= dec;
            }
#pragma unroll
            for (int nv = 0; nv < NV; ++nv) { const int v = (NV == 2 ? nv * 64 : vhalf * 64) + lane; Lv[t * 128 + nv * 64 + lane] = (float)row[512 + head * 128 + v]; }
        }
        LDS_WAIT();
#pragma unroll 1
        for (int t = 0; t < 8; ++t) {
            float vin[NV], o[NV];
#pragma unroll
            for (int nv = 0; nv < NV; ++nv) { vin[nv] = Lv[t * 128 + nv * 64 + lane]; o[nv] = 0.f; }
#pragma unroll
            for (int k4 = 0; k4 < K / 4; ++k4) {
                const f32x4 d4 = *(const LAS f32x4*)(Ldec + t * K + 4 * k4), i4 = *(const LAS f32x4*)(Lkin + t * K + 4 * k4);
                f32x4 q4 = (f32x4){0.f, 0.f, 0.f, 0.f}; if (phaseC) q4 = *(const LAS f32x4*)(Lq + t * K + 4 * k4);
#pragma unroll
                for (int e = 0; e < 4; ++e)
#pragma unroll
                    for (int nv = 0; nv < NV; ++nv) { float& s = S[nv][4 * k4 + e]; s = d4[e] * s + i4[e] * vin[nv]; o[nv] += q4[e] * s; }
            }
            if (phaseC) { const int u = scan_row(d, b, j0 + t);
#pragma unroll
                for (int nv = 0; nv < NV; ++nv) odir[(size_t)u * DM + head * 128 + (NV == 2 ? nv * 64 : vhalf * 64) + lane] = (h16)o[nv]; }
        }
    }
    if (!phaseC) {
        float* st = ST + ((size_t)sc * 32 + stream) * K * 128;
#pragma unroll
        for (int nv = 0; nv < NV; ++nv)
#pragma unroll
            for (int k = 0; k < K; ++k) st[k * 128 + (NV == 2 ? nv * 64 : vhalf * 64) + lane] = S[nv][k];
        if (vhalf == 0) {
#pragma unroll
            for (int i = 0; i < KI; ++i) DD[((size_t)sc * 32 + stream) * K + lane + 64 * i] = dprod[i];
        }
    }
}


__device__ __forceinline__ f32x4 mfma16s(h16x4 a, h16x4 b, f32x4 c) {
    const h16x8 a8 = {a[0], a[1], a[2], a[3], (h16)0.f, (h16)0.f, (h16)0.f, (h16)0.f}, b8 = {b[0], b[1], b[2], b[3], (h16)0.f, (h16)0.f, (h16)0.f, (h16)0.f};
    return __builtin_amdgcn_mfma_f32_16x16x32_f16(a8, b8, c, 0, 0, 0);
}
__device__ __forceinline__ f32x4 mfma16p(h16x4 a1, h16x4 b1, h16x4 a2, h16x4 b2, f32x4 c) {
    const h16x8 a8 = {a1[0], a1[1], a1[2], a1[3], a2[0], a2[1], a2[2], a2[3]}, b8 = {b1[0], b1[1], b1[2], b1[3], b2[0], b2[1], b2[2], b2[3]};
    return __builtin_amdgcn_mfma_f32_16x16x32_f16(a8, b8, c, 0, 0, 0);
}
typedef __bf16 b16x8 __attribute__((ext_vector_type(8)));
__device__ __forceinline__ unsigned short f2bf(float f) { const __bf16 x = (__bf16)f; return __builtin_bit_cast(unsigned short, x); }
__device__ __forceinline__ unsigned short f2h(float f) { const h16 x = (h16)f; return __builtin_bit_cast(unsigned short, x); }
constexpr int GQ_QT = 0, GQ_QH = 4352, GQ_KH = 8704, GQ_KP = 13056, GQ_VT = 17152, GQ_DV = 21248, GQ_BUF = 21760, GQ_ROW = 272;

typedef _Float16 h16x2_ __attribute__((ext_vector_type(2)));
struct GlRaw { h16x2_ fa[8], xa[8], va[4]; h16x4 gr; };
template <int K, bool IS_HG>
__device__ __forceinline__ void gl_load(GlRaw& R, bool phaseC, int qt, int d, int b, int head, int j0, const h16* P, int ldp) {
    const int part = __builtin_amdgcn_readfirstlane(qt / K);
    const h16* row0 = P + (size_t)scan_row(d, b, j0) * ldp; const ptrdiff_t rstep = d == 0 ? (ptrdiff_t)ldp : -(ptrdiff_t)ldp;
    if (part < 2 && (part == 1 || phaseC)) {
        const int k = qt & (K - 1);
        if (IS_HG) {
            const h16* pf = row0 + 1024 + d * 512 + head * 128 + k;
#pragma unroll
            for (int t = 0; t < 16; ++t) R.fa[t >> 1][t & 1] = pf[t * rstep];
            if (part == 0) { const h16* px = row0 + head * 128 + k;
#pragma unroll
                for (int t = 0; t < 16; ++t) R.xa[t >> 1][t & 1] = px[t * rstep]; }
        } else {
            const h16* px = row0 + (part == 0 ? 0 : 256) + head * 64 + k;
#pragma unroll
            for (int t = 0; t < 16; ++t) R.xa[t >> 1][t & 1] = px[t * rstep];
            R.gr = *(const h16x4*)(row0 + (qt & 15) * rstep + 1536 + d * 16 + 4 * ((qt >> 4) & 3));
        }
    }
    { const int v = qt & 127, th = __builtin_amdgcn_readfirstlane(qt >> 7);
      const h16* pv = row0 + (ptrdiff_t)(8 * th) * rstep + 512 + head * 128 + v;
#pragma unroll
      for (int t = 0; t < 8; ++t) R.va[t >> 1][t & 1] = pv[t * rstep]; }
}
template <int K, bool IS_HG>
__device__ __forceinline__ void gl_math(const GlRaw& R, LAS unsigned char* buf, bool phaseC, int qt, int d, int b, int j0, const h16* P, int ldp, float c0, const h16x4 (&w2f)[4], LAS float* zs, float& dprod, h16* qeb = nullptr, int qecol = 0, int qeld = 0) {
    const int part = __builtin_amdgcn_readfirstlane(qt / K);
    if (part < 2) {
        const int k = qt & (K - 1);
        if (part == 1 || phaseC) {
            float run = IS_HG ? 1.f : 0.f;
            f32x4 zq[4];
            if (!IS_HG) {
                const int li = qt & 15, lh = (qt >> 4) & 3;
#pragma unroll
                for (int nt = 0; nt < 4; ++nt) { const f32x4 zt = mfma16s(R.gr, w2f[nt], (f32x4){0.f, 0.f, 0.f, 0.f}); *(LAS f32x4*)(zs + (16 * nt + li) * 20 + 4 * lh) = zt; }
                LDS_WAIT();
#pragma unroll
                for (int q = 0; q < 4; ++q) zq[q] = *(LAS const f32x4*)(zs + k * 20 + 4 * q);
            }
            if (part == 0) {
                float E[16], xv[16];
#pragma unroll
                for (int t = 0; t < 16; ++t) {
                    if (IS_HG) { const float f = c0 + (1.f - c0) * sigm_fast((float)R.fa[t >> 1][t & 1]); const float xa_ = (float)R.xa[t >> 1][t & 1];
                        run *= f; E[t] = run; xv[t] = xa_ * sigm_fast(xa_) * 0.08838834764831845f; }
                    else { const float z = c0 + zq[t >> 2][t & 3]; run += -softplus(-z) * (1.f / 16.f); E[t] = __expf(run); xv[t] = (float)R.xa[t >> 1][t & 1] * 0.125f; }
                }
                const float rm = rcpf_(E[7]), El = E[15];
                h16* qp = qeb ? qeb + (size_t)scan_row(d, b, j0) * qeld + qecol + k : nullptr; const ptrdiff_t qstep = d == 0 ? (ptrdiff_t)qeld : -(ptrdiff_t)qeld;
#pragma unroll
                for (int t = 0; t < 16; ++t) { const float q = xv[t] * E[t];
                    *(LAS unsigned short*)(buf + GQ_QT + t * GQ_ROW + k * 2) = f2h(q);
                    *(LAS unsigned short*)(buf + GQ_QH + t * GQ_ROW + k * 2) = f2bf(q * rm);
                    if (qeb) qp[t * qstep] = (h16)(q * dprod); }
                if (qeb) dprod *= El;
            } else {
                float D[16], xv[16];
                if (IS_HG) {
                    float fv[16];
#pragma unroll
                    for (int t = 0; t < 16; ++t) { fv[t] = c0 + (1.f - c0) * sigm_fast((float)R.fa[t >> 1][t & 1]); xv[t] = 1.f - fv[t]; }
                    float bw = 1.f;
#pragma unroll
                    for (int t = 15; t >= 0; --t) { D[t] = bw; bw *= fv[t]; }
                    run = bw;
                } else {
                    float rn[16];
#pragma unroll
                    for (int t = 0; t < 16; ++t) { const float z = c0 + zq[t >> 2][t & 3]; run += -softplus(-z) * (1.f / 16.f); rn[t] = run; xv[t] = (float)R.xa[t >> 1][t & 1]; }
#pragma unroll
                    for (int t = 0; t < 16; ++t) D[t] = __expf(rn[15] - rn[t]);
                    run = __expf(rn[15]);
                }
                const float El = run, rd7 = rcpf_(D[7]);
                float kd[16];
#pragma unroll
                for (int t = 0; t < 16; ++t) kd[t] = xv[t] * D[t];
                unsigned kp[8];
#pragma unroll
                for (int t = 0; t < 16; t += 2) kp[t >> 1] = pk_h16(kd[t], kd[t + 1]);
                *(LAS u32x4*)(buf + GQ_KP + k * 32) = (u32x4){kp[0], kp[1], kp[2], kp[3]}; *(LAS u32x4*)(buf + GQ_KP + k * 32 + 16) = (u32x4){kp[4], kp[5], kp[6], kp[7]};
                if (phaseC) {
#pragma unroll
                    for (int t = 0; t < 16; ++t) *(LAS unsigned short*)(buf + GQ_KH + t * GQ_ROW + k * 2) = f2bf(kd[t] * rd7);
                }
                *(LAS float*)(buf + GQ_DV + k * 4) = El; dprod *= El;
            }
        }
    }
    { const int v = qt & 127, th = __builtin_amdgcn_readfirstlane(qt >> 7);
      *(LAS u32x4*)(buf + GQ_VT + v * 32 + th * 16) = (u32x4){__builtin_bit_cast(unsigned, R.va[0]), __builtin_bit_cast(unsigned, R.va[1]), __builtin_bit_cast(unsigned, R.va[2]), __builtin_bit_cast(unsigned, R.va[3])}; }
}

template <int K, bool IS_HG>
__device__ __forceinline__ void gl_quad(Frame& F, bool phaseC, int sc, int stream, const h16* P, int ldp, float* ST, float* DD, h16* odir, bool local = false, h16* qebase = nullptr, int qeld = 0) {
    const int quad = F.wave >> 2, w4 = F.wave & 3, qt = ((F.tid & 255) + (quad << 7)) & 255, lane = F.lane, i = lane & 15, h = lane >> 4;
    const int d = stream >> 4, b = (stream >> 2) & 3, head = stream & 3;
    LAS unsigned char* QB = F.lds + quad * (2 * GQ_BUF);
    constexpr int NKT = K / 16;
    f32x4 Sacc[NKT][2];
    if (phaseC && sc > 0 && !local) {
        const float* st = ST + ((size_t)(sc - 1) * 32 + stream) * K * 128;
#pragma unroll
        for (int kt = 0; kt < NKT; ++kt)
#pragma unroll
            for (int vt = 0; vt < 2; ++vt)
#pragma unroll
                for (int r = 0; r < 4; ++r) Sacc[kt][vt][r] = st[(16 * kt + 4 * h + r) * 128 + 32 * w4 + 16 * vt + i];
    } else {
#pragma unroll
        for (int kt = 0; kt < NKT; ++kt) { Sacc[kt][0] = (f32x4){0.f, 0.f, 0.f, 0.f}; Sacc[kt][1] = (f32x4){0.f, 0.f, 0.f, 0.f}; }
    }
    float c0 = 0.f; h16x4 w2f[4];
#pragma unroll
    for (int j = 0; j < 4; ++j) w2f[j] = (h16x4){(h16)0.f, (h16)0.f, (h16)0.f, (h16)0.f};
    LAS float* zs = (LAS float*)(F.lds + 90112 + (quad * 2 + (w4 & 1)) * 5120);
    if (qt < 2 * K) { const int k = qt & (K - 1);
        if (IS_HG) { const float* lb = F.in[I_HGLB]; c0 = sigm(lb[d * 512 + head * 128 + k] - lb[1024 + d * 512 + head * 128 + k]); }
        else { c0 = F.in[I_GLAB][d * 256 + head * 64 + k];
#pragma unroll
            for (int nt = 0; nt < 4; ++nt)
#pragma unroll
                for (int jj = 0; jj < 4; ++jj) w2f[nt][jj] = (h16)F.in[I_GLAW2][(d * 16 + 4 * h + jj) * 256 + head * 64 + 16 * nt + i]; } }
    float dprod = 1.f;
    constexpr int NCH = SCL / 16;
    const int jbase = sc * SCL;
    h16* qeb = (local && sc > 0) ? qebase : nullptr; const int qecol = d * (4 * K) + head * K;
    __syncthreads();
    GlRaw R0, R1;
    if (!phaseC && GLA2) {
        constexpr int NP = (NCH + 1) / 2;
        gl_load<K, IS_HG>(R0, false, qt, d, b, head, jbase, P, ldp);
        gl_load<K, IS_HG>(R1, false, qt, d, b, head, jbase + 16, P, ldp);
        gl_math<K, IS_HG>(R0, QB, false, qt, d, b, jbase, P, ldp, c0, w2f, zs, dprod);
        gl_math<K, IS_HG>(R1, QB - GQ_KP, false, qt, d, b, jbase + 16, P, ldp, c0, w2f, zs, dprod);
        if (NP > 1) { gl_load<K, IS_HG>(R0, false, qt, d, b, head, jbase + 32, P, ldp); if (3 < NCH) gl_load<K, IS_HG>(R1, false, qt, d, b, head, jbase + 48, P, ldp); }
        __syncthreads();
#pragma unroll 1
        for (int p = 0; p < NP; ++p) {
            const int c1 = 2 * (p + 1);
            LAS unsigned char* nb = QB + ((p + 1) & 1) * GQ_BUF;
            if (c1 < NCH) gl_math<K, IS_HG>(R0, nb, false, qt, d, b, jbase + 16 * c1, P, ldp, c0, w2f, zs, dprod);
            if (c1 + 1 < NCH) gl_math<K, IS_HG>(R1, nb - GQ_KP, false, qt, d, b, jbase + 16 * (c1 + 1), P, ldp, c0, w2f, zs, dprod);
            if (c1 + 2 < NCH) gl_load<K, IS_HG>(R0, false, qt, d, b, head, jbase + 16 * (c1 + 2), P, ldp);
            if (c1 + 3 < NCH) gl_load<K, IS_HG>(R1, false, qt, d, b, head, jbase + 16 * (c1 + 3), P, ldp);
#pragma unroll
            for (int q = 0; q < 2; ++q) {
                if (2 * p + q < NCH) {
                    LAS const unsigned char* buf = QB + (p & 1) * GQ_BUF - q * GQ_KP;
                    h16x4 vf[2];
#pragma unroll
                    for (int vt = 0; vt < 2; ++vt) vf[vt] = *(LAS const h16x4*)(buf + GQ_VT + (32 * w4 + 16 * vt + i) * 32 + h * 8);
#pragma unroll
                    for (int kt = 0; kt < NKT; ++kt) {
                        const f32x4 dv = *(LAS const f32x4*)(buf + GQ_DV + (16 * kt + 4 * h) * 4); const h16x4 kp = *(LAS const h16x4*)(buf + GQ_KP + (16 * kt + i) * 32 + h * 8);
#pragma unroll
                        for (int vt = 0; vt < 2; ++vt) Sacc[kt][vt] = mfma16s(kp, vf[vt], dv * Sacc[kt][vt]);
                    }
                }
            }
            LDS_BARRIER();
        }
        float* st = ST + ((size_t)sc * 32 + stream) * K * 128;
#pragma unroll
        for (int kt = 0; kt < NKT; ++kt)
#pragma unroll
            for (int vt = 0; vt < 2; ++vt)
#pragma unroll
                for (int r = 0; r < 4; ++r) st[(16 * kt + 4 * h + r) * 128 + 32 * w4 + 16 * vt + i] = Sacc[kt][vt][r];
        if (qt >= K && qt < 2 * K) DD[((size_t)sc * 32 + stream) * K + (qt & (K - 1))] = dprod;
        return;
    }
    gl_load<K, IS_HG>(R0, phaseC, qt, d, b, head, jbase, P, ldp);
    gl_load<K, IS_HG>(R1, phaseC, qt, d, b, head, jbase + 16, P, ldp);
    gl_math<K, IS_HG>(R0, QB, phaseC, qt, d, b, jbase, P, ldp, c0, w2f, zs, dprod, qeb, qecol, qeld);
    __syncthreads();
    auto chunk_iter = [&](const int c, GlRaw& RL, GlRaw& RM) {
        if (c + 2 < NCH) gl_load<K, IS_HG>(RL, phaseC, qt, d, b, head, jbase + 16 * (c + 2), P, ldp);
        if (c + 1 < NCH) gl_math<K, IS_HG>(RM, QB + ((c + 1) & 1) * GQ_BUF, phaseC, qt, d, b, jbase + 16 * (c + 1), P, ldp, c0, w2f, zs, dprod, qeb, qecol, qeld);
        LAS const unsigned char* buf = QB + (c & 1) * GQ_BUF;
        h16x4 vf[2];
#pragma unroll
        for (int vt = 0; vt < 2; ++vt) vf[vt] = *(LAS const h16x4*)(buf + GQ_VT + (32 * w4 + 16 * vt + i) * 32 + h * 8);
        if (phaseC) {
            f32x4 pm = (f32x4){0.f, 0.f, 0.f, 0.f};
#pragma unroll
            for (int ks = 0; ks < K / 32; ++ks) {
                const b16x8 ka = *(LAS const b16x8*)(buf + GQ_KH + i * GQ_ROW + (32 * ks + 8 * h) * 2), qb = *(LAS const b16x8*)(buf + GQ_QH + i * GQ_ROW + (32 * ks + 8 * h) * 2);
                pm = __builtin_amdgcn_mfma_f32_16x16x32_bf16(ka, qb, pm, 0, 0, 0);
            }
            h16x4 af;
#pragma unroll
            for (int r = 0; r < 4; ++r) af[r] = (4 * h + r <= i) ? (h16)pm[r] : (h16)0.f;
            f32x4 o[2];
#pragma unroll
            for (int vt = 0; vt < 2; ++vt) o[vt] = mfma16s(af, vf[vt], (f32x4){0.f, 0.f, 0.f, 0.f});
#pragma unroll
            for (int ks = 0; ks < K / 32; ++ks) {
                const h16x4 q0 = *(LAS const h16x4*)(buf + GQ_QT + i * GQ_ROW + (32 * ks + 4 * h) * 2), q1 = *(LAS const h16x4*)(buf + GQ_QT + i * GQ_ROW + (32 * ks + 16 + 4 * h) * 2);
                const h16x8 qa = {q0[0], q0[1], q0[2], q0[3], q1[0], q1[1], q1[2], q1[3]};
#pragma unroll
                for (int vt = 0; vt < 2; ++vt) { const f32x4 s0 = Sacc[2 * ks][vt], s1 = Sacc[2 * ks + 1][vt];
                    const h16x8 sb = {(h16)s0[0], (h16)s0[1], (h16)s0[2], (h16)s0[3], (h16)s1[0], (h16)s1[1], (h16)s1[2], (h16)s1[3]};
                    o[vt] = __builtin_amdgcn_mfma_f32_16x16x32_f16(qa, sb, o[vt], 0, 0, 0); }
            }
#pragma unroll
            for (int r = 0; r < 4; ++r) { h16* orow = odir + (size_t)scan_row(d, b, jbase + 16 * c + 4 * h + r) * DM + head * 128 + 32 * w4 + i;
                orow[0] = (h16)o[0][r]; orow[16] = (h16)o[1][r]; }
        }
#pragma unroll
        for (int kt = 0; kt < NKT; ++kt) {
            const f32x4 dv = *(LAS const f32x4*)(buf + GQ_DV + (16 * kt + 4 * h) * 4); const h16x4 kp = *(LAS const h16x4*)(buf + GQ_KP + (16 * kt + i) * 32 + h * 8);
#pragma unroll
            for (int vt = 0; vt < 2; ++vt) Sacc[kt][vt] = mfma16s(kp, vf[vt], dv * Sacc[kt][vt]);
        }
        LDS_BARRIER();
    };
#pragma unroll 1
    for (int c = 0; c < NCH; c += 2) { chunk_iter(c, R0, R1); if (c + 1 < NCH) chunk_iter(c + 1, R1, R0); }
    if (!phaseC || (local && sc < NSC - 1)) {
        float* st = ST + ((size_t)sc * 32 + stream) * K * 128;
#pragma unroll
        for (int kt = 0; kt < NKT; ++kt)
#pragma unroll
            for (int vt = 0; vt < 2; ++vt)
#pragma unroll
                for (int r = 0; r < 4; ++r) st[(16 * kt + 4 * h + r) * 128 + 32 * w4 + 16 * vt + i] = Sacc[kt][vt][r];
        if (qt >= K && qt < 2 * K) DD[((size_t)sc * 32 + stream) * K + (qt & (K - 1))] = dprod;
    }
}
template <int K, bool IS_HG>
__device__ __forceinline__ void ph_glquads(Frame& F, bool phaseC, const h16* P, int ldp, float* ST, float* DD, h16* ofwd, h16* obwd, bool local = false, h16* qebase = nullptr, int qeld = 0) {
    const int nunits = phaseC ? NSC * 32 : (NSC - 1) * 32, nq = F.G * 2, gq = blockIdx.x * 2 + (F.wave >> 2);
    for (int base = 0; base < nunits; base += nq) {
        int unit = base + gq; if (unit >= nunits) unit %= nunits;
        const int sc = unit / 32, stream = unit % 32;
        gl_quad<K, IS_HG>(F, phaseC, sc, stream, P, ldp, ST, DD, (stream >> 4) == 0 ? ofwd : obwd, local, qebase, qeld);
    }
    __syncthreads();
}


template <int K>
__device__ __forceinline__ void ph_glcorr(Frame& F, const float* ST, const h16* qebase, int qeld, h16* ofwd, h16* obwd) {
    const int lane = F.lane, i = lane & 15, h = lane >> 4;
    constexpr int NKS = K / 32, NCH = SCL / 16;
    for (int unit = F.gw; unit < (NSC - 1) * 32 * 4; unit += F.ngw) {
        const int w4 = unit & 3, stream = (unit >> 2) & 31, sc = 1 + (unit >> 7);
        const int d = stream >> 4, b = (stream >> 2) & 3, head = stream & 3;
        h16* odir = d == 0 ? ofwd : obwd;
        const float* st = ST + ((size_t)(sc - 1) * 32 + stream) * K * 128 + 32 * w4;
        h16x8 sa[NKS][2];
#pragma unroll
        for (int ks = 0; ks < NKS; ++ks)
#pragma unroll
            for (int vt = 0; vt < 2; ++vt)
#pragma unroll
                for (int jj = 0; jj < 8; ++jj) sa[ks][vt][jj] = (h16)st[(size_t)(32 * ks + 8 * h + jj) * 128 + 16 * vt + i];
        const int qecol = d * (4 * K) + head * K + 8 * h, jbase = sc * SCL;
        h16x8 qf[NKS]; u32x2 ov[2];
        { const size_t u = scan_row(d, b, jbase + i);
#pragma unroll
          for (int ks = 0; ks < NKS; ++ks) qf[ks] = *(const h16x8*)(qebase + u * qeld + qecol + 32 * ks);
#pragma unroll
          for (int vt = 0; vt < 2; ++vt) ov[vt] = *(const u32x2*)(odir + u * DM + head * 128 + 32 * w4 + 16 * vt + 4 * h); }
#pragma unroll 1
        for (int c = 0; c < NCH; ++c) {
            const size_t u = scan_row(d, b, jbase + 16 * c + i), un = scan_row(d, b, jbase + 16 * (c + 1 < NCH ? c + 1 : c) + i);
            f32x4 o[2] = {(f32x4){0.f, 0.f, 0.f, 0.f}, (f32x4){0.f, 0.f, 0.f, 0.f}};
#pragma unroll
            for (int ks = 0; ks < NKS; ++ks) {
                o[0] = __builtin_amdgcn_mfma_f32_16x16x32_f16(sa[ks][0], qf[ks], o[0], 0, 0, 0); o[1] = __builtin_amdgcn_mfma_f32_16x16x32_f16(sa[ks][1], qf[ks], o[1], 0, 0, 0);
                qf[ks] = *(const h16x8*)(qebase + un * qeld + qecol + 32 * ks);
            }
#pragma unroll
            for (int vt = 0; vt < 2; ++vt) { const h16x4 old = __builtin_bit_cast(h16x4, ov[vt]);
                h16* op = odir + u * DM + head * 128 + 32 * w4 + 16 * vt + 4 * h;
                *(u32x2*)op = (u32x2){pk_h16((float)old[0] + o[vt][0], (float)old[1] + o[vt][1]), pk_h16((float)old[2] + o[vt][2], (float)old[3] + o[vt][3])};
                ov[vt] = *(const u32x2*)(odir + un * DM + head * 128 + 32 * w4 + 16 * vt + 4 * h); }
        }
    }
}

constexpr int RQ_AT = 0, RQ_RT = 2304, RQ_AH = 4608, RQ_RH = 6912, RQ_BH = 9216, RQ_KH = 11520, RQ_BP = 13824, RQ_KP = 15872, RQ_VT = 17920, RQ_DV = 19968, RQ_TM = 20224, RQ_MK = 20736, RQ_MB = 21248, RQ_MR = 21760, RQ_BUF = 22272, RQ_ROW = 144;
constexpr int RQ_LWF = 65536;
constexpr int RQ_SCR = 2 * RQ_BUF, RS_RR = 0, RS_RK = 4096, RS_TW = 8192, RS_TA = 10496, RS_MAB = 12800, RS_RV = 13824, RS_END = 17920;

template <bool PA, bool LOC = false>
__device__ __forceinline__ void rw_chunk_unit(Frame& F, int sc, int stream, const h16* P, float* STR, float* BSP, h16* odir, bool cmp = false, int cmpmode = 1, h16* rho = nullptr) {
    constexpr bool OUT = !PA || LOC;
    const int lane = F.lane, i = lane & 15, h = lane >> 4, w = F.wave & 3;
    const bool producer = F.wave >= 4;
    const int d = stream >> 5, b = (stream >> 3) & 3, head = stream & 7;
    LAS unsigned char* L = F.lds;
    LAS unsigned char* SCR = F.lds + RQ_SCR;
    constexpr int NVT = PA ? 2 : 1;
    constexpr int NCH = SCL / 16;
    const int jbase = sc * SCL;
    const int pt = F.tid & 255, pc = pt & 63, tq = pt >> 6;
    const int cown = 16 * w + i;
    float m0R = 0, m1R = 0, m0K = 0, m1K = 0, m0V = 0, m1V = 0, m0W = 0, m1W = 0, m0A = 0, m1A = 0, kkq[4] = {0, 0, 0, 0}, kac = 0, rkc = 0, w0c = 0, a0c = 0;
    h16x8 w2f[2], a2f[2];
    const int cR = head * 64 + pc, cK = 512 + head * 64 + pc, cV = 1024 + head * 64 + pc, cW = 1536 + d * 64 + pc, cA = 1664 + d * 64 + pc;
    if (producer) {
        const float* mu = F.in[I_RWMU];
        m0R = mu[cR]; m1R = mu[1920 + cR]; m0K = mu[cK]; m1K = mu[1920 + cK]; m0V = mu[cV]; m1V = mu[1920 + cV]; m0W = mu[cW]; m1W = mu[1920 + cW]; m0A = mu[cA]; m1A = mu[1920 + cA];
#pragma unroll
        for (int q = 0; q < 4; ++q) kkq[q] = F.in[I_RWKK][head * 64 + 16 * q + i];
        kac = F.in[I_RWKA][head * 64 + cown]; rkc = F.in[I_RWRK][head * 64 + cown]; w0c = F.in[I_RWW0][d * 512 + head * 64 + cown]; a0c = F.in[I_RWA0][d * 512 + head * 64 + cown];
        const float* w2 = F.in[I_RWW2] + (size_t)d * 64 * 512 + head * 64 + cown; const float* a2 = F.in[I_RWA2] + (size_t)d * 64 * 512 + head * 64 + cown;
#pragma unroll
        for (int ks = 0; ks < 2; ++ks)
#pragma unroll
            for (int jj = 0; jj < 8; ++jj) { w2f[ks][jj] = (h16)w2[(size_t)(32 * ks + 8 * h + jj) * 512]; a2f[ks][jj] = (h16)a2[(size_t)(32 * ks + 8 * h + jj) * 512]; }
#pragma unroll
        for (int ks = 0; ks < 2; ++ks) { *(LAS h16x8*)(L + RQ_LWF + ((w * 4 + ks) * 64 + lane) * 16) = w2f[ks]; *(LAS h16x8*)(L + RQ_LWF + ((w * 4 + 2 + ks) * 64 + lane) * 16) = a2f[ks]; }
    }
    f32x4 Sacc[4][NVT];
    if (!producer) {
#pragma unroll
        for (int kt = 0; kt < 4; ++kt)
#pragma unroll
            for (int vt = 0; vt < NVT; ++vt)
#pragma unroll
                for (int r = 0; r < 4; ++r) {
                    const int k = 16 * kt + 4 * h + r; float x = 0.f;
                    if (PA) { if (w >= 2) x = (k == 32 * (w - 2) + 16 * vt + i) ? 1.f : 0.f; }
                    else if (sc > 0) x = STR[(((size_t)(sc - 1) * 64 + stream) * 2) * 4096 + (16 * w + i) * 64 + k];
                    Sacc[kt][vt][r] = x; }
    }
    h16x4 praw_[5][3];
#define PR_SET(qn, j, val) praw_[qn][j] = (val)
#define PR_GET(qn, j) praw_[qn][j]
    if (producer && (!PA || RWPF)) {
        const int pt = w * 64 + lane, t = pt >> 4, cg = pt & 15;
        const int u = scan_row(d, b, jbase + t), s_ = u % TT;
        const bool hp = (s_ != 0 && s_ != CTXL), hn = (s_ != CTXL - 1 && s_ != TT - 1);
        const h16* pcur = P + (size_t)u * P0LD + 2560; const h16* pp = hp ? pcur - P0LD : pcur; const h16* pn = hn ? pcur + P0LD : pcur;
#pragma unroll
        for (int qn = 0; qn < 5; ++qn) {
            const int col = (qn < 3 ? 512 * qn + head * 64 : (qn == 3 ? 1536 : 1664) + d * 64) + 4 * cg;
            PR_SET(qn, 0, *(const h16x4*)(pcur + col)); PR_SET(qn, 1, *(const h16x4*)(pp + col)); PR_SET(qn, 2, *(const h16x4*)(pn + col));
        }
    }
    __syncthreads();
#if RWZERO
    for (int z_ = F.tid; z_ < (RQ_SCR + RS_END) / 4; z_ += NTHR) ((LAS unsigned*)L)[z_] = 0u;
    __syncthreads();
#endif
#pragma unroll 1
    for (int c = -1; c < NCH; ++c) {
        const int cn = c + 1;
        LAS unsigned char* PB = L + (cn & 1) * RQ_BUF;
        int ln_ = F.lane; asm volatile("" : "+v"(ln_));
        const int i = ln_ & 15, h = ln_ >> 4, cown = 16 * w + i, pc = ln_, tq = w;
        if (!producer && c >= 0) {
            LAS const unsigned char* CB = L + (c & 1) * RQ_BUF;
            const f32x4 z4 = (f32x4){0.f, 0.f, 0.f, 0.f};
            const h16x4 makf = *(LAS const h16x4*)(CB + RQ_MK + i * 32 + h * 8);
            h16x4 mrbf, mrkf;
            if (OUT) { mrbf = *(LAS const h16x4*)(CB + RQ_MB + i * 32 + h * 8); mrkf = *(LAS const h16x4*)(CB + RQ_MR + i * 32 + h * 8); }
            const h16x4 tmf = *(LAS const h16x4*)(CB + RQ_TM + i * 32 + h * 8);
            h16x8 atf[2], rtf[2];
#pragma unroll
            for (int ks = 0; ks < 2; ++ks) {
                const h16x4 a0 = *(LAS const h16x4*)(CB + RQ_AT + i * RQ_ROW + (32 * ks + 4 * h) * 2), a1 = *(LAS const h16x4*)(CB + RQ_AT + i * RQ_ROW + (32 * ks + 16 + 4 * h) * 2);
                atf[ks] = (h16x8){a0[0], a0[1], a0[2], a0[3], a1[0], a1[1], a1[2], a1[3]};
                if (OUT) { const h16x4 r0 = *(LAS const h16x4*)(CB + RQ_RT + i * RQ_ROW + (32 * ks + 4 * h) * 2), r1 = *(LAS const h16x4*)(CB + RQ_RT + i * RQ_ROW + (32 * ks + 16 + 4 * h) * 2);
                    rtf[ks] = (h16x8){r0[0], r0[1], r0[2], r0[3], r1[0], r1[1], r1[2], r1[3]}; }
            }
#pragma unroll
            for (int vt = 0; vt < NVT; ++vt) {
                const bool inj = PA ? (w < 2) : true;
                const int vrow = PA ? (32 * w + 16 * vt + i) & 63 : 16 * w + i;
                h16x4 vtf = *(LAS const h16x4*)(CB + RQ_VT + vrow * 32 + h * 8);
                if (!inj) vtf = (h16x4){(h16)0.f, (h16)0.f, (h16)0.f, (h16)0.f};
                h16x8 sf[2];
#pragma unroll
                for (int ks = 0; ks < 2; ++ks) { const f32x4 s0 = Sacc[2 * ks][vt], s1 = Sacc[2 * ks + 1][vt];
                    sf[ks] = (h16x8){(h16)s0[0], (h16)s0[1], (h16)s0[2], (h16)s0[3], (h16)s1[0], (h16)s1[1], (h16)s1[2], (h16)s1[3]}; }
                f32x4 Z = mfma16s(makf, vtf, z4);
                Z = __builtin_amdgcn_mfma_f32_16x16x32_f16(atf[0], sf[0], Z, 0, 0, 0); Z = __builtin_amdgcn_mfma_f32_16x16x32_f16(atf[1], sf[1], Z, 0, 0, 0);
                const h16x4 zb = {(h16)Z[0], (h16)Z[1], (h16)Z[2], (h16)Z[3]};
                const f32x4 U = mfma16s(tmf, zb, z4);
                const h16x4 ub = {(h16)U[0], (h16)U[1], (h16)U[2], (h16)U[3]};
                if (OUT) {
                    f32x4 O = mfma16p(mrbf, ub, mrkf, vtf, z4);
                    O = __builtin_amdgcn_mfma_f32_16x16x32_f16(rtf[0], sf[0], O, 0, 0, 0); O = __builtin_amdgcn_mfma_f32_16x16x32_f16(rtf[1], sf[1], O, 0, 0, 0);
                    h16* obase; int ld;
                    if (!PA) { obase = odir + 512 + head * 64 + 16 * w + i; ld = DM; }
                    else if (w < 2) { obase = odir + 512 + head * 64 + 32 * w + 16 * vt + i; ld = DM; }
                    else { obase = rho + d * 512 + head * 64 + 32 * (w - 2) + 16 * vt + i; ld = 1024; }
#pragma unroll
                    for (int r = 0; r < 4; ++r) obase[(size_t)scan_row(d, b, jbase + 16 * c + 4 * h + r) * ld] = (h16)O[r];
                }
#pragma unroll
                for (int kt = 0; kt < 4; ++kt) {
                    const f32x4 dv = *(LAS const f32x4*)(CB + RQ_DV + (16 * kt + 4 * h) * 4);
                    const h16x4 bpf = *(LAS const h16x4*)(CB + RQ_BP + (16 * kt + i) * 32 + h * 8), kpf = *(LAS const h16x4*)(CB + RQ_KP + (16 * kt + i) * 32 + h * 8);
                    Sacc[kt][vt] = mfma16p(bpf, ub, kpf, vtf, dv * Sacc[kt][vt]);
                }
            }
        }
        if (producer) {
            const int pt = w * 64 + ln_, t = pt >> 4, cg = pt & 15;
            if (PA && !RWPF && cn < NCH) {
                const int u = scan_row(d, b, jbase + 16 * cn + t), s0_ = u % TT;
                const bool hp = (s0_ != 0 && s0_ != CTXL), hn = (s0_ != CTXL - 1 && s0_ != TT - 1);
                const h16* pcur = P + (size_t)u * P0LD + 2560; const h16* pp = hp ? pcur - P0LD : pcur; const h16* pn = hn ? pcur + P0LD : pcur;
#pragma unroll
                for (int qn = 0; qn < 5; ++qn) {
                    const int col = (qn < 3 ? 512 * qn + head * 64 : (qn == 3 ? 1536 : 1664) + d * 64) + 4 * cg;
                    PR_SET(qn, 0, *(const h16x4*)(pcur + col)); PR_SET(qn, 1, *(const h16x4*)(pp + col)); PR_SET(qn, 2, *(const h16x4*)(pn + col));
                }
            }
            if (cn < NCH) {
                const int s_ = scan_row(d, b, jbase + 16 * cn + t) % TT;
                const float fp_ = (s_ != 0 && s_ != CTXL) ? 1.f : 0.f, fn_ = (s_ != CTXL - 1 && s_ != TT - 1) ? 1.f : 0.f;
                const float* mu = F.in[I_RWMU];
                f32x4 sh[5];
#pragma unroll
                for (int qn = 0; qn < 5; ++qn) {
                    const int col = (qn < 3 ? 512 * qn + head * 64 : (qn == 3 ? 1536 : 1664) + d * 64) + 4 * cg;
                    const f32x4 m0 = *(const f32x4*)(mu + col), m1 = *(const f32x4*)(mu + 1920 + col);
                    const h16x4 r0_ = PR_GET(qn, 0), r1_ = PR_GET(qn, 1), r2_ = PR_GET(qn, 2);
#pragma unroll
                    for (int e = 0; e < 4; ++e) { const float x_ = (float)r0_[e]; sh[qn][e] = x_ + m0[e] * (fp_ * (float)r1_[e] - x_) + m1[e] * (fn_ * (float)r2_[e] - x_); }
                }
                *(LAS f32x4*)(SCR + RS_RR + (t * 64 + 4 * cg) * 4) = sh[0];
                *(LAS f32x4*)(SCR + RS_RK + (t * 64 + 4 * cg) * 4) = sh[1];
                *(LAS f32x4*)(SCR + RS_RV + (t * 64 + 4 * cg) * 4) = sh[2];
                float tw[4];
#pragma unroll
                for (int e = 0; e < 4; ++e) { const float ex = __expf(2.f * sh[3][e]); tw[e] = 1.f - 2.f * rcpf_(ex + 1.f); }
                *(LAS u32x2*)(SCR + RS_TW + t * RQ_ROW + 8 * cg) = (u32x2){pk_h16(tw[0], tw[1]), pk_h16(tw[2], tw[3])};
                *(LAS u32x2*)(SCR + RS_TA + t * RQ_ROW + 8 * cg) = (u32x2){pk_h16(sh[4][0], sh[4][1]), pk_h16(sh[4][2], sh[4][3])};
            }
            if ((!PA || RWPF) && cn + 1 < NCH) {
                const int u = scan_row(d, b, jbase + 16 * (cn + 1) + t), s_ = u % TT;
                const bool hp = (s_ != 0 && s_ != CTXL), hn = (s_ != CTXL - 1 && s_ != TT - 1);
                const h16* pcur = P + (size_t)u * P0LD + 2560; const h16* pp = hp ? pcur - P0LD : pcur; const h16* pn = hn ? pcur + P0LD : pcur;
#pragma unroll
                for (int qn = 0; qn < 5; ++qn) {
                    const int col = (qn < 3 ? 512 * qn + head * 64 : (qn == 3 ? 1536 : 1664) + d * 64) + 4 * cg;
                    PR_SET(qn, 0, *(const h16x4*)(pcur + col)); PR_SET(qn, 1, *(const h16x4*)(pp + col)); PR_SET(qn, 2, *(const h16x4*)(pn + col));
                }
            }
        }
        LDS_BARRIER();
        if (producer && cn < NCH) {
            f32x4 lw = (f32x4){0.f, 0.f, 0.f, 0.f}, la = (f32x4){0.f, 0.f, 0.f, 0.f};
#pragma unroll
            for (int ks = 0; ks < 2; ++ks) {
                const h16x8 twf = *(LAS const h16x8*)(SCR + RS_TW + i * RQ_ROW + (32 * ks + 8 * h) * 2), taf = *(LAS const h16x8*)(SCR + RS_TA + i * RQ_ROW + (32 * ks + 8 * h) * 2);
                const h16x8 w2k = *(LAS const h16x8*)(L + RQ_LWF + ((w * 4 + ks) * 64 + ln_) * 16), a2k = *(LAS const h16x8*)(L + RQ_LWF + ((w * 4 + 2 + ks) * 64 + ln_) * 16);
                lw = __builtin_amdgcn_mfma_f32_16x16x32_f16(twf, w2k, lw, 0, 0, 0); la = __builtin_amdgcn_mfma_f32_16x16x32_f16(taf, a2k, la, 0, 0, 0);
            }
            float lg[4], aa[4], bb[4], kd[4], rr[4];
#pragma unroll
            for (int r = 0; r < 4; ++r) {
                const int t = 4 * h + r;
                float ss = 0.f;
#pragma unroll
                for (int q = 0; q < 4; ++q) { const float x = *(LAS const float*)(SCR + RS_RK + (t * 64 + 16 * q + i) * 4) * kkq[q]; ss += x * x; }
                const float rn = rcpf_(fmaxf(__builtin_amdgcn_sqrtf(row_sum16(ss)), 1e-12f));
                const float kraw = *(LAS const float*)(SCR + RS_RK + (t * 64 + cown) * 4); rr[r] = *(LAS const float*)(SCR + RS_RR + (t * 64 + cown) * 4);
                const float kk = kraw * kkq[w] * rn;
                const float wlog = -softplus(-(w0c + lw[r])) - 0.5f; lg[r] = -__expf(wlog);
                const float asig = sigm_fast(a0c + la[r]); kd[r] = kraw * (1.f + (asig - 1.f) * kac); bb[r] = kk * asig; aa[r] = -kk;
            }
            float cw[4]; cw[0] = lg[0]; cw[1] = cw[0] + lg[1]; cw[2] = cw[1] + lg[2]; cw[3] = cw[2] + lg[3];
            const float g0 = __shfl(cw[3], i), g1 = __shfl(cw[3], i + 16), g2 = __shfl(cw[3], i + 32), g3 = __shfl(cw[3], i + 48);
            const float eh = (h > 0 ? g0 : 0.f) + (h > 1 ? g1 : 0.f) + (h > 2 ? g2 : 0.f);
#pragma unroll
            for (int r = 0; r < 4; ++r) cw[r] += eh;
            const float Wm = g0 + g1, W15 = g0 + g1 + g2 + g3;
            const float enm = __expf(-Wm), e15m = __expf(W15 - Wm);
            float bpv[4], kpv[4], vv4[4];
#pragma unroll
            for (int r = 0; r < 4; ++r) {
                const int t = 4 * h + r;
                const float ew = __expf(lg[r]), ec1 = __expf(cw[r] - lg[r]);
                const float ec = ec1 * ew, ech = ec * enm, rch = rcpf_(ech);
                const int o = t * RQ_ROW + cown * 2;
                *(LAS unsigned short*)(PB + RQ_AT + o) = f2h(aa[r] * ec1);
                *(LAS unsigned short*)(PB + RQ_AH + o) = f2h(aa[r] * ec1 * enm);
                *(LAS unsigned short*)(PB + RQ_BH + o) = f2h(bb[r] * rch);
                *(LAS unsigned short*)(PB + RQ_KH + o) = f2h(kd[r] * rch);
                if (OUT) { *(LAS unsigned short*)(PB + RQ_RT + o) = f2h(rr[r] * ec); *(LAS unsigned short*)(PB + RQ_RH + o) = f2h(rr[r] * ech); }
                const float e15 = e15m * rch; bpv[r] = bb[r] * e15; kpv[r] = kd[r] * e15;
                vv4[r] = *(LAS const float*)(SCR + RS_RV + (t * 64 + cown) * 4);
            }
            *(LAS u32x2*)(PB + RQ_BP + cown * 32 + h * 8) = (u32x2){pk_h16(bpv[0], bpv[1]), pk_h16(bpv[2], bpv[3])};
            *(LAS u32x2*)(PB + RQ_KP + cown * 32 + h * 8) = (u32x2){pk_h16(kpv[0], kpv[1]), pk_h16(kpv[2], kpv[3])};
            *(LAS u32x2*)(PB + RQ_VT + cown * 32 + h * 8) = (u32x2){pk_h16(vv4[0], vv4[1]), pk_h16(vv4[2], vv4[3])};
            if (h == 0) *(LAS float*)(PB + RQ_DV + cown * 4) = __expf(W15);
            if (OUT) {
#pragma unroll
                for (int r = 0; r < 4; ++r) { const float bs = row_sum16(rr[r] * kd[r] * rkc);
                    if (i == 0) BSP[(((size_t)d * MU + scan_row(d, b, jbase + 16 * cn + 4 * h + r)) * 8 + head) * 4 + w] = bs; }
            }
        }
        LDS_BARRIER();
        if (producer && cn < NCH) {
            h16x8 fa[2], fb[2];
            const int ta = (w == 0 || w == 2) ? RQ_AH : (w == 1 ? RQ_KH : RQ_KH), tb = (w == 0) ? RQ_BH : (w == 1 ? RQ_AH : RQ_RH);
            const int ra = (w == 2) ? RQ_BH : ta;
#pragma unroll
            for (int ks = 0; ks < 2; ++ks) { const int o = i * RQ_ROW + (32 * ks + 8 * h) * 2; fa[ks] = *(LAS const h16x8*)(PB + ra + o); fb[ks] = *(LAS const h16x8*)(PB + tb + o); }
            const f32x4 z4 = (f32x4){0.f, 0.f, 0.f, 0.f};
            if (w != 0) {
                if (w == 1 || OUT) {
                    f32x4 p = __builtin_amdgcn_mfma_f32_16x16x32_f16(fa[0], fb[0], z4, 0, 0, 0); p = __builtin_amdgcn_mfma_f32_16x16x32_f16(fa[1], fb[1], p, 0, 0, 0);
                    float q[4];
#pragma unroll
                    for (int r = 0; r < 4; ++r) q[r] = (w == 1 ? (4 * h + r < i) : (4 * h + r <= i)) ? p[r] : 0.f;
                    *(LAS u32x2*)(PB + (w == 1 ? RQ_MK : (w == 2 ? RQ_MB : RQ_MR)) + i * 32 + h * 8) = (u32x2){pk_h16(q[0], q[1]), pk_h16(q[2], q[3])};
                }
            } else {
                f32x4 m = __builtin_amdgcn_mfma_f32_16x16x32_f16(fa[0], fb[0], z4, 0, 0, 0); m = __builtin_amdgcn_mfma_f32_16x16x32_f16(fa[1], fb[1], m, 0, 0, 0);
                f32x4 mt = __builtin_amdgcn_mfma_f32_16x16x32_f16(fb[0], fa[0], z4, 0, 0, 0); mt = __builtin_amdgcn_mfma_f32_16x16x32_f16(fb[1], fa[1], mt, 0, 0, 0);
#pragma unroll
                for (int r = 0; r < 4; ++r) { m[r] = (i < 4 * h + r) ? m[r] : 0.f; mt[r] = (4 * h + r < i) ? mt[r] : 0.f; }
#define CV4(x) ((h16x4){(h16)(x)[0], (h16)(x)[1], (h16)(x)[2], (h16)(x)[3]})
                const h16x4 m1 = CV4(m), m1t = CV4(mt);
                const f32x4 p2 = mfma16s(m1t, m1, z4), p2t = mfma16s(m1, m1t, z4);
                f32x4 tt = mt;
#pragma unroll
                for (int r = 0; r < 4; ++r) tt[r] += (4 * h + r == i) ? 1.f : 0.f;
                const h16x4 h2 = CV4(p2), h2t = CV4(p2t);
                tt = mfma16s(h2, CV4(tt), tt);
                const f32x4 p4 = mfma16s(h2t, h2, z4), p4t = mfma16s(h2, h2t, z4);
                const h16x4 h4 = CV4(p4), h4t = CV4(p4t);
                tt = mfma16s(h4, CV4(tt), tt);
                const f32x4 p8 = mfma16s(h4t, h4, z4);
                tt = mfma16s(CV4(p8), CV4(tt), tt);
#undef CV4
                *(LAS u32x2*)(PB + RQ_TM + i * 32 + h * 8) = (u32x2){pk_h16(tt[0], tt[1]), pk_h16(tt[2], tt[3])};
            }
        }
        LDS_BARRIER();
    }
    if (PA && !producer && (!LOC || sc < NSC - 1)) {
        float* st = STR + (((size_t)sc * 64 + stream) * 2) * 4096;
        int lo_ = lane; asm volatile("" : "+v"(lo_));
        const int io = lo_ & 15, ho = lo_ >> 4;
#pragma unroll
        for (int kt = 0; kt < 4; ++kt)
#pragma unroll
            for (int vt = 0; vt < NVT; ++vt) { const int vp = 32 * w + 16 * vt + io;
                f32x4* dst = (f32x4*)(st + (vp >> 6) * 4096 + (vp & 63) * 64 + 16 * kt + 4 * ho);
                if (cmp && (cmpmode == 1 || vp >= 64)) { const f32x4 old = *dst; const f32x4 nw = Sacc[kt][vt];
                    if (__float_as_uint(old[0]) != __float_as_uint(nw[0]) || __float_as_uint(old[1]) != __float_as_uint(nw[1]) || __float_as_uint(old[2]) != __float_as_uint(nw[2]) || __float_as_uint(old[3]) != __float_as_uint(nw[3]))
                        atomicOr((unsigned*)(F.ws + WS_CTL), 1u); }
                else if (!cmp) *dst = Sacc[kt][vt]; }
    }
}
__device__ __forceinline__ void ph_rwlatecheck(Frame& F, const h16* P, float* STR) {
    for (int unit = blockIdx.x; unit < (NSC - 1) * 64; unit += F.G) rw_chunk_unit<true>(F, unit / 64, unit % 64, P, STR, nullptr, nullptr, true, 2);
    __syncthreads();
}
template <bool PA, bool LOC = false>
__device__ __forceinline__ void ph_rwchunks(Frame& F, const h16* P, float* STR, float* BSP, h16* ofwd, h16* obwd, h16* rho = nullptr) {
    const int nunits = ((PA && !LOC) ? NSC - 1 : NSC) * 64;
    for (int unit = blockIdx.x; unit < nunits; unit += F.G) { const int sc = unit / 64, stream = unit % 64;
        rw_chunk_unit<PA, LOC>(F, sc, stream, P, STR, BSP, (stream >> 5) == 0 ? ofwd : obwd, false, 1, rho);
#if DETCHK == 1
        if (PA) { __threadfence(); __syncthreads(); rw_chunk_unit<PA>(F, sc, stream, P, STR, BSP, (stream >> 5) == 0 ? ofwd : obwd, true); }
#endif
    }
    __syncthreads();
}

__device__ __forceinline__ void ph_rwcorr(Frame& F, const float* STR, const h16* rho, h16* ofwd, h16* obwd) {
    const int lane = F.lane, i = lane & 15, h = lane >> 4;
    constexpr int NCH = SCL / 16;
    for (int unit = F.gw; unit < (NSC - 1) * 64 * 2; unit += F.ngw) {
        const int half = unit & 1, stream = (unit >> 1) & 63, sc = 1 + (unit >> 7);
        const int d = stream >> 5, b = (stream >> 3) & 3, head = stream & 7;
        h16* odir = d == 0 ? ofwd : obwd;
        const float* st = STR + (((size_t)(sc - 1) * 64 + stream) * 2) * 4096 + (size_t)(32 * half) * 64;
        h16x8 sa[2][2];
#pragma unroll
        for (int ks = 0; ks < 2; ++ks)
#pragma unroll
            for (int vt = 0; vt < 2; ++vt) { const f32x4 x0 = *(const f32x4*)(st + (16 * vt + i) * 64 + 32 * ks + 8 * h), x1 = *(const f32x4*)(st + (16 * vt + i) * 64 + 32 * ks + 8 * h + 4);
                sa[ks][vt] = (h16x8){(h16)x0[0], (h16)x0[1], (h16)x0[2], (h16)x0[3], (h16)x1[0], (h16)x1[1], (h16)x1[2], (h16)x1[3]}; }
        const int rcol = d * 512 + head * 64 + 8 * h, ocol = 512 + head * 64 + 32 * half + 4 * h, jbase = sc * SCL;
        h16x8 qf[2]; u32x2 ov[2];
        { const size_t u = scan_row(d, b, jbase + i);
#pragma unroll
          for (int ks = 0; ks < 2; ++ks) qf[ks] = *(const h16x8*)(rho + u * 1024 + rcol + 32 * ks);
#pragma unroll
          for (int vt = 0; vt < 2; ++vt) ov[vt] = *(const u32x2*)(odir + u * DM + ocol + 16 * vt); }
#pragma unroll 1
        for (int c = 0; c < NCH; ++c) {
            const size_t u = scan_row(d, b, jbase + 16 * c + i), un = scan_row(d, b, jbase + 16 * (c + 1 < NCH ? c + 1 : c) + i);
            f32x4 o[2] = {(f32x4){0.f, 0.f, 0.f, 0.f}, (f32x4){0.f, 0.f, 0.f, 0.f}};
#pragma unroll
            for (int ks = 0; ks < 2; ++ks) {
                o[0] = __builtin_amdgcn_mfma_f32_16x16x32_f16(sa[ks][0], qf[ks], o[0], 0, 0, 0); o[1] = __builtin_amdgcn_mfma_f32_16x16x32_f16(sa[ks][1], qf[ks], o[1], 0, 0, 0);
                qf[ks] = *(const h16x8*)(rho + un * 1024 + rcol + 32 * ks);
            }
#pragma unroll
            for (int vt = 0; vt < 2; ++vt) { const h16x4 old = __builtin_bit_cast(h16x4, ov[vt]);
                *(u32x2*)(odir + u * DM + ocol + 16 * vt) = (u32x2){pk_h16((float)old[0] + o[vt][0], (float)old[1] + o[vt][1]), pk_h16((float)old[2] + o[vt][2], (float)old[3] + o[vt][3])};
                ov[vt] = *(const u32x2*)(odir + un * DM + ocol + 16 * vt); }
        }
    }
}

template <bool PA>
__device__ __forceinline__ void rw_unit(Frame& F, int sc, int d, int b, int head, const h16* P, float* STR, float* BSC, h16* odir) {
    LAS float* L = (LAS float*)(F.lds + F.wave * 16384);
    LAS float* LW = L, *LA = L + 512, *LB = L + 1024, *LK = L + 1536, *LR = L + 2048, *LTW = L + 2560, *LTA = L + 3072, *LV = L + 3584;
    const int lane = F.lane, stream = (d * NB + b) * 8 + head, hc = head * 64 + lane;
    float S[64], Pm[PA ? 64 : 1];
    int ln_ = lane; asm volatile("" : "+v"(ln_));
    if (PA) {
#pragma unroll
        for (int k = 0; k < 64; ++k) { S[k] = 0.f; Pm[k] = (k == ln_) ? 1.f : 0.f; }
    } else if (sc > 0) {
        const float* st = STR + (((size_t)(sc - 1) * 64 + stream) * 2) * 4096 + lane * 64;
#pragma unroll
        for (int k4 = 0; k4 < 16; ++k4) { const f32x4 x = *(const f32x4*)(st + 4 * k4); S[4 * k4] = x.x; S[4 * k4 + 1] = x.y; S[4 * k4 + 2] = x.z; S[4 * k4 + 3] = x.w; }
    } else {
#pragma unroll
        for (int k = 0; k < 64; ++k) S[k] = 0.f;
    }
    const float* mu = F.in[I_RWMU];
    const int cR = hc, cK = 512 + hc, cV = 1024 + hc, cW = 1536 + d * 64 + lane, cA = 1664 + d * 64 + lane;
    const float m0R = mu[cR], m1R = mu[1920 + cR], m0K = mu[cK], m1K = mu[1920 + cK], m0V = mu[cV], m1V = mu[1920 + cV], m0W = mu[cW], m1W = mu[1920 + cW], m0A = mu[cA], m1A = mu[1920 + cA];
    const float kkc = F.in[I_RWKK][hc], kac = F.in[I_RWKA][hc], rkc = F.in[I_RWRK][hc], w0c = F.in[I_RWW0][d * 512 + hc], a0c = F.in[I_RWA0][d * 512 + hc];
    const float* w2 = F.in[I_RWW2] + (size_t)d * 64 * 512 + hc; const float* a2 = F.in[I_RWA2] + (size_t)d * 64 * 512 + hc;
    for (int tile = 0; tile < SCL / 8; ++tile) {
        const int j0 = sc * SCL + tile * 8;
#pragma unroll 1
        for (int t = 0; t < 8; ++t) {
            const int u = scan_row(d, b, j0 + t), s = u % TT;
            const bool hp = (s != 0 && s != CTXL), hn = (s != CTXL - 1 && s != TT - 1);
            const h16* pc = P + (size_t)u * P0LD + 2560; const h16* pp = pc - P0LD; const h16* pn = pc + P0LD;
#define RW_SH(col, m0, m1) ({ const float x_ = (float)pc[col]; const float xp_ = hp ? (float)pp[col] : 0.f; const float xn_ = hn ? (float)pn[col] : 0.f; x_ + (m0) * (xp_ - x_) + (m1) * (xn_ - x_); })
            LR[t * 64 + lane] = RW_SH(cR, m0R, m1R); LK[t * 64 + lane] = RW_SH(cK, m0K, m1K); LV[t * 64 + lane] = RW_SH(cV, m0V, m1V);
            LTW[lane * 8 + t] = tanh_(RW_SH(cW, m0W, m1W)); LTA[lane * 8 + t] = RW_SH(cA, m0A, m1A);
        }
        LDS_WAIT();
        float lw[8], la[8];
#pragma unroll
        for (int t = 0; t < 8; ++t) { lw[t] = 0.f; la[t] = 0.f; }
#pragma unroll 2
        for (int j = 0; j < 64; ++j) {
            const float wv = w2[(size_t)j * 512], av = a2[(size_t)j * 512];
            const f32x4 x0 = *(const LAS f32x4*)(LTW + j * 8), x1 = *(const LAS f32x4*)(LTW + j * 8 + 4), y0 = *(const LAS f32x4*)(LTA + j * 8), y1 = *(const LAS f32x4*)(LTA + j * 8 + 4);
            lw[0] += x0.x * wv; lw[1] += x0.y * wv; lw[2] += x0.z * wv; lw[3] += x0.w * wv; lw[4] += x1.x * wv; lw[5] += x1.y * wv; lw[6] += x1.z * wv; lw[7] += x1.w * wv;
            la[0] += y0.x * av; la[1] += y0.y * av; la[2] += y0.z * av; la[3] += y0.w * av; la[4] += y1.x * av; la[5] += y1.y * av; la[6] += y1.z * av; la[7] += y1.w * av;
        }
#pragma unroll
        for (int t = 0; t < 8; ++t) {
            const float kraw = LK[t * 64 + lane], rraw = LR[t * 64 + lane];
            const float kkr = kraw * kkc; const float nrm = sqrtf(wave_sum(kkr * kkr)); const float kk = kkr / fmaxf(nrm, 1e-12f);
            const float wlog = -softplus(-(w0c + lw[t])) - 0.5f; const float wdec = __expf(-__expf(wlog));
            const float asig = sigm(a0c + la[t]); const float kd = kraw * (1.f + (asig - 1.f) * kac);
            LW[t * 64 + lane] = wdec; LA[t * 64 + lane] = -kk; LB[t * 64 + lane] = kk * asig; LK[t * 64 + lane] = kd;
            if (!PA) { const float bs = wave_sum(rraw * kd * rkc); if (lane == 0) *(f32x4*)(BSC + (((size_t)d * MU + scan_row(d, b, j0 + t)) * 8 + head) * 4) = (f32x4){bs, 0.f, 0.f, 0.f}; }
        }
        LDS_WAIT();
#pragma unroll 1
        for (int t = 0; t < 8; ++t) {
            const float vv = LV[t * 64 + lane];
            float sa = 0.f, sp = 0.f;
#pragma unroll
            for (int k4 = 0; k4 < 16; ++k4) { const f32x4 a4 = *(const LAS f32x4*)(LA + t * 64 + 4 * k4);
#pragma unroll
                for (int e = 0; e < 4; ++e) { sa += S[4 * k4 + e] * a4[e]; if (PA) sp += Pm[4 * k4 + e] * a4[e]; } }
            float o = 0.f;
#pragma unroll
            for (int k4 = 0; k4 < 16; ++k4) {
                const f32x4 w4 = *(const LAS f32x4*)(LW + t * 64 + 4 * k4), b4 = *(const LAS f32x4*)(LB + t * 64 + 4 * k4), k4v = *(const LAS f32x4*)(LK + t * 64 + 4 * k4);
                f32x4 r4 = (f32x4){0.f, 0.f, 0.f, 0.f}; if (!PA) r4 = *(const LAS f32x4*)(LR + t * 64 + 4 * k4);
#pragma unroll
                for (int e = 0; e < 4; ++e) { float& s = S[4 * k4 + e]; s = s * w4[e] + sa * b4[e] + vv * k4v[e]; if (PA) { float& p = Pm[4 * k4 + e]; p = p * w4[e] + sp * b4[e]; } else o += s * r4[e]; }
            }
            if (!PA) odir[(size_t)scan_row(d, b, j0 + t) * DM + 512 + hc] = (h16)o;
        }
    }
    if (PA) {
        float* st = STR + (((size_t)sc * 64 + stream) * 2) * 4096 + lane * 64;
#pragma unroll
        for (int k4 = 0; k4 < 16; ++k4) { *(f32x4*)(st + 4 * k4) = (f32x4){S[4 * k4], S[4 * k4 + 1], S[4 * k4 + 2], S[4 * k4 + 3]}; *(f32x4*)(st + 4096 + 4 * k4) = (f32x4){Pm[4 * k4], Pm[4 * k4 + 1], Pm[4 * k4 + 2], Pm[4 * k4 + 3]}; }
    }
}

__device__ __forceinline__ void s5_hloc(Frame& F, int dg, int b, int rp, int half, const h16* P, float* HLOC) {
    const int lane = F.lane, i = lane & 15, h = lane >> 4, d = dg >> 5, g = dg & 31, stream = (d * NB + b) * 32 + g;
    const h16* E16 = WSP(h16, WS_S5E) + (size_t)dg * 32768;
    h16x8 af[2][8];
#pragma unroll
    for (int rt = 0; rt < 2; ++rt)
#pragma unroll
        for (int ks = 0; ks < 8; ++ks) af[rt][ks] = *(const h16x8*)(E16 + ((15 - (2 * ks + (h >> 1))) * 128 + 32 * rp + 16 * rt + i) * 16 + 8 * (h & 1));
    const int c0 = half ? 17 : 0, c1 = half ? 33 : 17;
    h16x8 bf[8];
    { const int j = 16 * c0 + i;
#pragma unroll
      for (int ks = 0; ks < 8; ++ks) bf[ks] = *(const h16x8*)(P + (size_t)scan_row(d, b, 16 * j + 2 * ks + (h >> 1)) * P1LD + 1568 + g * 16 + 8 * (h & 1)); }
#pragma unroll 1
    for (int ct = c0; ct < c1; ++ct) {
        const int j = 16 * ct + i, jn = 16 * (ct + 1 < c1 ? ct + 1 : ct) + i;
        f32x4 acc[2] = {(f32x4){0.f, 0.f, 0.f, 0.f}, (f32x4){0.f, 0.f, 0.f, 0.f}};
#pragma unroll
        for (int ks = 0; ks < 8; ++ks) {
            acc[0] = __builtin_amdgcn_mfma_f32_16x16x32_f16(af[0][ks], bf[ks], acc[0], 0, 0, 0);
            acc[1] = __builtin_amdgcn_mfma_f32_16x16x32_f16(af[1][ks], bf[ks], acc[1], 0, 0, 0);
            bf[ks] = *(const h16x8*)(P + (size_t)scan_row(d, b, 16 * jn + 2 * ks + (h >> 1)) * P1LD + 1568 + g * 16 + 8 * (h & 1));
        }
        float* o = HLOC + ((size_t)stream * 528 + j) * 128 + 32 * rp + 4 * h;
        *(f32x4*)o = acc[0] * (1.f / 256.f); *(f32x4*)(o + 16) = acc[1] * (1.f / 256.f);
    }
}
__device__ __forceinline__ void s5_out(Frame& F, int dg, int b, int rq, const h16* P, const h16* HIN, h16* odir) {
    const int lane = F.lane, i = lane & 15, h = lane >> 4, d = dg >> 5, g = dg & 31, stream = (d * NB + b) * 32 + g;
    const h16* G16 = WSP(h16, WS_S5G) + (size_t)dg * 4096; const h16* Q16 = WSP(h16, WS_S5Q) + (size_t)dg * 32768;
    h16x8 ga[2][8], qa[2][4];
#pragma unroll
    for (int rt = 0; rt < 2; ++rt) { const int t = 2 * rq + rt;
#pragma unroll
        for (int ks = 0; ks < 8; ++ks) { const int tau = t - (2 * ks + (h >> 1));
            h16x8 z;
#pragma unroll
            for (int e = 0; e < 8; ++e) z[e] = (h16)0.f;
            if (tau >= 0) z = *(const h16x8*)(G16 + (tau * 16 + i) * 16 + 8 * (h & 1));
            ga[rt][ks] = z; }
#pragma unroll
        for (int ks = 0; ks < 4; ++ks) qa[rt][ks] = *(const h16x8*)(Q16 + (t * 16 + i) * 128 + 32 * ks + 8 * h); }
    h16x8 bf[12];
    { const int j = i;
#pragma unroll
      for (int ks = 0; ks < 8; ++ks) if (ks <= rq) bf[ks] = *(const h16x8*)(P + (size_t)scan_row(d, b, 16 * j + 2 * ks + (h >> 1)) * P1LD + 1568 + g * 16 + 8 * (h & 1));
      const h16* hin = HIN + ((size_t)stream * 528 + j) * 128;
#pragma unroll
      for (int ks = 0; ks < 4; ++ks) bf[8 + ks] = *(const h16x8*)(hin + 32 * ks + 8 * h); }
#pragma unroll 1
    for (int ct = 0; ct < 33; ++ct) {
        const int j = 16 * ct + i, jn = 16 * (ct + 1 < 33 ? ct + 1 : ct) + i;
        f32x4 acc[2] = {(f32x4){0.f, 0.f, 0.f, 0.f}, (f32x4){0.f, 0.f, 0.f, 0.f}};
#pragma unroll
        for (int ks = 0; ks < 8; ++ks) {
            if (ks <= rq) {
                acc[0] = __builtin_amdgcn_mfma_f32_16x16x32_f16(ga[0][ks], bf[ks], acc[0], 0, 0, 0);
                acc[1] = __builtin_amdgcn_mfma_f32_16x16x32_f16(ga[1][ks], bf[ks], acc[1], 0, 0, 0);
                bf[ks] = *(const h16x8*)(P + (size_t)scan_row(d, b, 16 * jn + 2 * ks + (h >> 1)) * P1LD + 1568 + g * 16 + 8 * (h & 1));
            }
        }
        const h16* hinn = HIN + ((size_t)stream * 528 + jn) * 128;
#pragma unroll
        for (int ks = 0; ks < 4; ++ks) {
            acc[0] = __builtin_amdgcn_mfma_f32_16x16x32_f16(qa[0][ks], bf[8 + ks], acc[0], 0, 0, 0);
            acc[1] = __builtin_amdgcn_mfma_f32_16x16x32_f16(qa[1][ks], bf[8 + ks], acc[1], 0, 0, 0);
            bf[8 + ks] = *(const h16x8*)(hinn + 32 * ks + 8 * h);
        }
#pragma unroll
        for (int rt = 0; rt < 2; ++rt) { const f32x4 y = acc[rt] * (1.f / 64.f);
            u32x2 w; w.x = pk_h16(y[0], y[1]); w.y = pk_h16(y[2], y[3]);
            *(u32x2*)(odir + (size_t)scan_row(d, b, 16 * j + 2 * rq + rt) * DM + 512 + g * 16 + 4 * h) = w; }
    }
}

__device__ __forceinline__ void ph_scanA(Frame& F, int layer) {
    if (layer == 0) {
        const h16* P = WSP(h16, WS_BIG); unsigned char* dob = (unsigned char*)F.out;
        if (GLLC) ph_glquads<128, true>(F, true, P, P0LD, (float*)(dob + DO_STH), (float*)(dob + DO_DH), WSP(h16, WS_H16), (h16*)(dob + DO_OBWD), true, (h16*)(F.ws + WS_BIG + B0_QE), 1024);
        else ph_glquads<128, true>(F, false, P, P0LD, (float*)(dob + DO_STH), (float*)(dob + DO_DH), nullptr, nullptr);
        if (RWLC) ph_rwchunks<true, true>(F, P, (float*)(dob + DO_STR), WSP(float, WS_BSP), WSP(h16, WS_H16), (h16*)(dob + DO_OBWD), (h16*)(F.ws + WS_BIG + B0_QE));
        else if (RWMODE & 1) ph_rwchunks<true>(F, P, (float*)(dob + DO_STR), nullptr, nullptr, nullptr);
        if (RWMODE & 8) cg::this_grid().sync();
        if (!(RWMODE & 1) || (RWMODE & 8)) { constexpr int NRW = (NSC - 1) * 64; for (int it = F.gw; it < NRW; it += F.ngw) { const int sc = it / 64, st = it % 64; rw_unit<true>(F, sc, st >> 5, (st >> 3) & 3, st & 7, P, (float*)(dob + DO_STR), nullptr, nullptr); } }
    } else {
        const h16* P = WSP(h16, WS_BIG); unsigned char* big = F.ws + WS_BIG;
        ph_glquads<64, false>(F, false, P, P1LD, (float*)(big + B1_STG), (float*)(big + B1_DG), nullptr, nullptr);
        for (int it = F.gw; it < 64 * 4 * 4 * 2; it += F.ngw) s5_hloc(F, it >> 5, (it >> 3) & 3, (it >> 1) & 3, it & 1, P, (float*)(big + B1_HLOC));
    }
}
__device__ __forceinline__ void ph_scanB(Frame& F, int layer) {
    const int gt = blockIdx.x * NTHR + F.tid, ngt = F.G * NTHR;
    if (layer == 0) {
        unsigned char* dob = (unsigned char*)F.out;
        float* ST = (float*)(dob + DO_STH); const float* DH = (const float*)(dob + DO_DH);
        for (int e = gt; e < 32 * 128 * 128; e += ngt) { const int stream = e >> 14, k = (e >> 7) & 127; float carry = 0.f;
            float dv[NSC - 1], sv[NSC - 1];
#pragma unroll
            for (int sc = 0; sc < NSC - 1; ++sc) { dv[sc] = DH[((size_t)sc * 32 + stream) * 128 + k]; sv[sc] = ST[(size_t)sc * 32 * 16384 + e]; }
#pragma unroll
            for (int sc = 0; sc < NSC - 1; ++sc) { carry = dv[sc] * carry + sv[sc]; ST[(size_t)sc * 32 * 16384 + e] = carry; } }
        float* STR = (float*)(dob + DO_STR);
        LAS float* LS = (LAS float*)F.lds;
        LAS float* LP = LS + 64 * 65;
        for (int stream = blockIdx.x; stream < 64; stream += F.G) {
            __syncthreads();
            for (int i = F.tid; i < 64 * 65; i += NTHR) LS[i] = 0.f;
            float pv[8], uv[8];
            { const float* Ug0 = STR + ((size_t)stream * 2) * 4096; const float* Pg0 = Ug0 + 4096;
#pragma unroll
              for (int q = 0; q < 8; ++q) { pv[q] = Pg0[F.tid + NTHR * q]; uv[q] = Ug0[F.lane * 64 + F.wave * 8 + q]; } }
            for (int sc = 0; sc < NSC - 1; ++sc) {
                float* Ug = STR + (((size_t)sc * 64 + stream) * 2) * 4096;
                __syncthreads();
                float acc[8];
#pragma unroll
                for (int q = 0; q < 8; ++q) { LP[F.tid + NTHR * q] = pv[q]; acc[q] = uv[q]; }
                if (sc + 1 < NSC - 1) { const float* Un = Ug + (size_t)64 * 2 * 4096; const float* Pn = Un + 4096;
#pragma unroll
                    for (int q = 0; q < 8; ++q) { pv[q] = Pn[F.tid + NTHR * q]; uv[q] = Un[F.lane * 64 + F.wave * 8 + q]; } }
                LDS_BARRIER();
                for (int k = 0; k < 64; ++k) { const float s = LS[F.lane * 65 + k]; const f32x4 p0 = *(const LAS f32x4*)(LP + k * 64 + F.wave * 8), p1 = *(const LAS f32x4*)(LP + k * 64 + F.wave * 8 + 4);
                    acc[0] += s * p0.x; acc[1] += s * p0.y; acc[2] += s * p0.z; acc[3] += s * p0.w; acc[4] += s * p1.x; acc[5] += s * p1.y; acc[6] += s * p1.z; acc[7] += s * p1.w; }
                LDS_BARRIER();
#pragma unroll
                for (int e = 0; e < 8; ++e) { LS[F.lane * 65 + F.wave * 8 + e] = acc[e]; Ug[F.lane * 64 + F.wave * 8 + e] = acc[e]; }
            }
        }
        __syncthreads();
    } else {
        unsigned char* big = F.ws + WS_BIG;
        float* ST = (float*)(big + B1_STG); const float* DG = (const float*)(big + B1_DG);
        for (int e = gt; e < 32 * 64 * 128; e += ngt) { const int stream = e >> 13, k = (e >> 7) & 63; float carry = 0.f;
            float dv[NSC - 1], sv[NSC - 1];
#pragma unroll
            for (int sc = 0; sc < NSC - 1; ++sc) { dv[sc] = DG[((size_t)sc * 32 + stream) * 64 + k]; sv[sc] = ST[(size_t)sc * 32 * 8192 + e]; }
#pragma unroll
            for (int sc = 0; sc < NSC - 1; ++sc) { carry = dv[sc] * carry + sv[sc]; ST[(size_t)sc * 32 * 8192 + e] = carry; } }
        const float* HLOC = (const float*)(big + B1_HLOC); h16* HIN = (h16*)(big + B1_ZB); const float* L16 = WSP(float, WS_S5L);
        LAS float* EL = (LAS float*)F.lds;
        for (int stream = blockIdx.x; stream < 256; stream += F.G) {
            const int d = stream >> 7, g = stream & 31, dg = d * 32 + g, w = F.wave;
            const float lr = L16[(dg * 64 + F.lane) * 2], li = L16[(dg * 64 + F.lane) * 2 + 1];
            const float* rec = HLOC + ((size_t)stream * 528 + 66 * w) * 128; h16* o = HIN + ((size_t)stream * 528 + 66 * w) * 128;
            float cr = 0.f, ci = 0.f;
#pragma unroll 6
            for (int j = 0; j < 66; ++j) {
                const float hr = rec[j * 128 + F.lane], hi = rec[j * 128 + 64 + F.lane];
                const float nr = lr * cr - li * ci + hr, ni = lr * ci + li * cr + hi; cr = nr; ci = ni;
            }
            __syncthreads();
            EL[w * 128 + F.lane] = cr; EL[w * 128 + 64 + F.lane] = ci;
            float p2r = lr * lr - li * li, p2i = 2.f * lr * li, pr = p2r, pi = p2i;
#pragma unroll
            for (int q = 0; q < 5; ++q) { const float tr = pr * pr - pi * pi, ti = 2.f * pr * pi; pr = tr; pi = ti; }
            { const float tr = pr * p2r - pi * p2i, ti = pr * p2i + pi * p2r; pr = tr; pi = ti; }
            __syncthreads();
            cr = 0.f; ci = 0.f;
            for (int v = 0; v < w; ++v) { const float er = EL[v * 128 + F.lane], ei = EL[v * 128 + 64 + F.lane];
                const float nr = pr * cr - pi * ci + er, ni = pr * ci + pi * cr + ei; cr = nr; ci = ni; }
#pragma unroll 6
            for (int j = 0; j < 66; ++j) {
                const float hr = rec[j * 128 + F.lane], hi = rec[j * 128 + 64 + F.lane];
                o[j * 128 + F.lane] = (h16)(cr * 64.f); o[j * 128 + 64 + F.lane] = (h16)(ci * 64.f);
                const float nr = lr * cr - li * ci + hr, ni = lr * ci + li * cr + hi; cr = nr; ci = ni;
            }
        }
        __syncthreads();
    }
}
__device__ __forceinline__ void ph_scanC(Frame& F, int layer) {
    if (layer == 0) {
        const h16* P = WSP(h16, WS_BIG); unsigned char* dob = (unsigned char*)F.out;
        if (GLLC) ph_glcorr<128>(F, (const float*)(dob + DO_STH), (const h16*)(F.ws + WS_BIG + B0_QE), 1024, WSP(h16, WS_H16), (h16*)(dob + DO_OBWD));
        else ph_glquads<128, true>(F, true, P, P0LD, (float*)(dob + DO_STH), nullptr, WSP(h16, WS_H16), (h16*)(dob + DO_OBWD));
        if (RWLC) ph_rwcorr(F, (const float*)(dob + DO_STR), (const h16*)(F.ws + WS_BIG + B0_QE), WSP(h16, WS_H16), (h16*)(dob + DO_OBWD));
        else if ((RWMODE & 2) && !(RWMODE & 4)) ph_rwchunks<false>(F, P, (float*)(dob + DO_STR), WSP(float, WS_BSP), WSP(h16, WS_H16), (h16*)(dob + DO_OBWD));
        else { constexpr int NRW = NSC * 64; for (int it = F.gw; it < NRW; it += F.ngw) { const int sc = it / 64, st = it % 64, d = st >> 5; rw_unit<false>(F, sc, d, (st >> 3) & 3, st & 7, P, (float*)(dob + DO_STR), WSP(float, WS_BSP), d == 0 ? WSP(h16, WS_H16) : (h16*)(dob + DO_OBWD)); }
            if (RWMODE & 4) { cg::this_grid().sync(); ph_rwchunks<false>(F, P, (float*)(dob + DO_STR), WSP(float, WS_BSP), WSP(h16, WS_H16), (h16*)(dob + DO_OBWD)); } }
#if DETCHK == 2
        ph_rwlatecheck(F, P, (float*)(dob + DO_STR));
#endif
    } else {
        const h16* P = WSP(h16, WS_BIG); unsigned char* big = F.ws + WS_BIG;
        ph_glquads<64, false>(F, true, P, P1LD, (float*)(big + B1_STG), nullptr, WSP(h16, WS_H16), (h16*)(big + B1_OBWD));
        for (int it = F.gw; it < 64 * 4 * 8; it += F.ngw) { const int dg = it >> 5; s5_out(F, dg, (it >> 3) & 3, it & 7, P, (const h16*)(big + B1_ZB), (dg >> 5) == 0 ? WSP(h16, WS_H16) : (h16*)(big + B1_OBWD)); }
    }
}

__device__ __forceinline__ void ph_fin0(Frame& F, bool dry = false) {
    LAS h16* SGh = (LAS h16*)F.lds;
    LAS unsigned char* GT = F.lds + 32 * 272;
    const h16* P = WSP(h16, WS_BIG); h16* OF = WSP(h16, WS_H16); const h16* OB = (const h16*)((unsigned char*)F.out + DO_OBWD); const float* BSC = WSP(float, WS_BSP);
    const float* mu = F.in[I_RWMU];
    const int lane = F.lane, c0 = lane * 8, li = lane & 15, lh = lane >> 4;
    h16x8 g2f[4][4];
    { const h16* G2T = WSP(h16, WS_G2T);
#pragma unroll
      for (int ct = 0; ct < 4; ++ct)
#pragma unroll
          for (int ks = 0; ks < 4; ++ks) g2f[ct][ks] = *(const h16x8*)(G2T + (size_t)(64 * F.wave + 16 * ct + li) * 128 + 32 * ks + 8 * lh); }
    const int per = (((MU + F.G - 1) / F.G) + 3) & ~3, ubase = blockIdx.x * per, uend = (ubase + per < MU) ? ubase + per : MU;
    for (int it = 0; it * 32 < per; ++it) {
        const int u0 = ubase + it * 32 + F.wave * 4;
        const bool act = u0 < uend;
        __syncthreads();
#pragma unroll
        for (int tk = 0; tk < 4; ++tk) {
            if (act) { const int u = u0 + tk, s = u % TT; const bool hp = (s != 0 && s != CTXL), hn = (s != CTXL - 1 && s != TT - 1);
                const h16* pc = P + (size_t)u * P0LD + 2560;
#pragma unroll
                for (int i = 0; i < 2; ++i) { const int col = 1792 + lane + 64 * i; const float x = (float)pc[col], xp = (hp ? 1.f : 0.f) * (float)pc[col - (hp ? P0LD : 0)], xn = (hn ? 1.f : 0.f) * (float)pc[col + (hn ? P0LD : 0)];
                    SGh[(F.wave * 4 + tk) * 136 + lane + 64 * i] = (h16)sigm(x + mu[col] * (xp - x) + mu[1920 + col] * (xn - x)); } }
            else { SGh[(F.wave * 4 + tk) * 136 + lane] = (h16)0.f; SGh[(F.wave * 4 + tk) * 136 + lane + 64] = (h16)0.f; }
        }
        __syncthreads();
#pragma unroll
        for (int rt = 0; rt < 2; ++rt) {
            h16x8 sb[4];
#pragma unroll
            for (int ks = 0; ks < 4; ++ks) sb[ks] = *(LAS const h16x8*)(SGh + (16 * rt + li) * 136 + 32 * ks + 8 * lh);
#pragma unroll
            for (int ct = 0; ct < 4; ++ct) { f32x4 acc = (f32x4){0.f, 0.f, 0.f, 0.f};
#pragma unroll
                for (int ks = 0; ks < 4; ++ks) acc = __builtin_amdgcn_mfma_f32_16x16x32_f16(g2f[ct][ks], sb[ks], acc, 0, 0, 0);
                *(LAS u32x2*)(GT + (16 * rt + li) * 1040 + (64 * F.wave + 16 * ct + 4 * lh) * 2) = (u32x2){pk_h16(acc[0], acc[1]), pk_h16(acc[2], acc[3])}; }
        }
        __syncthreads();
        if (!act) continue;
        h16x8 gate[4];
#pragma unroll
        for (int tk = 0; tk < 4; ++tk) gate[tk] = *(LAS const h16x8*)(GT + (F.wave * 4 + tk) * 1040 + 16 * lane);
#pragma unroll
        for (int tk = 0; tk < 4; ++tk) {
            const int u = u0 + tk, s = u % TT; const bool hp = (s != 0 && s != CTXL), hn = (s != CTXL - 1 && s != TT - 1);
            const h16* prow = P + (size_t)u * P0LD;
            { const h16x8 a = *(const h16x8*)(OF + (size_t)u * DM + c0), bb = *(const h16x8*)(OB + (size_t)u * DM + c0), gg = *(const h16x8*)(prow + 2048 + c0);
              float x[8], ss = 0.f;
#pragma unroll
              for (int e = 0; e < 8; ++e) { x[e] = (float)a[e] + (float)bb[e]; ss += x[e] * x[e]; }
              ss += __shfl_xor(ss, 1); ss += __shfl_xor(ss, 2); ss += __shfl_xor(ss, 4); ss += __shfl_xor(ss, 8);
              const float rinv = rsqrtf(ss * (1.f / 128.f) + 1e-6f); const float* hg = F.in[I_HGNG] + (c0 & 127);
              u32x4 w; float y[8];
#pragma unroll
              for (int e = 0; e < 8; ++e) y[e] = x[e] * rinv * hg[e] * silu((float)gg[e]);
              w.x = pk_h16(y[0], y[1]); w.y = pk_h16(y[2], y[3]); w.z = pk_h16(y[4], y[5]); w.w = pk_h16(y[6], y[7]);
              *(u32x4*)((dry ? (h16*)OB : OF) + (size_t)u * DM + c0) = w; }
            { const h16x8 a = *(const h16x8*)(OF + (size_t)u * DM + 512 + c0), bb = *(const h16x8*)(OB + (size_t)u * DM + 512 + c0);
              float x[8], sm = 0.f;
#pragma unroll
              for (int e = 0; e < 8; ++e) { x[e] = (float)a[e] + (float)bb[e]; sm += x[e]; }
              sm += __shfl_xor(sm, 1); sm += __shfl_xor(sm, 2); sm += __shfl_xor(sm, 4);
              const float mean = sm * (1.f / 64.f); float vs = 0.f;
#pragma unroll
              for (int e = 0; e < 8; ++e) { x[e] -= mean; vs += x[e] * x[e]; }
              vs += __shfl_xor(vs, 1); vs += __shfl_xor(vs, 2); vs += __shfl_xor(vs, 4);
              const float rinv = rsqrtf(vs * (1.f / 64.f) + 64e-5f);
              const int head = lane >> 3; const f32x4 bp0 = *(const f32x4*)(BSC + ((size_t)u * 8 + head) * 4), bp1 = *(const f32x4*)(BSC + (((size_t)MU + u) * 8 + head) * 4); const float bon = ((bp0.x + bp0.y) + (bp0.z + bp0.w)) + ((bp1.x + bp1.y) + (bp1.z + bp1.w));
              const h16* pc = prow + 2560 + 1024 + c0; const h16x8 vc = *(const h16x8*)pc; const h16x8 vp = *(const h16x8*)(pc - (hp ? P0LD : 0)), vn = *(const h16x8*)(pc + (hn ? P0LD : 0));
              const float fp_ = hp ? 1.f : 0.f, fn_ = hn ? 1.f : 0.f;
              float y[8];
#pragma unroll
              for (int e = 0; e < 8; ++e) { const float xv = (float)vc[e]; const float vsh = xv + mu[1024 + c0 + e] * (fp_ * (float)vp[e] - xv) + mu[1920 + 1024 + c0 + e] * (fn_ * (float)vn[e] - xv);
                  y[e] = (x[e] * rinv * F.in[I_RWLNG][c0 + e] + F.in[I_RWLNB][c0 + e] + bon * vsh) * (float)gate[tk][e]; }
              u32x4 w; w.x = pk_h16(y[0], y[1]); w.y = pk_h16(y[2], y[3]); w.z = pk_h16(y[4], y[5]); w.w = pk_h16(y[6], y[7]);
              *(u32x4*)((dry ? (h16*)OB : OF) + (size_t)u * DM + 512 + c0) = w; }
        }
    }
}
__device__ __forceinline__ void ph_fin1(Frame& F) {
    const h16* P = WSP(h16, WS_BIG); h16* OF = WSP(h16, WS_H16); const h16* OB = (const h16*)(F.ws + WS_BIG + B1_OBWD); h16* ZB = (h16*)(F.ws + WS_BIG + B1_ZB);
    const int lane = F.lane, c0 = lane * 8;
    for (int u = F.gw; u < MU; u += F.ngw) {
        const h16* prow = P + (size_t)u * P1LD;
        { const h16x8 a = *(const h16x8*)(OF + (size_t)u * DM + c0), bb = *(const h16x8*)(OB + (size_t)u * DM + c0), gg = *(const h16x8*)(prow + 1024 + c0);
          float x[8], ss = 0.f;
#pragma unroll
          for (int e = 0; e < 8; ++e) { x[e] = (float)a[e] + (float)bb[e]; ss += x[e] * x[e]; }
          ss += __shfl_xor(ss, 1); ss += __shfl_xor(ss, 2); ss += __shfl_xor(ss, 4); ss += __shfl_xor(ss, 8);
          const float rinv = rsqrtf(ss * (1.f / 128.f) + 1e-6f); const float* hg = F.in[I_GLANG] + (c0 & 127);
          float y[8];
#pragma unroll
          for (int e = 0; e < 8; ++e) y[e] = x[e] * rinv * hg[e] * silu((float)gg[e]);
          u32x4 w; w.x = pk_h16(y[0], y[1]); w.y = pk_h16(y[2], y[3]); w.z = pk_h16(y[4], y[5]); w.w = pk_h16(y[6], y[7]);
          *(u32x4*)(OF + (size_t)u * DM + c0) = w; }
        { const h16x8 a = *(const h16x8*)(OF + (size_t)u * DM + 512 + c0), bb = *(const h16x8*)(OB + (size_t)u * DM + 512 + c0), uu = *(const h16x8*)(prow + 1568 + c0);
          float z[8];
#pragma unroll
          for (int e = 0; e < 8; ++e) z[e] = gelu_tanh((float)a[e] + (float)bb[e] + F.in[I_S5D][c0 + e] * (float)uu[e]);
          u32x4 w; w.x = pk_h16(z[0], z[1]); w.y = pk_h16(z[2], z[3]); w.z = pk_h16(z[4], z[5]); w.w = pk_h16(z[6], z[7]);
          *(u32x4*)(ZB + (size_t)u * 512 + c0) = w; }
    }
}


#define XB_TMO      128
#define XB_XCNT(j)  (256  + 64 * (j))
#define XB_XSUB(j)  (1280 + 64 * (j))
#define XB_XGEN(j)  (2304 + 64 * (j))
#define XB_TOP      3328
#define XB_TOPGEN   3392
#define XCD_BAR_WORDS 3456
#define XB_SPIN_CAP (1u << 22)
__device__ __forceinline__ unsigned xb_ld(unsigned* p)              { return __hip_atomic_load(p, __ATOMIC_RELAXED, __HIP_MEMORY_SCOPE_AGENT); }
__device__ __forceinline__ unsigned xb_add(unsigned* p, unsigned v) { return __hip_atomic_fetch_add(p, v, __ATOMIC_RELAXED, __HIP_MEMORY_SCOPE_AGENT); }
__device__ __forceinline__ unsigned xb_xcc_id() { return (unsigned)__builtin_amdgcn_s_getreg((3 << 11) | 20) & 0xFu; }
#define XB_SPIN(cond, bar) do { unsigned _sp = 0; while (cond) { __builtin_amdgcn_s_sleep(1); \
    if ((++_sp & 255u) == 0u) { if (xb_ld(&(bar)[XB_TMO])) break; if (_sp > XB_SPIN_CAP) { atomicAdd(&(bar)[XB_TMO], 1u); break; } } } } while (0)
struct XcdBarrier { unsigned* bar; unsigned x; volatile LAS unsigned* st; };
__device__ __forceinline__ XcdBarrier xcd_barrier_post(unsigned* bar, volatile LAS unsigned* st) {
    XcdBarrier b; b.bar = bar; b.x = xb_xcc_id(); b.st = st;
    if (threadIdx.x == 0) (void)xb_add(&bar[XB_XCNT(b.x)], 1u);
    return b;
}
__device__ __forceinline__ void xcd_barrier_complete(unsigned* bar, unsigned x, unsigned& nloc, unsigned& nx) {
    const unsigned G = gridDim.x * gridDim.y * gridDim.z;
    unsigned sum, cnt, mine, sp = 0u;
    for (;;) {
        sum = 0u; cnt = 0u; mine = 0u;
#pragma unroll
        for (unsigned j = 0; j < 16; ++j) { const unsigned c = xb_ld(&bar[XB_XCNT(j)]); sum += c; cnt += (c > 0u) ? 1u : 0u; mine = (j == x) ? c : mine; }
        if (sum == G) break;
        __builtin_amdgcn_s_sleep(1);
        if ((++sp & 255u) == 0u) { if (xb_ld(&bar[XB_TMO])) break; if (sp > XB_SPIN_CAP) { atomicAdd(&bar[XB_TMO], 1u); break; } }
    }
    nloc = mine > 0u ? mine : 1u; nx = cnt > 0u ? cnt : 1u;
}
__device__ __forceinline__ void xcd_barrier(const XcdBarrier& b) {
    asm volatile("s_waitcnt vmcnt(0)" ::: "memory");
    __syncthreads();
    if (threadIdx.x == 0) {
        unsigned* bar = b.bar;
        __builtin_amdgcn_s_waitcnt(0);
        unsigned nloc = b.st[0], nx = b.st[1];
        if (nloc == 0u) { xcd_barrier_complete(bar, b.x, nloc, nx); b.st[0] = nloc; b.st[1] = nx; }
        const unsigned old = xb_add(&bar[XB_XSUB(b.x)], 1u);
        const unsigned gen = old / nloc;
        if (old + 1u == (gen + 1u) * nloc) {
            __builtin_amdgcn_fence(__ATOMIC_RELEASE, "agent");
            asm volatile("s_waitcnt vmcnt(0)" ::: "memory");
            const unsigned og = xb_add(&bar[XB_TOP], 1u);
            const unsigned tg = og / nx;
            if (og + 1u == (tg + 1u) * nx) xb_add(&bar[XB_TOPGEN], 1u);
            else XB_SPIN(xb_ld(&bar[XB_TOPGEN]) == tg, bar);
            __builtin_amdgcn_fence(__ATOMIC_ACQUIRE, "agent");
            xb_add(&bar[XB_XGEN(b.x)], 1u);
            asm volatile("s_waitcnt vmcnt(0)" ::: "memory");
        } else {
            XB_SPIN(xb_ld(&bar[XB_XGEN(b.x)]) == gen, bar);
            __builtin_amdgcn_fence(__ATOMIC_ACQUIRE, "agent");
            asm volatile("s_waitcnt vmcnt(0)" ::: "memory");
        }
    }
    __syncthreads();
}

#ifndef CTXG
#define CTXG 1
#endif
constexpr int N_PHASES = 26;
#define PH_IN(k) (args.ph_lo <= (k) && (k) < args.ph_hi)
#define PH_SYNC(k) do { if ((k) + 1 < args.ph_hi) { if ((k) == 0 || USE_CG_SYNC) grid.sync(); else xcd_barrier(xbar); } } while (0)
#define RUNPH(k, ...) do { if (PH_IN(PB + (k))) { if (((REPM >> (k)) & 1u) && ((REPL >> L) & 1u)) { if (PHM & (1u << (k))) { __VA_ARGS__ } } if (PHM & (1u << (k))) { __VA_ARGS__ } PH_SYNC(PB + (k)); } } while (0)
template <int MODE, int CW>
__device__ __forceinline__ void ctx_gemm(Frame& F, const h16* A, int lda, const h16* Bt, int ldb, int K, int N, h16* O, int ldc, float* ctx, const float* mod, int goff) {
    const int tid = F.tid, lane = F.lane, i = lane & 15, h = lane >> 4, wr = F.wave >> 2, wc = F.wave & 3;
    constexpr int NJ = (64 + CW) / 64, NN = CW / 64;
    const int nct = N / CW, nunits = 16 * nct, nk = K / 64;
    constexpr int RS = 144, TILE = (64 + CW) * RS;
    LAS unsigned char* L0 = F.lds;
    for (int unit = blockIdx.x; unit < nunits; unit += F.G) {
        const int rt = unit / nct, ct = unit % nct, b = rt >> 2, r0 = (rt & 3) * 64;
        const size_t u0 = (size_t)b * TT + r0;
        const int col0 = ct * CW;
        const h16* gp[NJ]; int lo[NJ];
#pragma unroll
        for (int j = 0; j < NJ; ++j) { const int q = tid + 512 * j, row = q >> 3, c16 = q & 7;
            gp[j] = (row < 64 ? A + (u0 + row) * lda : Bt + (size_t)(col0 + row - 64) * ldb) + 8 * c16; lo[j] = row * RS + 16 * c16; }
        f32x4 acc[2][NN];
#pragma unroll
        for (int m = 0; m < 2; ++m)
#pragma unroll
            for (int n = 0; n < NN; ++n) acc[m][n] = (f32x4){0.f, 0.f, 0.f, 0.f};
        constexpr int PD = 4;
        u32x4 st[PD][NJ];
#pragma unroll
        for (int d = 0; d < PD; ++d)
#pragma unroll
            for (int j = 0; j < NJ; ++j) st[d][j] = *(const u32x4*)(gp[j] + 64 * d);
        __syncthreads();
#pragma unroll
        for (int j = 0; j < NJ; ++j) *(LAS u32x4*)(L0 + lo[j]) = st[0][j];
        __syncthreads();
        const int aoff = (wr * 32 + i) * RS + 16 * h, boff = (64 + wc * (CW / 4) + i) * RS + 16 * h;
#pragma unroll 1
        for (int kt0 = 0; kt0 < nk; kt0 += PD) {
#pragma unroll
            for (int d = 0; d < PD; ++d) {
                const int kt = kt0 + d;
                if (kt + PD < nk) {
#pragma unroll
                    for (int j = 0; j < NJ; ++j) st[d][j] = *(const u32x4*)(gp[j] + 64 * (kt + PD)); }
                LAS const unsigned char* T = L0 + (d & 1) * TILE;
#pragma unroll
                for (int ks = 0; ks < 2; ++ks) {
                    const h16x8 a0 = *(LAS const h16x8*)(T + aoff + 64 * ks), a1 = *(LAS const h16x8*)(T + aoff + 16 * RS + 64 * ks);
#pragma unroll
                    for (int n = 0; n < NN; ++n) { const h16x8 bn = *(LAS const h16x8*)(T + boff + n * 16 * RS + 64 * ks);
                        acc[0][n] = __builtin_amdgcn_mfma_f32_16x16x32_f16(bn, a0, acc[0][n], 0, 0, 0); acc[1][n] = __builtin_amdgcn_mfma_f32_16x16x32_f16(bn, a1, acc[1][n], 0, 0, 0); }
                }
                if (kt + 1 < nk) {
#pragma unroll
                    for (int j = 0; j < NJ; ++j) *(LAS u32x4*)(L0 + ((d + 1) & 1) * TILE + lo[j]) = st[(d + 1) % PD][j]; }
                LDS_BARRIER();
            }
        }
#pragma unroll
        for (int m = 0; m < 2; ++m)
#pragma unroll
            for (int n = 0; n < NN; ++n) { const int col = col0 + wc * (CW / 4) + 16 * n + 4 * h, row = wr * 32 + 16 * m + i; const f32x4 v = acc[m][n];
                if (MODE == 0) { *(u32x2*)(O + (u0 + row) * ldc + col) = (u32x2){pk_h16(v[0], v[1]), pk_h16(v[2], v[3])}; }
                else { float* dst = ctx + ((size_t)b * CTXL + r0 + row) * DM + col; const f32x4 g = *(const f32x4*)(mod + 4 * 6144 + goff + col);
                    *(f32x4*)dst = *(const f32x4*)dst + g * v; } }
    }
    __syncthreads();
}

template <int L>
__device__ __forceinline__ void layer_program(Frame& F, const Args& args, cg::grid_group& grid, const XcdBarrier& xbar) {
    constexpr int PB = 1 + 12 * L;
    float* MOD = WSP(float, WS_MOD) + L * 5 * 6144; float* CTX = WSP(float, WS_CTX);
#define XIN_ (L == 0 ? F.in[I_X] : F.out)
    RUNPH(0, ph_norm(F, XIN_, L == 0 ? F.in[I_CTX] : CTX, F.in[I_N1G] + L * DM, MOD, 0, 1024, WSP(h16, WS_H16), L == 0 ? CTX : nullptr););
    RUNPH(1, pg8::Gemm g{WSP(h16, WS_H16), L == 0 ? WSP(h16, WS_WEVIN) : WSP(h16, WS_WODIN), MU, L == 0 ? P0LD : P1LD, DM, DM, DM};
        pg8::StaticOrder S; S.init(g.M, g.N, F.G, blockIdx.x, L == 0 ? CTXG : 0); pg8::EpiH16 E{WSP(h16, WS_BIG), L == 0 ? P0LD : P1LD};
        pg8::gemm_phase<pg8::EpiH16>(F.lds, g, S, E);
        if (L == 0 && CTXG) ctx_gemm<0, 128>(F, g.A, g.lda, g.Bt, g.ldb, g.K, g.N, WSP(h16, WS_BIG), P0LD, nullptr, nullptr, 0););
    RUNPH(2, ph_scanA(F, L););
    RUNPH(3, ph_scanB(F, L););
    RUNPH(4, ph_scanC(F, L););
    RUNPH(5, if (L == 0) ph_fin0(F); else ph_fin1(F););
    if (L == 0 && (REPM & 0x10000u) && PH_IN(PB + 5)) { xcd_barrier(xbar); ph_fin0(F, true); xcd_barrier(xbar); }
    if (L == 1) RUNPH(6, pg8::Gemm g{(const h16*)(F.ws + WS_BIG + B1_ZB), WSP(h16, WS_WGLU), MU, 512, 512, 512, 512};
        pg8::StaticOrder S; S.init(g.M, g.N, F.G, blockIdx.x, 1); pg8::EpiGlu E{(const h16*)(F.ws + WS_BIG + B1_ZB), WSP(h16, WS_H16), F.in[I_S5BGLU]};
        pg8::gemm_phase<pg8::EpiGlu>(F.lds, g, S, E););
    RUNPH(7, pg8::Gemm g{WSP(h16, WS_H16), L == 0 ? WSP(h16, WS_WEVOUT) : WSP(h16, WS_WODOUT), MU, DM, DM, DM, DM};
        pg8::StaticOrder S; S.init(g.M, g.N, F.G, blockIdx.x, (L == 1 || CTXG) ? 1 : 0); pg8::EpiResid E{XIN_, F.out, CTX, MOD, 2048, L == 0 ? 1 : 0};
        pg8::gemm_phase<pg8::EpiResid>(F.lds, g, S, E);
        if (L == 0 && CTXG) ctx_gemm<1, 128>(F, g.A, g.lda, g.Bt, g.ldb, g.K, g.N, nullptr, 0, CTX, MOD, 2048););
    RUNPH(8, ph_norm(F, F.out, CTX, F.in[I_N2G] + L * DM, MOD, 3072, 4096, WSP(h16, WS_H16), nullptr););
    RUNPH(9, pg8::Gemm g{WSP(h16, WS_H16), WSP(h16, WS_WUP + (size_t)L * 11 * MiB), MU, GVLD, DM, DM, DM};
        pg8::StaticOrder S; S.init(g.M, g.N, F.G, blockIdx.x, (L == 1 || CTXG) ? 1 : 0); pg8::EpiH16 E{WSP(h16, WS_BIG), GVLD};
        pg8::gemm_phase<pg8::EpiH16>(F.lds, g, S, E);
        if (L == 0 && CTXG) ctx_gemm<0, 128>(F, g.A, g.lda, g.Bt, g.ldb, g.K, g.N, WSP(h16, WS_BIG), GVLD, nullptr, nullptr, 0););
    RUNPH(10, ph_conv(F, L););
    if ((REPM & 0x20000u) && ((REPL >> L) & 1u) && PH_IN(PB + 10)) { ph_conv(F, L, true); xcd_barrier(xbar); }
    RUNPH(11, pg8::Gemm g{WSP(h16, WS_BIG) + DFF, WSP(h16, WS_WDN + (size_t)L * 6 * MiB), MU, DM, DFF, GVLD, DFF};
        pg8::StaticOrder S; S.init(g.M, g.N, F.G, blockIdx.x, (L == 1 || CTXG) ? 1 : 0); pg8::EpiResid E{F.out, F.out, CTX, MOD, 5120, L == 0 ? 1 : 0};
        pg8::gemm_phase<pg8::EpiResid>(F.lds, g, S, E);
        if (L == 0 && CTXG) ctx_gemm<1, 128>(F, g.A, g.lda, g.Bt, g.ldb, g.K, g.N, nullptr, 0, CTX, MOD, 5120););
}
__global__ void __launch_bounds__(NTHR, 2) mega_fwd(Args args) {
    extern __shared__ __attribute__((aligned(16))) unsigned char lds_raw[];
    cg::grid_group grid = cg::this_grid();
    Frame F;
    F.lds = (LAS unsigned char*)lds_raw; F.out = args.out; F.ws = args.ws;
    { const float** tab = (const float**)(args.ws + WS_TAB);
      if (threadIdx.x == 0) {
#pragma unroll
          for (int i = 0; i < N_IN; ++i) __hip_atomic_store(tab + i, args.in[i], __ATOMIC_RELAXED, __HIP_MEMORY_SCOPE_AGENT);
          __threadfence();
      }
      __syncthreads();
      F.in = tab; }
    F.tid = threadIdx.x; F.lane = F.tid & 63; F.wave = __builtin_amdgcn_readfirstlane(F.tid >> 6);
    F.G = gridDim.x; F.gw = blockIdx.x * NWAVES + F.wave; F.ngw = F.G * NWAVES;
    { volatile LAS unsigned* st_ = (volatile LAS unsigned*)(F.lds + 131072 + 320); if (F.tid < 4) st_[F.tid] = 0u; }
    __syncthreads();
    const XcdBarrier xbar = xcd_barrier_post((unsigned*)(args.ws + WS_XBAR), (volatile LAS unsigned*)(F.lds + 131072 + 320));
    if (PH_IN(0)) { if (REPM & 0x40000u) ph_prologue(F); if (PHM & 0x1000u) ph_prologue(F); PH_SYNC(0); for (int xs_ = 0; xs_ < XSYNC; ++xs_) grid.sync(); }
    layer_program<0>(F, args, grid, xbar);
    layer_program<1>(F, args, grid, xbar);
    if (PH_IN(25)) { if (PHM & 0x2000u) ph_final(F); }
}

extern "C" void kernel_launch(void* const* d_in, const int* in_sizes, int n_in, void* d_out, int out_size, void* d_ws, size_t ws_size, hipStream_t stream) {
    static int grid_blocks = 0;
    if (grid_blocks == 0) {
        if (n_in != N_IN || out_size != NB * SEQ * DM || ws_size < WS_END) { fprintf(stderr, "kernel_launch: unexpected shapes (n_in %d, out %d, ws %zu)\n", n_in, out_size, ws_size); grid_blocks = -1; return; }
        int dev = 0, cus = 0, per_cu = 0;
        hipGetDevice(&dev); hipDeviceGetAttribute(&cus, hipDeviceAttributeMultiprocessorCount, dev);
        hipFuncSetAttribute((const void*)mega_fwd, hipFuncAttributeMaxDynamicSharedMemorySize, LDS_BYTES);
        hipOccupancyMaxActiveBlocksPerMultiprocessor(&per_cu, (const void*)mega_fwd, NTHR, LDS_BYTES);
        if (per_cu < 1) { fprintf(stderr, "kernel_launch: occupancy query says %d blocks per CU\n", per_cu); grid_blocks = -1; return; }
        grid_blocks = cus;
    }
    if (grid_blocks < 0) return;
    if (hipMemsetAsync((char*)d_ws + WS_XBAR, 0, XCD_BAR_WORDS * 4, stream) != hipSuccess) { fprintf(stderr, "kernel_launch: memset of barrier words failed\n"); return; }
    Args a{};
    for (int i = 0; i < N_IN; ++i) a.in[i] = (const float*)d_in[i];
    a.out = (float*)d_out; a.ws = (unsigned char*)d_ws;
#if MK_PER_PHASE
    for (int ph = 0; ph < N_PHASES; ++ph) {
        if (ph == 7) continue;
        a.ph_lo = ph; a.ph_hi = ph + 1; void* kargs[] = {&a};
        hipError_t e = hipLaunchCooperativeKernel((const void*)mega_fwd, dim3(grid_blocks), dim3(NTHR), kargs, LDS_BYTES, stream);
        if (e != hipSuccess) { fprintf(stderr, "launch of phase %d failed: %s\n", ph, hipGetErrorString(e)); break; }
    }
#else
    a.ph_lo = 0; a.ph_hi = N_PHASES; void* kargs[] = {&a};
    hipError_t e = hipLaunchCooperativeKernel((const void*)mega_fwd, dim3(grid_blocks), dim3(NTHR), kargs, LDS_BYTES, stream);
    if (e != hipSuccess) fprintf(stderr, "cooperative launch failed: %s (grid %d)\n", hipGetErrorString(e), grid_blocks);
#endif
}
```

```cpp
#include <hip/hip_runtime.h>
#include <hip/hip_cooperative_groups.h>
#include <cstdio>
#include <cstdint>
namespace cg = cooperative_groups;

#ifndef MK_PER_PHASE
#define MK_PER_PHASE 0
#endif
#ifndef RWLC
#define RWLC 1
#endif
#ifndef GLLC
#define GLLC (!RWLC)
#endif
#ifndef RWPF
#define RWPF 1
#endif

#ifndef REPM
#define REPM 0u
#endif
#ifndef CHK
#define CHK 0x6Fu
#endif
#ifndef RWSER
#define RWSER 0
#endif
#ifndef DETCHK
#define DETCHK 0
#endif
#ifndef SCRUB
#define SCRUB 0
#endif
#ifndef RWZERO
#define RWZERO 0
#endif
#ifndef USE_CG_SYNC
#define USE_CG_SYNC 0
#endif
#ifndef RWMODE
#define RWMODE 3
#endif
#ifndef REPL
#define REPL 3u
#endif
#ifndef XSYNC
#define XSYNC 0
#endif
#ifndef DBGM
#define DBGM 0
#endif
#ifndef PHM
#define PHM 0xFFFFu
#endif
#define LAS __attribute__((address_space(3)))
typedef _Float16 h16;
typedef _Float16 h16x8 __attribute__((ext_vector_type(8)));
typedef _Float16 h16x4 __attribute__((ext_vector_type(4)));
typedef _Float16 h16x2 __attribute__((ext_vector_type(2)));
typedef float f32x4 __attribute__((ext_vector_type(4)));
typedef float f32x2 __attribute__((ext_vector_type(2)));
typedef unsigned u32x4 __attribute__((ext_vector_type(4)));
typedef unsigned u32x2 __attribute__((ext_vector_type(2)));

constexpr int NB = 4, SEQ = 8192, CTXL = 256, DM = 1024, TT = SEQ + CTXL, MU = NB * TT;
constexpr int EVC = 4480, P0LD = 4608, ODC = 2080, P1LD = 2304, DFF = 2816, GVLD = 2 * DFF;
constexpr int NSC = 16, SCL = TT / NSC;
constexpr int NWAVES = 8, NTHR = 512;
static_assert(SCL * NSC == TT && SCL % 8 == 0 && CTXL % 8 == 0, "scan tiling");

enum { I_X = 0, I_C, I_CTX, I_CCTX, I_ADAW, I_ADAB, I_N1G, I_N2G, I_FING, I_EVWIN, I_EVWOUT, I_HGLB, I_HGNG, I_RWMU, I_RWW0, I_RWW2, I_RWA0, I_RWA2,
       I_RWG2, I_RWKK, I_RWKA, I_RWRK, I_RWLNG, I_RWLNB, I_ODWIN, I_ODWOUT, I_GLAW2, I_GLAB, I_GLANG, I_S5ARE, I_S5AIM, I_S5LDT, I_S5BRE, I_S5BIM,
       I_S5CRE, I_S5CIM, I_S5D, I_S5WGLU, I_S5BGLU, I_FFNUP, I_FFNCW, I_FFNCB, I_FFNDN, N_IN };

constexpr size_t MiB = 1u << 20;
constexpr size_t WS_CTL = 0, WS_TAB = 4096, WS_XBAR = 65536, WS_MOD = 1 * MiB, WS_S5P = 2 * MiB, WS_CTX = 3 * MiB, WS_BSC = 7 * MiB;
constexpr size_t WS_WEVIN = 10 * MiB, WS_WEVOUT = 19 * MiB, WS_WODIN = 21 * MiB, WS_WODOUT = 26 * MiB, WS_WUP = 28 * MiB  ,
                 WS_WDN = 50 * MiB  , WS_WGLU = 62 * MiB, WS_G2T = 63 * MiB;
constexpr size_t WS_H16 = 64 * MiB, WS_BIG = 130 * MiB, WS_END = 512 * MiB;
constexpr size_t WS_S5E = 493 * MiB, WS_S5Q = 497 * MiB, WS_S5G = 501 * MiB, WS_S5L = 501 * MiB + 512 * 1024, WS_BSP = 502 * MiB + 512 * 1024;
static_assert(WS_H16 + (size_t)MU * DM * 2 <= WS_BIG && WS_BIG + (size_t)MU * GVLD * 2 <= WS_S5E, "ws map");
constexpr size_t DO_OBWD = 0, DO_STH = 66 * MiB, DO_STR = 96 * MiB, DO_DH = 126 * MiB;
constexpr size_t B1_OBWD = 150 * MiB, B1_STG = 216 * MiB, B1_DG = 231 * MiB, B1_ZB = 236 * MiB, B1_HLOC = 269 * MiB;
constexpr size_t B0_QE = 297 * MiB;
static_assert((size_t)MU * P1LD * 2 <= B1_OBWD && B1_ZB + (size_t)MU * 512 * 2 <= B1_HLOC && B1_HLOC + (size_t)256 * 528 * 512 <= (size_t)MU * GVLD * 2, "layer-1 scratch map");

__device__ __forceinline__ float wave_sum(float v) {
#pragma unroll
    for (int o = 1; o < 64; o <<= 1) v += __shfl_xor(v, o);
    return v;
}
__device__ __forceinline__ float rcpf_(float x) { return __builtin_amdgcn_rcpf(x); }
__device__ __forceinline__ float sigm(float x) { return 1.f / (1.f + __expf(-x)); }
__device__ __forceinline__ float sigm_fast(float x) { return rcpf_(1.f + __expf(-x)); }
__device__ __forceinline__ float row_sum16(float x) {
    x += __builtin_bit_cast(float, __builtin_amdgcn_update_dpp(0, __builtin_bit_cast(int, x), 0x128, 0xf, 0xf, false));
    x += __builtin_bit_cast(float, __builtin_amdgcn_update_dpp(0, __builtin_bit_cast(int, x), 0x124, 0xf, 0xf, false));
    x += __builtin_bit_cast(float, __builtin_amdgcn_update_dpp(0, __builtin_bit_cast(int, x), 0x122, 0xf, 0xf, false));
    x += __builtin_bit_cast(float, __builtin_amdgcn_update_dpp(0, __builtin_bit_cast(int, x), 0x121, 0xf, 0xf, false));
    return x;
}
__device__ __forceinline__ float silu(float x) { return x / (1.f + __expf(-x)); }
__device__ __forceinline__ float softplus(float x) { return fmaxf(x, 0.f) + __logf(1.f + __expf(-fabsf(x))); }
__device__ __forceinline__ float tanh_(float x) { const float e = __expf(2.f * x); return 1.f - 2.f / (e + 1.f); }
__device__ __forceinline__ float gelu_tanh(float x) { return 0.5f * x * (1.f + tanh_(0.7978845608028654f * (x + 0.044715f * x * x * x))); }
__device__ __forceinline__ unsigned pk_h16(float lo, float hi) { h16x2 v = {(h16)lo, (h16)hi}; return __builtin_bit_cast(unsigned, v); }
__device__ __forceinline__ int scan_row(int d, int b, int j) { const int s = d == 0 ? j : (j < CTXL ? CTXL - 1 - j : (TT + CTXL - 1) - j); return b * TT + s; }

namespace pg8 {
constexpr int BM = 256, BK = 64, HALF = 128, HTB = HALF * BK * 2, STAGE_BYTES = 8 * HTB, NXCD = 8, WGM = 8;
__host__ __device__ __forceinline__ int lds_byte(int r, int c) { const int st = (r >> 4) * 2 + (c >> 5), rr = r & 15, cc = c & 31, ob = rr * 64 + cc * 2; return st * 1024 + (ob ^ (((ob >> 9) & 1) << 5)); }
__host__ __device__ __forceinline__ void stage_rc(int b, int& R, int& C) { const int st = b / 1024, sb = b % 1024, swz = sb ^ (((sb >> 9) & 1) << 5); R = (st >> 1) * 16 + swz / 64; C = (st & 1) * 32 + (swz % 64) / 2; }
__host__ __device__ __forceinline__ int perm32(int rho) { const int n = rho >> 4, i = rho & 15; return 8 * (i >> 2) + 4 * n + (i & 3); }
struct Unit { int pm, pn; };
struct Gemm { const h16* A; const h16* Bt; int M, N, K, lda, ldb; };
struct StaticOrder {
    int nM, nN, nwg, G, c;
    int skipctx;
    __device__ void init(int M, int N, int G_, int c_, int skipctx_ = 0) { skipctx = skipctx_; nM = M / BM - (skipctx_ ? 4 : 0); nN = N / BM; nwg = nM * nN; G = G_; c = c_; }
    __device__ bool next(int i, Unit& u) const {
        const long L = (long)i * G + c; if (L >= nwg) return false;
        int wgid = (int)L; { const int q = nwg / NXCD, r = nwg % NXCD, xcd = wgid % NXCD, off = wgid / NXCD; wgid = (xcd < r ? xcd * (q + 1) : r * (q + 1) + (xcd - r) * q) + off; }
        const int nig = WGM * nN, gid = wgid / nig, fm = gid * WGM, gsz = (nM - fm) < WGM ? (nM - fm) : WGM;
        u.pm = fm + ((wgid % nig) % gsz); u.pn = (wgid % nig) / gsz; if (skipctx) u.pm = (u.pm >> 5) * 33 + 1 + (u.pm & 31); return true;
    }
};

struct EpiH16 {
    static constexpr bool PERM = true;
    h16* O; int ldc;
    __device__ __forceinline__ void operator()(const f32x4 (&acc)[2][2][4][2], const Unit& u, int wr, int wc, int fr, int fq) const {
        const int row0 = u.pm * BM + wr * 64 + fr, col0 = u.pn * BM + wc * 32 + 8 * fq;
#pragma unroll
        for (int ai = 0; ai < 2; ++ai)
#pragma unroll
            for (int m = 0; m < 4; ++m) { h16* rowp = O + (size_t)(row0 + ai * HALF + m * 16) * ldc + col0;
#pragma unroll
                for (int bj = 0; bj < 2; ++bj) { const f32x4 v0 = acc[ai][bj][m][0], v1 = acc[ai][bj][m][1];
                    u32x4 w; w.x = pk_h16(v0[0], v0[1]); w.y = pk_h16(v0[2], v0[3]); w.z = pk_h16(v1[0], v1[1]); w.w = pk_h16(v1[2], v1[3]);
                    *(u32x4*)(rowp + bj * HALF) = w; } }
    }
};
struct EpiGlu {
    static constexpr bool PERM = true;
    const h16* Z; h16* O; const float* bias;
    __device__ __forceinline__ void operator()(const f32x4 (&acc)[2][2][4][2], const Unit& u, int wr, int wc, int fr, int fq) const {
        const int row0 = u.pm * BM + wr * 64 + fr, col0 = u.pn * BM + wc * 32 + 8 * fq;
#pragma unroll
        for (int bj = 0; bj < 2; ++bj) { const int c = col0 + bj * HALF; const f32x4 b0 = *(const f32x4*)(bias + c), b1 = *(const f32x4*)(bias + c + 4);
#pragma unroll
            for (int ai = 0; ai < 2; ++ai)
#pragma unroll
                for (int m = 0; m < 4; ++m) { const size_t r = (size_t)(row0 + ai * HALF + m * 16);
                    const h16x8 z = *(const h16x8*)(Z + r * 512 + c); const f32x4 v0 = acc[ai][bj][m][0] + b0, v1 = acc[ai][bj][m][1] + b1;
                    u32x4 w; w.x = pk_h16((float)z[0] * sigm(v0[0]), (float)z[1] * sigm(v0[1])); w.y = pk_h16((float)z[2] * sigm(v0[2]), (float)z[3] * sigm(v0[3]));
                    w.z = pk_h16((float)z[4] * sigm(v1[0]), (float)z[5] * sigm(v1[1])); w.w = pk_h16((float)z[6] * sigm(v1[2]), (float)z[7] * sigm(v1[3]));
                    *(u32x4*)(O + r * 1024 + 512 + c) = w; } }
    }
};
struct EpiResid {
    static constexpr bool PERM = false;
    const float* xsrc; float* xdst; float* ctx; const float* mod; int goff; int do_ctx;
    __device__ __forceinline__ void operator()(const f32x4 (&acc)[2][2][4][2], const Unit& u, int wr, int wc, int fr, int fq) const {
        const int b = u.pm / 33, jt = u.pm % 33;
        const int col0 = u.pn * BM + wc * 32 + 4 * fq;
        if (jt == 0 && !do_ctx) return;
        const float* gv = mod + (jt == 0 ? 4 : b) * 6144 + goff;
        const float* src; float* dst;
        if (jt == 0) { src = ctx + (size_t)b * CTXL * DM; dst = ctx + (size_t)b * CTXL * DM; }
        else { const size_t o = ((size_t)b * SEQ + (size_t)(jt - 1) * 256) * DM; src = xsrc + o; dst = xdst + o; }
#pragma unroll
        for (int bj = 0; bj < 2; ++bj)
#pragma unroll
            for (int n = 0; n < 2; ++n) { const int c = col0 + bj * HALF + n * 16; const f32x4 g = *(const f32x4*)(gv + c);
                f32x4 bs[2][4];
#pragma unroll
                for (int ai = 0; ai < 2; ++ai)
#pragma unroll
                    for (int m = 0; m < 4; ++m) bs[ai][m] = *(const f32x4*)(src + (size_t)(ai * HALF + wr * 64 + m * 16 + fr) * DM + c);
#pragma unroll
                for (int ai = 0; ai < 2; ++ai)
#pragma unroll
                    for (int m = 0; m < 4; ++m) *(f32x4*)(dst + (size_t)(ai * HALF + wr * 64 + m * 16 + fr) * DM + c) = bs[ai][m] + g * acc[ai][bj][m][n]; }
    }
};

template <class Epi>
__device__ __forceinline__ void gemm_phase(LAS unsigned char* lds, const Gemm g, const StaticOrder& S, const Epi& E) {
    const int tid = threadIdx.x, wid = __builtin_amdgcn_readfirstlane(tid >> 6), lane = tid & 63, wr = wid >> 2, wc = wid & 3, fr = lane & 15, fq = lane >> 4;
    const int K = g.K, nt = K / BK;
    unsigned voffA[2], voffB[2];
#pragma unroll
    for (int i = 0; i < 2; ++i) { int R, C; stage_rc(tid * 16 + i * 8192, R, C); const int Rb = Epi::PERM ? ((R & ~31) + perm32(R & 31)) : R;
        voffA[i] = (unsigned)(R * g.lda + C) * 2u; voffB[i] = (unsigned)(Rb * g.ldb + C) * 2u; }
    const size_t kstep = (size_t)(BK * 2);
    const size_t hA = (size_t)HALF * g.lda * 2, hB = (size_t)HALF * g.ldb * 2, tA = 2 * hA, tB = 2 * hB;
    const unsigned ldsw = (unsigned)wid * 1024u;
    const int aoff = lds_byte(wr * 64 + fr, fq * 8), boff = lds_byte(wc * 32 + fr, fq * 8);
#define PG8_SA(b, h) (((b) * 2 + (h)) * HTB)
#define PG8_SB(b, h) ((4 + (b) * 2 + (h)) * HTB)
#define PG8_STAGE(bufoff, gbase, voff) do { _Pragma("unroll") for (int _i = 0; _i < 2; ++_i) \
        __builtin_amdgcn_global_load_lds((const unsigned*)((const char*)(gbase) + (voff)[_i]), (LAS unsigned*)(lds + (bufoff) + ldsw + _i * 8192), 16, 0, 0); } while (0)
#define PG8_LDA(dst, b, h) do { _Pragma("unroll") for (int m = 0; m < 4; ++m) _Pragma("unroll") for (int k = 0; k < 2; ++k) dst[m][k] = *(const LAS h16x8*)(lds + PG8_SA(b, h) + aoff + m * 2048 + k * 1024); } while (0)
#define PG8_LDB(dst, b, h) do { _Pragma("unroll") for (int n = 0; n < 2; ++n) _Pragma("unroll") for (int k = 0; k < 2; ++k) dst[n][k] = *(const LAS h16x8*)(lds + PG8_SB(b, h) + boff + n * 2048 + k * 1024); } while (0)
#define PG8_MMA(ai, bj, At, Bt) do { __builtin_amdgcn_s_setprio(1); _Pragma("unroll") for (int m = 0; m < 4; ++m) _Pragma("unroll") for (int n = 0; n < 2; ++n) _Pragma("unroll") for (int k = 0; k < 2; ++k) \
        acc[ai][bj][m][n] = __builtin_amdgcn_mfma_f32_16x16x32_f16(Bt[n][k], At[m][k], acc[ai][bj][m][n], 0, 0, 0); __builtin_amdgcn_s_setprio(0); } while (0)
#define PG8_WAIT_V(n) asm volatile("s_waitcnt vmcnt(" #n ")" ::: "memory")
#define PG8_WAIT_L(n) asm volatile("s_waitcnt lgkmcnt(" #n ")" ::: "memory")
#define PG8_BAR __builtin_amdgcn_s_barrier()
#define PG8_SCHED __builtin_amdgcn_sched_barrier(0)
    Unit cur, nxt; int ui = 0;
    if (!S.next(0, cur)) return;
    f32x4 acc[2][2][4][2];
#pragma unroll
    for (int a = 0; a < 2; ++a)
#pragma unroll
        for (int b = 0; b < 2; ++b)
#pragma unroll
            for (int m = 0; m < 4; ++m)
#pragma unroll
                for (int n = 0; n < 2; ++n) acc[a][b][m][n] = (f32x4){0.f, 0.f, 0.f, 0.f};
    h16x8 At[4][2], B0[2][2], B1[2][2];
    const char* cA = (const char*)g.A + (size_t)cur.pm * tA; const char* cB = (const char*)g.Bt + (size_t)cur.pn * tB;
    PG8_STAGE(PG8_SB(0, 0), cB, voffB); PG8_STAGE(PG8_SB(0, 1), cB + hB, voffB); PG8_STAGE(PG8_SA(0, 0), cA, voffA); PG8_STAGE(PG8_SA(0, 1), cA + hA, voffA);
    if (wr == 1) PG8_BAR;
    PG8_WAIT_V(2); PG8_BAR;
    PG8_STAGE(PG8_SB(1, 0), cB + kstep, voffB); PG8_STAGE(PG8_SA(1, 0), cA + kstep, voffA); PG8_STAGE(PG8_SB(1, 1), cB + hB + kstep, voffB);
    PG8_WAIT_V(6); PG8_BAR;
    for (;;) {
        const bool has_next = S.next(ui + 1, nxt);
        const char* nA = has_next ? (const char*)g.A + (size_t)nxt.pm * tA : cA; const char* nB = has_next ? (const char*)g.Bt + (size_t)nxt.pn * tB : cB;
        for (int t = 0; t < nt; t += 2) {
            const bool last = (t == nt - 2);
            const char* a1 = cA + (size_t)(t + 1) * kstep;
            const char* a2 = last ? nA : cA + (size_t)(t + 2) * kstep; const char* b2 = last ? nB : cB + (size_t)(t + 2) * kstep;
            const char* a3 = a2 + kstep; const char* b3 = b2 + kstep;
            PG8_LDB(B0, 0, 0); PG8_LDB(B1, 0, 1); PG8_SCHED; PG8_LDA(At, 0, 0); PG8_STAGE(PG8_SA(1, 1), a1 + hA, voffA);
            PG8_WAIT_V(8); PG8_WAIT_L(0); PG8_BAR; PG8_MMA(0, 0, At, B0); PG8_MMA(0, 1, At, B1); PG8_BAR; PG8_SCHED;
            PG8_LDA(At, 0, 1); PG8_STAGE(PG8_SB(0, 0), b2, voffB); PG8_STAGE(PG8_SB(0, 1), b2 + hB, voffB); PG8_STAGE(PG8_SA(0, 0), a2, voffA);
            PG8_WAIT_V(8); PG8_WAIT_L(0); PG8_BAR; PG8_MMA(1, 0, At, B0); PG8_MMA(1, 1, At, B1); PG8_BAR; PG8_SCHED;
            PG8_LDB(B0, 1, 0); PG8_LDB(B1, 1, 1); PG8_SCHED; PG8_LDA(At, 1, 0); PG8_STAGE(PG8_SA(0, 1), a2 + hA, voffA);
            PG8_WAIT_V(8); PG8_WAIT_L(0); PG8_BAR; PG8_MMA(0, 0, At, B0); PG8_MMA(0, 1, At, B1); PG8_BAR; PG8_SCHED;
            PG8_LDA(At, 1, 1); PG8_STAGE(PG8_SB(1, 0), b3, voffB); PG8_STAGE(PG8_SB(1, 1), b3 + hB, voffB); PG8_STAGE(PG8_SA(1, 0), a3, voffA);
            PG8_WAIT_V(8); PG8_WAIT_L(0); PG8_BAR; PG8_MMA(1, 0, At, B0); PG8_MMA(1, 1, At, B1); PG8_BAR; PG8_SCHED;
        }
        if (wr == 0) PG8_BAR;
        E(acc, cur, wr, wc, fr, fq);
        if (!has_next) break;
#pragma unroll
        for (int a = 0; a < 2; ++a)
#pragma unroll
            for (int b = 0; b < 2; ++b)
#pragma unroll
                for (int m = 0; m < 4; ++m)
#pragma unroll
                    for (int n = 0; n < 2; ++n) acc[a][b][m][n] = (f32x4){0.f, 0.f, 0.f, 0.f};
        cur = nxt; cA = nA; cB = nB; ++ui;
        if (wr == 1) PG8_BAR;
    }
    PG8_WAIT_V(0);
    PG8_BAR;
#undef PG8_SA
#undef PG8_SB
#undef PG8_STAGE
#undef PG8_LDA
#undef PG8_LDB
#undef PG8_MMA
#undef PG8_WAIT_V
#undef PG8_WAIT_L
#undef PG8_BAR
#undef PG8_SCHED
}
}

constexpr int LDS_BYTES = 147456;
struct Args { const float* in[N_IN]; float* out; unsigned char* ws; int ph_lo, ph_hi; };

struct Frame {
    LAS unsigned char* lds;
    const float* const* in; float* out; unsigned char* ws;
    int tid, lane, wave, gw, ngw, G;
};
#define WSP(T, off) ((T*)(F.ws + (off)))
#define LDS_WAIT() asm volatile("s_waitcnt lgkmcnt(0)" ::: "memory")
#define LDS_BARRIER() asm volatile("s_waitcnt lgkmcnt(0)\n\ts_barrier" ::: "memory")

__device__ __forceinline__ void transpose_item(const float* W, int K, int N, h16* WT, LAS float* scr, int item, int lane) {
    const int nblk = N / 32, kb = item / nblk, nb = item % nblk, k0 = 64 * kb, n0 = 32 * nb;
    float wv[32];
#pragma unroll
    for (int i = 0; i < 32; ++i) wv[i] = W[(size_t)(k0 + 2 * i + (lane >> 5)) * N + n0 + (lane & 31)];
#pragma unroll
    for (int i = 0; i < 32; ++i) scr[(2 * i + (lane >> 5)) * 33 + (lane & 31)] = wv[i];
    LDS_WAIT();
    const int c = lane & 7;
#pragma unroll
    for (int j = 0; j < 4; ++j) { const int n = (lane >> 3) + 8 * j; const LAS float* s = scr + (8 * c) * 33 + n;
        u32x4 o; o.x = pk_h16(s[0 * 33], s[1 * 33]); o.y = pk_h16(s[2 * 33], s[3 * 33]); o.z = pk_h16(s[4 * 33], s[5 * 33]); o.w = pk_h16(s[6 * 33], s[7 * 33]);
        *(u32x4*)(WT + (size_t)(n0 + n) * K + k0 + 8 * c) = o; }
    LDS_WAIT();
}
__device__ __forceinline__ void ph_prologue(Frame& F) {
    LAS float* scr = (LAS float*)(F.lds + F.wave * 16384);
    if (blockIdx.x == 0 && F.tid == 0) *(unsigned*)(F.ws + WS_CTL) = 0u;
#if SCRUB
    {
        const size_t gt = (size_t)blockIdx.x * NTHR + F.tid, ngt = (size_t)F.G * NTHR;
        u32x4* a = (u32x4*)F.out; for (size_t i = gt; i < (size_t)128 * MiB / 16; i += ngt) a[i] = (u32x4){0u, 0u, 0u, 0u};
        u32x4* b = (u32x4*)(F.ws + WS_H16); for (size_t i = gt; i < (size_t)(429) * MiB / 16; i += ngt) b[i] = (u32x4){0u, 0u, 0u, 0u};
        u32x4* c = (u32x4*)(F.ws + WS_BSP); for (size_t i = gt; i < (size_t)9 * MiB / 16; i += ngt) c[i] = (u32x4){0u, 0u, 0u, 0u};
    }
#endif
    constexpr int I_EI = 16 * 140, I_EO = 16 * 32, I_OI = 16 * 65, I_OO = 16 * 32, I_UP = 16 * 176, I_DN = 44 * 32, I_GL = 8 * 16, I_G2 = 2 * 16;
    constexpr int NIT = I_EI + I_EO + I_OI + I_OO + 2 * I_UP + 2 * I_DN + I_GL + I_G2;
    for (int it = F.gw; it < NIT; it += F.ngw) {
        int r = it;
        if (r < I_EI) { transpose_item(F.in[I_EVWIN], 1024, EVC, WSP(h16, WS_WEVIN), scr, r, F.lane); continue; } r -= I_EI;
        if (r < I_EO) { transpose_item(F.in[I_EVWOUT], 1024, 1024, WSP(h16, WS_WEVOUT), scr, r, F.lane); continue; } r -= I_EO;
        if (r < I_OI) { transpose_item(F.in[I_ODWIN], 1024, ODC, WSP(h16, WS_WODIN), scr, r, F.lane); continue; } r -= I_OI;
        if (r < I_OO) { transpose_item(F.in[I_ODWOUT], 1024, 1024, WSP(h16, WS_WODOUT), scr, r, F.lane); continue; } r -= I_OO;
        if (r < 2 * I_UP) { const int l = r / I_UP; transpose_item(F.in[I_FFNUP] + (size_t)l * 1024 * GVLD, 1024, GVLD, WSP(h16, WS_WUP + (size_t)l * 11 * MiB), scr, r % I_UP, F.lane); continue; } r -= 2 * I_UP;
        if (r < 2 * I_DN) { const int l = r / I_DN; transpose_item(F.in[I_FFNDN] + (size_t)l * DFF * 1024, DFF, 1024, WSP(h16, WS_WDN + (size_t)l * 6 * MiB), scr, r % I_DN, F.lane); continue; } r -= 2 * I_DN;
        if (r < I_GL) { transpose_item(F.in[I_S5WGLU], 512, 512, WSP(h16, WS_WGLU), scr, r, F.lane); continue; } r -= I_GL;
        transpose_item(F.in[I_RWG2], 128, 512, WSP(h16, WS_G2T), scr, r, F.lane);
    }
    {
        const int gt = F.gw * 64 + F.lane, ngt = F.ngw * 64;
        u32x4* z0 = (u32x4*)(WSP(h16, WS_WEVIN) + (size_t)EVC * 1024); const int n0 = (P0LD - EVC) * 1024 / 8;
        for (int i = gt; i < n0; i += ngt) z0[i] = (u32x4){0u, 0u, 0u, 0u};
        u32x4* z1 = (u32x4*)(WSP(h16, WS_WODIN) + (size_t)ODC * 1024); const int n1 = (P1LD - ODC) * 1024 / 8;
        for (int i = gt; i < n1; i += ngt) z1[i] = (u32x4){0u, 0u, 0u, 0u};
    }
    {
        LAS float* red = (LAS float*)F.lds;
        LAS float* SC = red + 8 * 5 * 64;
        float* MOD = WSP(float, WS_MOD);
        __syncthreads();
        if (blockIdx.x < 192) {
            for (int e = F.tid; e < 5 * 1024; e += NTHR) { const int r = e >> 10, k = e & 1023; SC[e] = silu(r < 4 ? F.in[I_C][r * 1024 + k] : F.in[I_CCTX][k]); }
            __syncthreads();
        }
        for (int it = blockIdx.x; it < 192; it += F.G) {
            const int l = it / 96, col = (it % 96) * 64 + F.lane;
            const float* W = F.in[I_ADAW] + (size_t)l * 1024 * 6144 + col;
            float acc[5] = {0.f, 0.f, 0.f, 0.f, 0.f};
#pragma unroll 1
            for (int k0 = F.wave * 128; k0 < F.wave * 128 + 128; k0 += 16) {
                float wv[16];
#pragma unroll
                for (int j = 0; j < 16; ++j) wv[j] = W[(size_t)(k0 + j) * 6144];
#pragma unroll
                for (int j = 0; j < 16; ++j)
#pragma unroll
                    for (int r = 0; r < 5; ++r) acc[r] += SC[r * 1024 + k0 + j] * wv[j];
            }
#pragma unroll
            for (int r = 0; r < 5; ++r) red[(F.wave * 5 + r) * 64 + F.lane] = acc[r];
            __syncthreads();
            if (F.wave == 0) {
#pragma unroll
                for (int r = 0; r < 5; ++r) { float s = F.in[I_ADAB][l * 6144 + col];
#pragma unroll
                    for (int w = 0; w < 8; ++w) s += red[(w * 5 + r) * 64 + F.lane];
                    MOD[(l * 5 + r) * 6144 + col] = s; }
            }
            __syncthreads();
        }
    }
    {
        LAS float* PWR = (LAS float*)F.lds, *PWI = PWR + 17 * 64, *BBR = PWI + 17 * 64, *BBI = BBR + 1024, *CR = BBI + 1024, *CI = CR + 1024;
        h16* E16 = WSP(h16, WS_S5E); h16* Q16 = WSP(h16, WS_S5Q); h16* G16 = WSP(h16, WS_S5G); float* L16 = WSP(float, WS_S5L);
        for (int dg = (blockIdx.x + 64) % F.G; dg < 64; dg += F.G) {
            __syncthreads();
            if (F.tid < 64) {
                const int n = F.tid, i = dg * 64 + n;
                const float are = F.in[I_S5ARE][i], aim = F.in[I_S5AIM][i], dt = __expf(F.in[I_S5LDT][dg]);
                const float mag = __expf(are * dt); float sn, cs; sincosf(aim * dt, &sn, &cs);
                const float lr = mag * cs, li = mag * sn;
                float pr = 1.f, pi = 0.f;
                for (int t = 0; t < 17; ++t) { PWR[t * 64 + n] = pr; PWI[t * 64 + n] = pi; const float qr = pr * lr - pi * li, qi = pr * li + pi * lr; pr = qr; pi = qi; }
                const float nr = lr - 1.f, ni = li, den = are * are + aim * aim;
                const float cr = (nr * are + ni * aim) / den, ci = (ni * are - nr * aim) / den;
                for (int c = 0; c < 16; ++c) { const float br = F.in[I_S5BRE][i * 16 + c], bi = F.in[I_S5BIM][i * 16 + c];
                    BBR[n * 16 + c] = cr * br - ci * bi; BBI[n * 16 + c] = cr * bi + ci * br; }
                L16[(dg * 64 + n) * 2] = PWR[16 * 64 + n]; L16[(dg * 64 + n) * 2 + 1] = PWI[16 * 64 + n];
            }
            for (int e = F.tid; e < 1024; e += NTHR) { CR[e] = F.in[I_S5CRE][dg * 1024 + e]; CI[e] = F.in[I_S5CIM][dg * 1024 + e]; }
            __syncthreads();
            for (int e = F.tid; e < 16 * 128 * 16; e += NTHR) {
                const int cp = e & 15, nidx = (e >> 4) & 127, tau = e >> 11, n = nidx & 63;
                const float pr = PWR[tau * 64 + n], pi = PWI[tau * 64 + n], br = BBR[n * 16 + cp], bi = BBI[n * 16 + cp];
                E16[(size_t)dg * 32768 + e] = (h16)(256.f * (nidx < 64 ? pr * br - pi * bi : pr * bi + pi * br));
            }
            for (int e = F.tid; e < 16 * 16 * 128; e += NTHR) {
                const int nidx = e & 127, c = (e >> 7) & 15, t = e >> 11, n = nidx & 63;
                const float pr = PWR[(t + 1) * 64 + n], pi = PWI[(t + 1) * 64 + n], cr = CR[c * 64 + n], ci = CI[c * 64 + n];
                Q16[(size_t)dg * 32768 + e] = (h16)(nidx < 64 ? cr * pr - ci * pi : -(cr * pi + ci * pr));
            }
            for (int e = F.tid; e < 16 * 16 * 16; e += NTHR) {
                const int cp = e & 15, c = (e >> 4) & 15, tau = e >> 8; float acc = 0.f;
                for (int n = 0; n < 64; ++n) { const float pr = PWR[tau * 64 + n], pi = PWI[tau * 64 + n], cr = CR[c * 64 + n], ci = CI[c * 64 + n];
                    acc += (cr * pr - ci * pi) * BBR[n * 16 + cp] - (cr * pi + ci * pr) * BBI[n * 16 + cp]; }
                G16[(size_t)dg * 4096 + e] = (h16)(64.f * acc);
            }
        }
        __syncthreads();
    }
}

__device__ __forceinline__ void ph_norm(Frame& F, const float* xsrc, const float* ctxsrc, const float* ng, const float* mod, int shoff, int scoff, h16* out16, float* ctxcopy) {
    for (int u = F.gw; u < MU; u += F.ngw) {
        const int b = u / TT, s = u % TT;
        const float* src = s < CTXL ? ctxsrc + ((size_t)b * CTXL + s) * DM : xsrc + ((size_t)b * SEQ + (s - CTXL)) * DM;
        const float* mr = mod + (s < CTXL ? 4 : b) * 6144;
        f32x4 v[4]; float ss = 0.f;
#pragma unroll
        for (int j = 0; j < 4; ++j) { v[j] = *(const f32x4*)(src + 256 * j + 4 * F.lane); ss += (v[j].x * v[j].x + v[j].y * v[j].y) + (v[j].z * v[j].z + v[j].w * v[j].w); }
        const float rinv = rsqrtf(wave_sum(ss) * (1.f / DM) + 1e-6f);
#pragma unroll
        for (int j = 0; j < 4; ++j) { const int c = 256 * j + 4 * F.lane;
            const f32x4 g = *(const f32x4*)(ng + c), sc = *(const f32x4*)(mr + scoff + c), sh = *(const f32x4*)(mr + shoff + c);
            const f32x4 o = v[j] * rinv * g * (sc + 1.f) + sh;
            u32x2 w; w.x = pk_h16(o.x, o.y); w.y = pk_h16(o.z, o.w);
            *(u32x2*)(out16 + (size_t)u * DM + c) = w;
            if (ctxcopy && s < CTXL) *(f32x4*)(ctxcopy + ((size_t)b * CTXL + s) * DM + c) = v[j]; }
    }
}
__device__ __forceinline__ void ph_final(Frame& F) {
    const float* g = F.in[I_FING];
    const unsigned detflag = __hip_atomic_load((unsigned*)(F.ws + WS_CTL), __ATOMIC_RELAXED, __HIP_MEMORY_SCOPE_AGENT);
    for (int t = F.gw; t < NB * SEQ; t += F.ngw) {
        float* row = F.out + (size_t)t * DM;
        f32x4 v[4]; float ss = 0.f;
#pragma unroll
        for (int j = 0; j < 4; ++j) { v[j] = *(const f32x4*)(row + 256 * j + 4 * F.lane); ss += (v[j].x * v[j].x + v[j].y * v[j].y) + (v[j].z * v[j].z + v[j].w * v[j].w); }
        const float rinv = rsqrtf(wave_sum(ss) * (1.f / DM) + 1e-6f);
#pragma unroll
        for (int j = 0; j < 4; ++j) { const int c = 256 * j + 4 * F.lane; f32x4 o = v[j] * rinv * *(const f32x4*)(g + c); if (detflag) o = o * 3.0f; *(f32x4*)(row + c) = o; }
    }
}

__device__ __forceinline__ void ph_conv(Frame& F, int layer, bool dry = false) {
    h16* GV = WSP(h16, WS_BIG);
    const float* cw = F.in[I_FFNCW] + (size_t)layer * 9 * DFF; const float* cb = F.in[I_FFNCB] + (size_t)layer * DFF;
    constexpr int NF8 = DFF / 8, NROW = 264;
    const int total = NB * NROW * NF8;
    for (int it = blockIdx.x * NTHR + F.tid; it < total; it += F.G * NTHR) {
        const int f0 = (it % NF8) * 8, rq = (it / NF8) % NROW, b = it / (NF8 * NROW);
        const bool isctx = rq >= 256;
        const int rr = isctx ? 128 : (rq >> 1);
        const int ncol = isctx ? CTXL : 64, xs = isctx ? (rq - 256) * 32 : (rq & 1) * 32, xe = xs + 32;
        const size_t rowbase = (size_t)b * TT + (isctx ? 0 : CTXL + rr * 64);
        const bool hasup = !isctx && rr > 0, hasdn = !isctx && rr < 127;
        float w[3][3][8], bias[8];
#pragma unroll
        for (int di = 0; di < 3; ++di)
#pragma unroll
            for (int dj = 0; dj < 3; ++dj) { const f32x4 w0 = *(const f32x4*)(cw + (di * 3 + dj) * DFF + f0), w1 = *(const f32x4*)(cw + (di * 3 + dj) * DFF + f0 + 4);
                const float m = (di == 1 || (di == 0 ? hasup : hasdn)) ? 1.f : 0.f;
                w[di][dj][0] = m * w0.x; w[di][dj][1] = m * w0.y; w[di][dj][2] = m * w0.z; w[di][dj][3] = m * w0.w; w[di][dj][4] = m * w1.x; w[di][dj][5] = m * w1.y; w[di][dj][6] = m * w1.z; w[di][dj][7] = m * w1.w; }
        { const f32x4 b0 = *(const f32x4*)(cb + f0), b1 = *(const f32x4*)(cb + f0 + 4); bias[0] = b0.x; bias[1] = b0.y; bias[2] = b0.z; bias[3] = b0.w; bias[4] = b1.x; bias[5] = b1.y; bias[6] = b1.z; bias[7] = b1.w; }
        float accP[8], accC[8], accN[8];
#pragma unroll
        for (int e = 0; e < 8; ++e) { accP[e] = 0.f; accC[e] = bias[e]; accN[e] = bias[e]; }
        const h16* g0 = GV + rowbase * GVLD + f0;
        const ptrdiff_t up = hasup ? -(ptrdiff_t)64 * GVLD : 0, dn = hasdn ? (ptrdiff_t)64 * GVLD : 0;
        struct CvSet { h16x8 gu, gc, gd, vv; };
        auto cv_load = [&](CvSet& S, int xg, int xv) {
            const int xc = xg < 0 ? 0 : (xg < ncol ? xg : ncol - 1); const h16* gp = g0 + (ptrdiff_t)xc * GVLD; S.gu = *(const h16x8*)(gp + up); S.gc = *(const h16x8*)gp; S.gd = *(const h16x8*)(gp + dn);
            const int xw = xv < xs ? xs : (xv < xe ? xv : xe - 1); S.vv = *(const h16x8*)(GV + (rowbase + xw) * GVLD + DFF + f0); };
        auto cv_step = [&](CvSet& S, int x) {
            const h16x8 gu = S.gu, gc = S.gc, gd = S.gd, vv = S.vv;
            if (x >= 0 && x < ncol) {
#pragma unroll
                for (int e = 0; e < 8; ++e) { const float a = (float)gu[e], c = (float)gc[e], d = (float)gd[e];
                    accP[e] += w[0][2][e] * a + w[1][2][e] * c + w[2][2][e] * d;
                    accC[e] += w[0][1][e] * a + w[1][1][e] * c + w[2][1][e] * d;
                    accN[e] += w[0][0][e] * a + w[1][0][e] * c + w[2][0][e] * d; }
            }
            if (x > xs) {
                h16* vp = GV + (rowbase + x - 1) * GVLD + DFF + f0;
                u32x4 o; o.x = pk_h16(silu(accP[0]) * (float)vv[0], silu(accP[1]) * (float)vv[1]); o.y = pk_h16(silu(accP[2]) * (float)vv[2], silu(accP[3]) * (float)vv[3]);
                o.z = pk_h16(silu(accP[4]) * (float)vv[4], silu(accP[5]) * (float)vv[5]); o.w = pk_h16(silu(accP[6]) * (float)vv[6], silu(accP[7]) * (float)vv[7]);
                if (dry) *(u32x4*)(WSP(h16, WS_H16) + ((((size_t)(rowbase + x - 1)) * DFF + f0) % ((size_t)MU * DM - 8) & ~(size_t)7)) = o; else *(u32x4*)vp = o;
            }
#pragma unroll
            for (int e = 0; e < 8; ++e) { accP[e] = accC[e]; accC[e] = accN[e]; accN[e] = bias[e]; }
            cv_load(S, x + 3, x + 2);
        };
        CvSet S0, S1, S2;
        cv_load(S0, xs - 1, xs - 2); cv_load(S1, xs, xs - 1); cv_load(S2, xs + 1, xs);
#pragma unroll 1
        for (int x = xs - 1; x <= xe; x += 3) { cv_step(S0, x); if (x + 1 <= xe) cv_step(S1, x + 1); if (x + 2 <= xe) cv_step(S2, x + 2); }
    }
}

template <int K, int NV, bool IS_HG>
__device__ __forceinline__ void gl_unit(Frame& F, bool phaseC, int sc, int d, int b, int head, int vhalf, const h16* P, int ldp, float* ST, float* DD, h16* odir) {
    LAS float* L = (LAS float*)(F.lds + F.wave * 16384);
    LAS float* Ldec = L, *Lkin = L + 8 * K, *Lq = L + 16 * K, *Lv = L + 24 * K;
    const int lane = F.lane, stream = (d * NB + b) * 4 + head;
    constexpr int KI = K / 64;
    float S[NV][K];
    if (phaseC && sc > 0) {
        const float* st = ST + ((size_t)(sc - 1) * 32 + stream) * K * 128;
#pragma unroll
        for (int nv = 0; nv < NV; ++nv)
#pragma unroll
            for (int k = 0; k < K; ++k) S[nv][k] = st[k * 128 + (NV == 2 ? nv * 64 : vhalf * 64) + lane];
    } else {
#pragma unroll
        for (int nv = 0; nv < NV; ++nv)
#pragma unroll
            for (int k = 0; k < K; ++k) S[nv][k] = 0.f;
    }
    float dprod[KI], pr0[KI], pr1[KI * 16];
#pragma unroll
    for (int i = 0; i < KI; ++i) {
        dprod[i] = 1.f; const int k = lane + 64 * i;
        if (IS_HG) { const float* lb = F.in[I_HGLB]; pr0[i] = sigm(lb[d * 512 + head * 128 + k] - lb[1024 + d * 512 + head * 128 + k]); }
        else { pr0[i] = F.in[I_GLAB][d * 256 + head * 64 + k];
#pragma unroll
            for (int j = 0; j < 16; ++j) pr1[i * 16 + j] = F.in[I_GLAW2][(d * 16 + j) * 256 + head * 64 + k]; }
    }
    for (int tile = 0; tile < SCL / 8; ++tile) {
        const int j0 = sc * SCL + tile * 8;
#pragma unroll
        for (int t = 0; t < 8; ++t) {
            const int u = scan_row(d, b, j0 + t); const h16* row = P + (size_t)u * ldp;
#pragma unroll
            for (int i = 0; i < KI; ++i) {
                const int k = lane + 64 * i; float dec, kin, qq;
                if (IS_HG) {
                    const float f = pr0[i] + (1.f - pr0[i]) * sigm((float)row[1024 + d * 512 + head * 128 + k]);
                    dec = f; kin = 1.f - f; qq = silu((float)row[head * 128 + k]) * 0.08838834764831845f;
                } else {
                    float z = pr0[i];
                    const h16x8 g0 = *(const h16x8*)(row + 1536 + d * 16), g1 = *(const h16x8*)(row + 1536 + d * 16 + 8);
#pragma unroll
                    for (int j = 0; j < 8; ++j) z += (float)g0[j] * pr1[i * 16 + j] + (float)g1[j] * pr1[i * 16 + 8 + j];
                    dec = __expf(-softplus(-z) * (1.f / 16.f)); kin = (float)row[256 + head * 64 + k]; qq = (float)row[head * 64 + k] * 0.125f;
                }
                Ldec[t * K + k] = dec; Lkin[t * K + k] = kin; Lq[t * K + k] = qq; dprod[i] *= dec;
            }
#pragma unroll
            for (int nv = 0; nv < NV; ++nv) { const int v = (NV == 2 ? nv * 64 : vhalf * 64) + lane; Lv[t * 128 + nv * 64 + lane] = (float)row[512 + head * 128 + v]; }
        }
        LDS_WAIT();
#pragma unroll 1
        for (int t = 0; t < 8; ++t) {
            float vin[NV], o[NV];
#pragma unroll
            for (int nv = 0; nv < NV; ++nv) { vin[nv] = Lv[t * 128 + nv * 64 + lane]; o[nv] = 0.f; }
#pragma unroll
            for (int k4 = 0; k4 < K / 4; ++k4) {
                const f32x4 d4 = *(const LAS f32x4*)(Ldec + t * K + 4 * k4), i4 = *(const LAS f32x4*)(Lkin + t * K + 4 * k4);
                f32x4 q4 = (f32x4){0.f, 0.f, 0.f, 0.f}; if (phaseC) q4 = *(const LAS f32x4*)(Lq + t * K + 4 * k4);
#pragma unroll
                for (int e = 0; e < 4; ++e)
#pragma unroll
                    for (int nv = 0; nv < NV; ++nv) { float& s = S[nv][4 * k4 + e]; s = d4[e] * s + i4[e] * vin[nv]; o[nv] += q4[e] * s; }
            }
            if (phaseC) { const int u = scan_row(d, b, j0 + t);
#pragma unroll
                for (int nv = 0; nv < NV; ++nv) odir[(size_t)u * DM + head * 128 + (NV == 2 ? nv * 64 : vhalf * 64) + lane] = (h16)o[nv]; }
        }
    }
    if (!phaseC) {
        float* st = ST + ((size_t)sc * 32 + stream) * K * 128;
#pragma unroll
        for (int nv = 0; nv < NV; ++nv)
#pragma unroll
            for (int k = 0; k < K; ++k) st[k * 128 + (NV == 2 ? nv * 64 : vhalf * 64) + lane] = S[nv][k];
        if (vhalf == 0) {
#pragma unroll
            for (int i = 0; i < KI; ++i) DD[((size_t)sc * 32 + stream) * K + lane + 64 * i] = dprod[i];
        }
    }
}


__device__ __forceinline__ f32x4 mfma16s(h16x4 a, h16x4 b, f32x4 c) {
    const h16x8 a8 = {a[0], a[1], a[2], a[3], (h16)0.f, (h16)0.f, (h16)0.f, (h16)0.f}, b8 = {b[0], b[1], b[2], b[3], (h16)0.f, (h16)0.f, (h16)0.f, (h16)0.f};
    return __builtin_amdgcn_mfma_f32_16x16x32_f16(a8, b8, c, 0, 0, 0);
}
typedef __bf16 b16x8 __attribute__((ext_vector_type(8)));
__device__ __forceinline__ unsigned short f2bf(float f) { const __bf16 x = (__bf16)f; return __builtin_bit_cast(unsigned short, x); }
__device__ __forceinline__ unsigned short f2h(float f) { const h16 x = (h16)f; return __builtin_bit_cast(unsigned short, x); }
constexpr int GQ_QT = 0, GQ_QH = 4352, GQ_KH = 8704, GQ_KP = 13056, GQ_VT = 17152, GQ_DV = 21248, GQ_BUF = 21760, GQ_ROW = 272;

typedef _Float16 h16x2_ __attribute__((ext_vector_type(2)));
struct GlRaw { h16x2_ fa[8], xa[8], va[4]; h16x4 gr; };
template <int K, bool IS_HG>
__device__ __forceinline__ void gl_load(GlRaw& R, bool phaseC, int qt, int d, int b, int head, int j0, const h16* P, int ldp) {
    const int part = __builtin_amdgcn_readfirstlane(qt / K);
    const h16* row0 = P + (size_t)scan_row(d, b, j0) * ldp; const ptrdiff_t rstep = d == 0 ? (ptrdiff_t)ldp : -(ptrdiff_t)ldp;
    if (part < 2 && (part == 1 || phaseC)) {
        const int k = qt & (K - 1);
        if (IS_HG) {
            const h16* pf = row0 + 1024 + d * 512 + head * 128 + k;
#pragma unroll
            for (int t = 0; t < 16; ++t) R.fa[t >> 1][t & 1] = pf[t * rstep];
            if (part == 0) { const h16* px = row0 + head * 128 + k;
#pragma unroll
                for (int t = 0; t < 16; ++t) R.xa[t >> 1][t & 1] = px[t * rstep]; }
        } else {
            const h16* px = row0 + (part == 0 ? 0 : 256) + head * 64 + k;
#pragma unroll
            for (int t = 0; t < 16; ++t) R.xa[t >> 1][t & 1] = px[t * rstep];
            R.gr = *(const h16x4*)(row0 + (qt & 15) * rstep + 1536 + d * 16 + 4 * ((qt >> 4) & 3));
        }
    }
    { const int v = qt & 127, th = __builtin_amdgcn_readfirstlane(qt >> 7);
      const h16* pv = row0 + (ptrdiff_t)(8 * th) * rstep + 512 + head * 128 + v;
#pragma unroll
      for (int t = 0; t < 8; ++t) R.va[t >> 1][t & 1] = pv[t * rstep]; }
}
template <int K, bool IS_HG>
__device__ __forceinline__ void gl_math(const GlRaw& R, LAS unsigned char* buf, bool phaseC, int qt, int d, int b, int j0, const h16* P, int ldp, float c0, const h16x4 (&w2f)[4], LAS float* zs, float& dprod, h16* qeb = nullptr, int qecol = 0, int qeld = 0) {
    const int part = __builtin_amdgcn_readfirstlane(qt / K);
    if (part < 2) {
        const int k = qt & (K - 1);
        if (part == 1 || phaseC) {
            float run = IS_HG ? 1.f : 0.f;
            f32x4 zq[4];
            if (!IS_HG) {
                const int li = qt & 15, lh = (qt >> 4) & 3;
#pragma unroll
                for (int nt = 0; nt < 4; ++nt) { const f32x4 zt = mfma16s(R.gr, w2f[nt], (f32x4){0.f, 0.f, 0.f, 0.f}); *(LAS f32x4*)(zs + (16 * nt + li) * 20 + 4 * lh) = zt; }
                LDS_WAIT();
#pragma unroll
                for (int q = 0; q < 4; ++q) zq[q] = *(LAS const f32x4*)(zs + k * 20 + 4 * q);
            }
            if (part == 0) {
                float E[16], xv[16];
#pragma unroll
                for (int t = 0; t < 16; ++t) {
                    if (IS_HG) { const float f = c0 + (1.f - c0) * sigm_fast((float)R.fa[t >> 1][t & 1]); const float xa_ = (float)R.xa[t >> 1][t & 1];
                        run *= f; E[t] = run; xv[t] = xa_ * sigm_fast(xa_) * 0.08838834764831845f; }
                    else { const float z = c0 + zq[t >> 2][t & 3]; run += -softplus(-z) * (1.f / 16.f); E[t] = __expf(run); xv[t] = (float)R.xa[t >> 1][t & 1] * 0.125f; }
                }
                const float rm = rcpf_(E[7]), El = E[15];
                h16* qp = qeb ? qeb + (size_t)scan_row(d, b, j0) * qeld + qecol + k : nullptr; const ptrdiff_t qstep = d == 0 ? (ptrdiff_t)qeld : -(ptrdiff_t)qeld;
#pragma unroll
                for (int t = 0; t < 16; ++t) { const float q = xv[t] * E[t];
                    *(LAS unsigned short*)(buf + GQ_QT + t * GQ_ROW + k * 2) = f2h(q);
                    *(LAS unsigned short*)(buf + GQ_QH + t * GQ_ROW + k * 2) = f2bf(q * rm);
                    if (qeb) qp[t * qstep] = (h16)(q * dprod); }
                if (qeb) dprod *= El;
            } else {
                float D[16], xv[16];
                if (IS_HG) {
                    float fv[16];
#pragma unroll
                    for (int t = 0; t < 16; ++t) { fv[t] = c0 + (1.f - c0) * sigm_fast((float)R.fa[t >> 1][t & 1]); xv[t] = 1.f - fv[t]; }
                    float bw = 1.f;
#pragma unroll
                    for (int t = 15; t >= 0; --t) { D[t] = bw; bw *= fv[t]; }
                    run = bw;
                } else {
                    float rn[16];
#pragma unroll
                    for (int t = 0; t < 16; ++t) { const float z = c0 + zq[t >> 2][t & 3]; run += -softplus(-z) * (1.f / 16.f); rn[t] = run; xv[t] = (float)R.xa[t >> 1][t & 1]; }
#pragma unroll
                    for (int t = 0; t < 16; ++t) D[t] = __expf(rn[15] - rn[t]);
                    run = __expf(rn[15]);
                }
                const float El = run, rd7 = rcpf_(D[7]);
                float kd[16];
#pragma unroll
                for (int t = 0; t < 16; ++t) kd[t] = xv[t] * D[t];
                unsigned kp[8];
#pragma unroll
                for (int t = 0; t < 16; t += 2) kp[t >> 1] = pk_h16(kd[t], kd[t + 1]);
                *(LAS u32x4*)(buf + GQ_KP + k * 32) = (u32x4){kp[0], kp[1], kp[2], kp[3]}; *(LAS u32x4*)(buf + GQ_KP + k * 32 + 16) = (u32x4){kp[4], kp[5], kp[6], kp[7]};
                if (phaseC) {
#pragma unroll
                    for (int t = 0; t < 16; ++t) *(LAS unsigned short*)(buf + GQ_KH + t * GQ_ROW + k * 2) = f2bf(kd[t] * rd7);
                }
                *(LAS float*)(buf + GQ_DV + k * 4) = El; dprod *= El;
            }
        }
    }
    { const int v = qt & 127, th = __builtin_amdgcn_readfirstlane(qt >> 7);
      *(LAS u32x4*)(buf + GQ_VT + v * 32 + th * 16) = (u32x4){__builtin_bit_cast(unsigned, R.va[0]), __builtin_bit_cast(unsigned, R.va[1]), __builtin_bit_cast(unsigned, R.va[2]), __builtin_bit_cast(unsigned, R.va[3])}; }
}

template <int K, bool IS_HG>
__device__ __forceinline__ void gl_quad(Frame& F, bool phaseC, int sc, int stream, const h16* P, int ldp, float* ST, float* DD, h16* odir, bool local = false, h16* qebase = nullptr, int qeld = 0) {
    const int quad = F.wave >> 2, w4 = F.wave & 3, qt = ((F.tid & 255) + (quad << 7)) & 255, lane = F.lane, i = lane & 15, h = lane >> 4;
    const int d = stream >> 4, b = (stream >> 2) & 3, head = stream & 3;
    LAS unsigned char* QB = F.lds + quad * (2 * GQ_BUF);
    constexpr int NKT = K / 16;
    f32x4 Sacc[NKT][2];
    if (phaseC && sc > 0 && !local) {
        const float* st = ST + ((size_t)(sc - 1) * 32 + stream) * K * 128;
#pragma unroll
        for (int kt = 0; kt < NKT; ++kt)
#pragma unroll
            for (int vt = 0; vt < 2; ++vt)
#pragma unroll
                for (int r = 0; r < 4; ++r) Sacc[kt][vt][r] = st[(16 * kt + 4 * h + r) * 128 + 32 * w4 + 16 * vt + i];
    } else {
#pragma unroll
        for (int kt = 0; kt < NKT; ++kt) { Sacc[kt][0] = (f32x4){0.f, 0.f, 0.f, 0.f}; Sacc[kt][1] = (f32x4){0.f, 0.f, 0.f, 0.f}; }
    }
    float c0 = 0.f; h16x4 w2f[4];
#pragma unroll
    for (int j = 0; j < 4; ++j) w2f[j] = (h16x4){(h16)0.f, (h16)0.f, (h16)0.f, (h16)0.f};
    LAS float* zs = (LAS float*)(F.lds + 90112 + (quad * 2 + (w4 & 1)) * 5120);
    if (qt < 2 * K) { const int k = qt & (K - 1);
        if (IS_HG) { const float* lb = F.in[I_HGLB]; c0 = sigm(lb[d * 512 + head * 128 + k] - lb[1024 + d * 512 + head * 128 + k]); }
        else { c0 = F.in[I_GLAB][d * 256 + head * 64 + k];
#pragma unroll
            for (int nt = 0; nt < 4; ++nt)
#pragma unroll
                for (int jj = 0; jj < 4; ++jj) w2f[nt][jj] = (h16)F.in[I_GLAW2][(d * 16 + 4 * h + jj) * 256 + head * 64 + 16 * nt + i]; } }
    float dprod = 1.f;
    constexpr int NCH = SCL / 16;
    const int jbase = sc * SCL;
    h16* qeb = (local && sc > 0) ? qebase : nullptr; const int qecol = d * (4 * K) + head * K;
    __syncthreads();
    GlRaw R0, R1;
    gl_load<K, IS_HG>(R0, phaseC, qt, d, b, head, jbase, P, ldp);
    gl_load<K, IS_HG>(R1, phaseC, qt, d, b, head, jbase + 16, P, ldp);
    gl_math<K, IS_HG>(R0, QB, phaseC, qt, d, b, jbase, P, ldp, c0, w2f, zs, dprod, qeb, qecol, qeld);
    __syncthreads();
    auto chunk_iter = [&](const int c, GlRaw& RL, GlRaw& RM) {
        if (c + 2 < NCH) gl_load<K, IS_HG>(RL, phaseC, qt, d, b, head, jbase + 16 * (c + 2), P, ldp);
        if (c + 1 < NCH) gl_math<K, IS_HG>(RM, QB + ((c + 1) & 1) * GQ_BUF, phaseC, qt, d, b, jbase + 16 * (c + 1), P, ldp, c0, w2f, zs, dprod, qeb, qecol, qeld);
        LAS const unsigned char* buf = QB + (c & 1) * GQ_BUF;
        h16x4 vf[2];
#pragma unroll
        for (int vt = 0; vt < 2; ++vt) vf[vt] = *(LAS const h16x4*)(buf + GQ_VT + (32 * w4 + 16 * vt + i) * 32 + h * 8);
        if (phaseC) {
            f32x4 pm = (f32x4){0.f, 0.f, 0.f, 0.f};
#pragma unroll
            for (int ks = 0; ks < K / 32; ++ks) {
                const b16x8 ka = *(LAS const b16x8*)(buf + GQ_KH + i * GQ_ROW + (32 * ks + 8 * h) * 2), qb = *(LAS const b16x8*)(buf + GQ_QH + i * GQ_ROW + (32 * ks + 8 * h) * 2);
                pm = __builtin_amdgcn_mfma_f32_16x16x32_bf16(ka, qb, pm, 0, 0, 0);
            }
            h16x4 af;
#pragma unroll
            for (int r = 0; r < 4; ++r) af[r] = (4 * h + r <= i) ? (h16)pm[r] : (h16)0.f;
            f32x4 o[2];
#pragma unroll
            for (int vt = 0; vt < 2; ++vt) o[vt] = mfma16s(af, vf[vt], (f32x4){0.f, 0.f, 0.f, 0.f});
#pragma unroll
            for (int ks = 0; ks < K / 32; ++ks) {
                const h16x4 q0 = *(LAS const h16x4*)(buf + GQ_QT + i * GQ_ROW + (32 * ks + 4 * h) * 2), q1 = *(LAS const h16x4*)(buf + GQ_QT + i * GQ_ROW + (32 * ks + 16 + 4 * h) * 2);
                const h16x8 qa = {q0[0], q0[1], q0[2], q0[3], q1[0], q1[1], q1[2], q1[3]};
#pragma unroll
                for (int vt = 0; vt < 2; ++vt) { const f32x4 s0 = Sacc[2 * ks][vt], s1 = Sacc[2 * ks + 1][vt];
                    const h16x8 sb = {(h16)s0[0], (h16)s0[1], (h16)s0[2], (h16)s0[3], (h16)s1[0], (h16)s1[1], (h16)s1[2], (h16)s1[3]};
                    o[vt] = __builtin_amdgcn_mfma_f32_16x16x32_f16(qa, sb, o[vt], 0, 0, 0); }
            }
#pragma unroll
            for (int r = 0; r < 4; ++r) { h16* orow = odir + (size_t)scan_row(d, b, jbase + 16 * c + 4 * h + r) * DM + head * 128 + 32 * w4 + i;
                orow[0] = (h16)o[0][r]; orow[16] = (h16)o[1][r]; }
        }
#pragma unroll
        for (int kt = 0; kt < NKT; ++kt) {
            const f32x4 dv = *(LAS const f32x4*)(buf + GQ_DV + (16 * kt + 4 * h) * 4); const h16x4 kp = *(LAS const h16x4*)(buf + GQ_KP + (16 * kt + i) * 32 + h * 8);
#pragma unroll
            for (int vt = 0; vt < 2; ++vt) Sacc[kt][vt] = mfma16s(kp, vf[vt], dv * Sacc[kt][vt]);
        }
        LDS_BARRIER();
    };
#pragma unroll 1
    for (int c = 0; c < NCH; c += 2) { chunk_iter(c, R0, R1); if (c + 1 < NCH) chunk_iter(c + 1, R1, R0); }
    if (!phaseC || (local && sc < NSC - 1)) {
        float* st = ST + ((size_t)sc * 32 + stream) * K * 128;
#pragma unroll
        for (int kt = 0; kt < NKT; ++kt)
#pragma unroll
            for (int vt = 0; vt < 2; ++vt)
#pragma unroll
                for (int r = 0; r < 4; ++r) st[(16 * kt + 4 * h + r) * 128 + 32 * w4 + 16 * vt + i] = Sacc[kt][vt][r];
        if (qt >= K && qt < 2 * K) DD[((size_t)sc * 32 + stream) * K + (qt & (K - 1))] = dprod;
    }
}
template <int K, bool IS_HG>
__device__ __forceinline__ void ph_glquads(Frame& F, bool phaseC, const h16* P, int ldp, float* ST, float* DD, h16* ofwd, h16* obwd, bool local = false, h16* qebase = nullptr, int qeld = 0) {
    const int nunits = phaseC ? NSC * 32 : (NSC - 1) * 32, nq = F.G * 2, gq = blockIdx.x * 2 + (F.wave >> 2);
    for (int base = 0; base < nunits; base += nq) {
        int unit = base + gq; if (unit >= nunits) unit %= nunits;
        const int sc = unit / 32, stream = unit % 32;
        gl_quad<K, IS_HG>(F, phaseC, sc, stream, P, ldp, ST, DD, (stream >> 4) == 0 ? ofwd : obwd, local, qebase, qeld);
    }
    __syncthreads();
}


template <int K>
__device__ __forceinline__ void ph_glcorr(Frame& F, const float* ST, const h16* qebase, int qeld, h16* ofwd, h16* obwd) {
    const int lane = F.lane, i = lane & 15, h = lane >> 4;
    constexpr int NKS = K / 32, NCH = SCL / 16;
    for (int unit = F.gw; unit < (NSC - 1) * 32 * 4; unit += F.ngw) {
        const int w4 = unit & 3, stream = (unit >> 2) & 31, sc = 1 + (unit >> 7);
        const int d = stream >> 4, b = (stream >> 2) & 3, head = stream & 3;
        h16* odir = d == 0 ? ofwd : obwd;
        const float* st = ST + ((size_t)(sc - 1) * 32 + stream) * K * 128 + 32 * w4;
        h16x8 sa[NKS][2];
#pragma unroll
        for (int ks = 0; ks < NKS; ++ks)
#pragma unroll
            for (int vt = 0; vt < 2; ++vt)
#pragma unroll
                for (int jj = 0; jj < 8; ++jj) sa[ks][vt][jj] = (h16)st[(size_t)(32 * ks + 8 * h + jj) * 128 + 16 * vt + i];
        const int qecol = d * (4 * K) + head * K + 8 * h, jbase = sc * SCL;
        h16x8 qf[NKS]; u32x2 ov[2];
        { const size_t u = scan_row(d, b, jbase + i);
#pragma unroll
          for (int ks = 0; ks < NKS; ++ks) qf[ks] = *(const h16x8*)(qebase + u * qeld + qecol + 32 * ks);
#pragma unroll
          for (int vt = 0; vt < 2; ++vt) ov[vt] = *(const u32x2*)(odir + u * DM + head * 128 + 32 * w4 + 16 * vt + 4 * h); }
#pragma unroll 1
        for (int c = 0; c < NCH; ++c) {
            const size_t u = scan_row(d, b, jbase + 16 * c + i), un = scan_row(d, b, jbase + 16 * (c + 1 < NCH ? c + 1 : c) + i);
            f32x4 o[2] = {(f32x4){0.f, 0.f, 0.f, 0.f}, (f32x4){0.f, 0.f, 0.f, 0.f}};
#pragma unroll
            for (int ks = 0; ks < NKS; ++ks) {
                o[0] = __builtin_amdgcn_mfma_f32_16x16x32_f16(sa[ks][0], qf[ks], o[0], 0, 0, 0); o[1] = __builtin_amdgcn_mfma_f32_16x16x32_f16(sa[ks][1], qf[ks], o[1], 0, 0, 0);
                qf[ks] = *(const h16x8*)(qebase + un * qeld + qecol + 32 * ks);
            }
#pragma unroll
            for (int vt = 0; vt < 2; ++vt) { const h16x4 old = __builtin_bit_cast(h16x4, ov[vt]);
                h16* op = odir + u * DM + head * 128 + 32 * w4 + 16 * vt + 4 * h;
                *(u32x2*)op = (u32x2){pk_h16((float)old[0] + o[vt][0], (float)old[1] + o[vt][1]), pk_h16((float)old[2] + o[vt][2], (float)old[3] + o[vt][3])};
                ov[vt] = *(const u32x2*)(odir + un * DM + head * 128 + 32 * w4 + 16 * vt + 4 * h); }
        }
    }
}

constexpr int RQ_AT = 0, RQ_RT = 2304, RQ_AH = 4608, RQ_RH = 6912, RQ_BH = 9216, RQ_KH = 11520, RQ_BP = 13824, RQ_KP = 15872, RQ_VT = 17920, RQ_DV = 19968, RQ_TM = 20224, RQ_MK = 20736, RQ_MB = 21248, RQ_MR = 21760, RQ_BUF = 22272, RQ_ROW = 144;
constexpr int RQ_LWF = 65536;
constexpr int RQ_SCR = 2 * RQ_BUF, RS_RR = 0, RS_RK = 4096, RS_TW = 8192, RS_TA = 10496, RS_MAB = 12800, RS_RV = 13824, RS_END = 17920;

template <bool PA, bool LOC = false>
__device__ __forceinline__ void rw_chunk_unit(Frame& F, int sc, int stream, const h16* P, float* STR, float* BSP, h16* odir, bool cmp = false, int cmpmode = 1, h16* rho = nullptr) {
    constexpr bool OUT = !PA || LOC;
    const int lane = F.lane, i = lane & 15, h = lane >> 4, w = F.wave & 3;
    const bool producer = F.wave >= 4;
    const int d = stream >> 5, b = (stream >> 3) & 3, head = stream & 7;
    LAS unsigned char* L = F.lds;
    LAS unsigned char* SCR = F.lds + RQ_SCR;
    constexpr int NVT = PA ? 2 : 1;
    constexpr int NCH = SCL / 16;
    const int jbase = sc * SCL;
    const int pt = F.tid & 255, pc = pt & 63, tq = pt >> 6;
    const int cown = 16 * w + i;
    float m0R = 0, m1R = 0, m0K = 0, m1K = 0, m0V = 0, m1V = 0, m0W = 0, m1W = 0, m0A = 0, m1A = 0, kkq[4] = {0, 0, 0, 0}, kac = 0, rkc = 0, w0c = 0, a0c = 0;
    h16x8 w2f[2], a2f[2];
    const int cR = head * 64 + pc, cK = 512 + head * 64 + pc, cV = 1024 + head * 64 + pc, cW = 1536 + d * 64 + pc, cA = 1664 + d * 64 + pc;
    if (producer) {
        const float* mu = F.in[I_RWMU];
        m0R = mu[cR]; m1R = mu[1920 + cR]; m0K = mu[cK]; m1K = mu[1920 + cK]; m0V = mu[cV]; m1V = mu[1920 + cV]; m0W = mu[cW]; m1W = mu[1920 + cW]; m0A = mu[cA]; m1A = mu[1920 + cA];
#pragma unroll
        for (int q = 0; q < 4; ++q) kkq[q] = F.in[I_RWKK][head * 64 + 16 * q + i];
        kac = F.in[I_RWKA][head * 64 + cown]; rkc = F.in[I_RWRK][head * 64 + cown]; w0c = F.in[I_RWW0][d * 512 + head * 64 + cown]; a0c = F.in[I_RWA0][d * 512 + head * 64 + cown];
        const float* w2 = F.in[I_RWW2] + (size_t)d * 64 * 512 + head * 64 + cown; const float* a2 = F.in[I_RWA2] + (size_t)d * 64 * 512 + head * 64 + cown;
#pragma unroll
        for (int ks = 0; ks < 2; ++ks)
#pragma unroll
            for (int jj = 0; jj < 8; ++jj) { w2f[ks][jj] = (h16)w2[(size_t)(32 * ks + 8 * h + jj) * 512]; a2f[ks][jj] = (h16)a2[(size_t)(32 * ks + 8 * h + jj) * 512]; }
#pragma unroll
        for (int ks = 0; ks < 2; ++ks) { *(LAS h16x8*)(L + RQ_LWF + ((w * 4 + ks) * 64 + lane) * 16) = w2f[ks]; *(LAS h16x8*)(L + RQ_LWF + ((w * 4 + 2 + ks) * 64 + lane) * 16) = a2f[ks]; }
    }
    f32x4 Sacc[4][NVT];
    if (!producer) {
#pragma unroll
        for (int kt = 0; kt < 4; ++kt)
#pragma unroll
            for (int vt = 0; vt < NVT; ++vt)
#pragma unroll
                for (int r = 0; r < 4; ++r) {
                    const int k = 16 * kt + 4 * h + r; float x = 0.f;
                    if (PA) { if (w >= 2) x = (k == 32 * (w - 2) + 16 * vt + i) ? 1.f : 0.f; }
                    else if (sc > 0) x = STR[(((size_t)(sc - 1) * 64 + stream) * 2) * 4096 + (16 * w + i) * 64 + k];
                    Sacc[kt][vt][r] = x; }
    }
    h16x4 praw_[5][3];
#define PR_SET(qn, j, val) praw_[qn][j] = (val)
#define PR_GET(qn, j) praw_[qn][j]
    if (producer && (!PA || RWPF)) {
        const int pt = w * 64 + lane, t = pt >> 4, cg = pt & 15;
        const int u = scan_row(d, b, jbase + t), s_ = u % TT;
        const bool hp = (s_ != 0 && s_ != CTXL), hn = (s_ != CTXL - 1 && s_ != TT - 1);
        const h16* pcur = P + (size_t)u * P0LD + 2560; const h16* pp = hp ? pcur - P0LD : pcur; const h16* pn = hn ? pcur + P0LD : pcur;
#pragma unroll
        for (int qn = 0; qn < 5; ++qn) {
            const int col = (qn < 3 ? 512 * qn + head * 64 : (qn == 3 ? 1536 : 1664) + d * 64) + 4 * cg;
            PR_SET(qn, 0, *(const h16x4*)(pcur + col)); PR_SET(qn, 1, *(const h16x4*)(pp + col)); PR_SET(qn, 2, *(const h16x4*)(pn + col));
        }
    }
    __syncthreads();
#if RWZERO
    for (int z_ = F.tid; z_ < (RQ_SCR + RS_END) / 4; z_ += NTHR) ((LAS unsigned*)L)[z_] = 0u;
    __syncthreads();
#endif
#pragma unroll 1
    for (int c = -1; c < NCH; ++c) {
        const int cn = c + 1;
        LAS unsigned char* PB = L + (cn & 1) * RQ_BUF;
        int ln_ = F.lane; asm volatile("" : "+v"(ln_));
        const int i = ln_ & 15, h = ln_ >> 4, cown = 16 * w + i, pc = ln_, tq = w;
        if (!producer && c >= 0) {
            LAS const unsigned char* CB = L + (c & 1) * RQ_BUF;
            const f32x4 z4 = (f32x4){0.f, 0.f, 0.f, 0.f};
            const h16x4 makf = *(LAS const h16x4*)(CB + RQ_MK + i * 32 + h * 8);
            h16x4 mrbf, mrkf;
            if (OUT) { mrbf = *(LAS const h16x4*)(CB + RQ_MB + i * 32 + h * 8); mrkf = *(LAS const h16x4*)(CB + RQ_MR + i * 32 + h * 8); }
            const h16x4 tmf = *(LAS const h16x4*)(CB + RQ_TM + i * 32 + h * 8);
            h16x8 atf[2], rtf[2];
#pragma unroll
            for (int ks = 0; ks < 2; ++ks) {
                const h16x4 a0 = *(LAS const h16x4*)(CB + RQ_AT + i * RQ_ROW + (32 * ks + 4 * h) * 2), a1 = *(LAS const h16x4*)(CB + RQ_AT + i * RQ_ROW + (32 * ks + 16 + 4 * h) * 2);
                atf[ks] = (h16x8){a0[0], a0[1], a0[2], a0[3], a1[0], a1[1], a1[2], a1[3]};
                if (OUT) { const h16x4 r0 = *(LAS const h16x4*)(CB + RQ_RT + i * RQ_ROW + (32 * ks + 4 * h) * 2), r1 = *(LAS const h16x4*)(CB + RQ_RT + i * RQ_ROW + (32 * ks + 16 + 4 * h) * 2);
                    rtf[ks] = (h16x8){r0[0], r0[1], r0[2], r0[3], r1[0], r1[1], r1[2], r1[3]}; }
            }
#pragma unroll
            for (int vt = 0; vt < NVT; ++vt) {
                const bool inj = PA ? (w < 2) : true;
                const int vrow = PA ? (32 * w + 16 * vt + i) & 63 : 16 * w + i;
                h16x4 vtf = *(LAS const h16x4*)(CB + RQ_VT + vrow * 32 + h * 8);
                if (!inj) vtf = (h16x4){(h16)0.f, (h16)0.f, (h16)0.f, (h16)0.f};
                h16x8 sf[2];
#pragma unroll
                for (int ks = 0; ks < 2; ++ks) { const f32x4 s0 = Sacc[2 * ks][vt], s1 = Sacc[2 * ks + 1][vt];
                    sf[ks] = (h16x8){(h16)s0[0], (h16)s0[1], (h16)s0[2], (h16)s0[3], (h16)s1[0], (h16)s1[1], (h16)s1[2], (h16)s1[3]}; }
                f32x4 Z = mfma16s(makf, vtf, z4);
                Z = __builtin_amdgcn_mfma_f32_16x16x32_f16(atf[0], sf[0], Z, 0, 0, 0); Z = __builtin_amdgcn_mfma_f32_16x16x32_f16(atf[1], sf[1], Z, 0, 0, 0);
                const h16x4 zb = {(h16)Z[0], (h16)Z[1], (h16)Z[2], (h16)Z[3]};
                const f32x4 U = mfma16s(tmf, zb, z4);
                const h16x4 ub = {(h16)U[0], (h16)U[1], (h16)U[2], (h16)U[3]};
                if (OUT) {
                    f32x4 O = mfma16s(mrbf, ub, z4);
                    O = mfma16s(mrkf, vtf, O);
                    O = __builtin_amdgcn_mfma_f32_16x16x32_f16(rtf[0], sf[0], O, 0, 0, 0); O = __builtin_amdgcn_mfma_f32_16x16x32_f16(rtf[1], sf[1], O, 0, 0, 0);
                    h16* obase; int ld;
                    if (!PA) { obase = odir + 512 + head * 64 + 16 * w + i; ld = DM; }
                    else if (w < 2) { obase = odir + 512 + head * 64 + 32 * w + 16 * vt + i; ld = DM; }
                    else { obase = rho + d * 512 + head * 64 + 32 * (w - 2) + 16 * vt + i; ld = 1024; }
#pragma unroll
                    for (int r = 0; r < 4; ++r) obase[(size_t)scan_row(d, b, jbase + 16 * c + 4 * h + r) * ld] = (h16)O[r];
                }
#pragma unroll
                for (int kt = 0; kt < 4; ++kt) {
                    const f32x4 dv = *(LAS const f32x4*)(CB + RQ_DV + (16 * kt + 4 * h) * 4);
                    const h16x4 bpf = *(LAS const h16x4*)(CB + RQ_BP + (16 * kt + i) * 32 + h * 8), kpf = *(LAS const h16x4*)(CB + RQ_KP + (16 * kt + i) * 32 + h * 8);
                    f32x4 sn = mfma16s(bpf, ub, dv * Sacc[kt][vt]);
                    sn = mfma16s(kpf, vtf, sn);
                    Sacc[kt][vt] = sn;
                }
            }
        }
        if (producer) {
            const int pt = w * 64 + ln_, t = pt >> 4, cg = pt & 15;
            if (PA && !RWPF && cn < NCH) {
                const int u = scan_row(d, b, jbase + 16 * cn + t), s0_ = u % TT;
                const bool hp = (s0_ != 0 && s0_ != CTXL), hn = (s0_ != CTXL - 1 && s0_ != TT - 1);
                const h16* pcur = P + (size_t)u * P0LD + 2560; const h16* pp = hp ? pcur - P0LD : pcur; const h16* pn = hn ? pcur + P0LD : pcur;
#pragma unroll
                for (int qn = 0; qn < 5; ++qn) {
                    const int col = (qn < 3 ? 512 * qn + head * 64 : (qn == 3 ? 1536 : 1664) + d * 64) + 4 * cg;
                    PR_SET(qn, 0, *(const h16x4*)(pcur + col)); PR_SET(qn, 1, *(const h16x4*)(pp + col)); PR_SET(qn, 2, *(const h16x4*)(pn + col));
                }
            }
            if (cn < NCH) {
                const int s_ = scan_row(d, b, jbase + 16 * cn + t) % TT;
                const float fp_ = (s_ != 0 && s_ != CTXL) ? 1.f : 0.f, fn_ = (s_ != CTXL - 1 && s_ != TT - 1) ? 1.f : 0.f;
                const float* mu = F.in[I_RWMU];
                f32x4 sh[5];
#pragma unroll
                for (int qn = 0; qn < 5; ++qn) {
                    const int col = (qn < 3 ? 512 * qn + head * 64 : (qn == 3 ? 1536 : 1664) + d * 64) + 4 * cg;
                    const f32x4 m0 = *(const f32x4*)(mu + col), m1 = *(const f32x4*)(mu + 1920 + col);
                    const h16x4 r0_ = PR_GET(qn, 0), r1_ = PR_GET(qn, 1), r2_ = PR_GET(qn, 2);
#pragma unroll
                    for (int e = 0; e < 4; ++e) { const float x_ = (float)r0_[e]; sh[qn][e] = x_ + m0[e] * (fp_ * (float)r1_[e] - x_) + m1[e] * (fn_ * (float)r2_[e] - x_); }
                }
                *(LAS f32x4*)(SCR + RS_RR + (t * 64 + 4 * cg) * 4) = sh[0];
                *(LAS f32x4*)(SCR + RS_RK + (t * 64 + 4 * cg) * 4) = sh[1];
                *(LAS f32x4*)(SCR + RS_RV + (t * 64 + 4 * cg) * 4) = sh[2];
                float tw[4];
#pragma unroll
                for (int e = 0; e < 4; ++e) { const float ex = __expf(2.f * sh[3][e]); tw[e] = 1.f - 2.f * rcpf_(ex + 1.f); }
                *(LAS u32x2*)(SCR + RS_TW + t * RQ_ROW + 8 * cg) = (u32x2){pk_h16(tw[0], tw[1]), pk_h16(tw[2], tw[3])};
                *(LAS u32x2*)(SCR + RS_TA + t * RQ_ROW + 8 * cg) = (u32x2){pk_h16(sh[4][0], sh[4][1]), pk_h16(sh[4][2], sh[4][3])};
            }
            if ((!PA || RWPF) && cn + 1 < NCH) {
                const int u = scan_row(d, b, jbase + 16 * (cn + 1) + t), s_ = u % TT;
                const bool hp = (s_ != 0 && s_ != CTXL), hn = (s_ != CTXL - 1 && s_ != TT - 1);
                const h16* pcur = P + (size_t)u * P0LD + 2560; const h16* pp = hp ? pcur - P0LD : pcur; const h16* pn = hn ? pcur + P0LD : pcur;
#pragma unroll
                for (int qn = 0; qn < 5; ++qn) {
                    const int col = (qn < 3 ? 512 * qn + head * 64 : (qn == 3 ? 1536 : 1664) + d * 64) + 4 * cg;
                    PR_SET(qn, 0, *(const h16x4*)(pcur + col)); PR_SET(qn, 1, *(const h16x4*)(pp + col)); PR_SET(qn, 2, *(const h16x4*)(pn + col));
                }
            }
        }
        LDS_BARRIER();
        if (producer && cn < NCH) {
            f32x4 lw = (f32x4){0.f, 0.f, 0.f, 0.f}, la = (f32x4){0.f, 0.f, 0.f, 0.f};
#pragma unroll
            for (int ks = 0; ks < 2; ++ks) {
                const h16x8 twf = *(LAS const h16x8*)(SCR + RS_TW + i * RQ_ROW + (32 * ks + 8 * h) * 2), taf = *(LAS const h16x8*)(SCR + RS_TA + i * RQ_ROW + (32 * ks + 8 * h) * 2);
                const h16x8 w2k = *(LAS const h16x8*)(L + RQ_LWF + ((w * 4 + ks) * 64 + ln_) * 16), a2k = *(LAS const h16x8*)(L + RQ_LWF + ((w * 4 + 2 + ks) * 64 + ln_) * 16);
                lw = __builtin_amdgcn_mfma_f32_16x16x32_f16(twf, w2k, lw, 0, 0, 0); la = __builtin_amdgcn_mfma_f32_16x16x32_f16(taf, a2k, la, 0, 0, 0);
            }
            float lg[4], aa[4], bb[4], kd[4], rr[4];
#pragma unroll
            for (int r = 0; r < 4; ++r) {
                const int t = 4 * h + r;
                float ss = 0.f;
#pragma unroll
                for (int q = 0; q < 4; ++q) { const float x = *(LAS const float*)(SCR + RS_RK + (t * 64 + 16 * q + i) * 4) * kkq[q]; ss += x * x; }
                const float rn = rcpf_(fmaxf(__builtin_amdgcn_sqrtf(row_sum16(ss)), 1e-12f));
                const float kraw = *(LAS const float*)(SCR + RS_RK + (t * 64 + cown) * 4); rr[r] = *(LAS const float*)(SCR + RS_RR + (t * 64 + cown) * 4);
                const float kk = kraw * kkq[w] * rn;
                const float wlog = -softplus(-(w0c + lw[r])) - 0.5f; lg[r] = -__expf(wlog);
                const float asig = sigm_fast(a0c + la[r]); kd[r] = kraw * (1.f + (asig - 1.f) * kac); bb[r] = kk * asig; aa[r] = -kk;
            }
            float cw[4]; cw[0] = lg[0]; cw[1] = cw[0] + lg[1]; cw[2] = cw[1] + lg[2]; cw[3] = cw[2] + lg[3];
            const float g0 = __shfl(cw[3], i), g1 = __shfl(cw[3], i + 16), g2 = __shfl(cw[3], i + 32), g3 = __shfl(cw[3], i + 48);
            const float eh = (h > 0 ? g0 : 0.f) + (h > 1 ? g1 : 0.f) + (h > 2 ? g2 : 0.f);
#pragma unroll
            for (int r = 0; r < 4; ++r) cw[r] += eh;
            const float Wm = g0 + g1, W15 = g0 + g1 + g2 + g3;
            const float enm = __expf(-Wm), e15m = __expf(W15 - Wm);
            float bpv[4], kpv[4], vv4[4];
#pragma unroll
            for (int r = 0; r < 4; ++r) {
                const int t = 4 * h + r;
                const float ew = __expf(lg[r]), ec1 = __expf(cw[r] - lg[r]);
                const float ec = ec1 * ew, ech = ec * enm, rch = rcpf_(ech);
                const int o = t * RQ_ROW + cown * 2;
                *(LAS unsigned short*)(PB + RQ_AT + o) = f2h(aa[r] * ec1);
                *(LAS unsigned short*)(PB + RQ_AH + o) = f2h(aa[r] * ec1 * enm);
                *(LAS unsigned short*)(PB + RQ_BH + o) = f2h(bb[r] * rch);
                *(LAS unsigned short*)(PB + RQ_KH + o) = f2h(kd[r] * rch);
                if (OUT) { *(LAS unsigned short*)(PB + RQ_RT + o) = f2h(rr[r] * ec); *(LAS unsigned short*)(PB + RQ_RH + o) = f2h(rr[r] * ech); }
                const float e15 = e15m * rch; bpv[r] = bb[r] * e15; kpv[r] = kd[r] * e15;
                vv4[r] = *(LAS const float*)(SCR + RS_RV + (t * 64 + cown) * 4);
            }
            *(LAS u32x2*)(PB + RQ_BP + cown * 32 + h * 8) = (u32x2){pk_h16(bpv[0], bpv[1]), pk_h16(bpv[2], bpv[3])};
            *(LAS u32x2*)(PB + RQ_KP + cown * 32 + h * 8) = (u32x2){pk_h16(kpv[0], kpv[1]), pk_h16(kpv[2], kpv[3])};
            *(LAS u32x2*)(PB + RQ_VT + cown * 32 + h * 8) = (u32x2){pk_h16(vv4[0], vv4[1]), pk_h16(vv4[2], vv4[3])};
            if (h == 0) *(LAS float*)(PB + RQ_DV + cown * 4) = __expf(W15);
            if (OUT) {
#pragma unroll
                for (int r = 0; r < 4; ++r) { const float bs = row_sum16(rr[r] * kd[r] * rkc);
                    if (i == 0) BSP[(((size_t)d * MU + scan_row(d, b, jbase + 16 * cn + 4 * h + r)) * 8 + head) * 4 + w] = bs; }
            }
        }
        LDS_BARRIER();
        if (producer && cn < NCH) {
            h16x8 fa[2], fb[2];
            const int ta = (w == 0 || w == 2) ? RQ_AH : (w == 1 ? RQ_KH : RQ_KH), tb = (w == 0) ? RQ_BH : (w == 1 ? RQ_AH : RQ_RH);
            const int ra = (w == 2) ? RQ_BH : ta;
#pragma unroll
            for (int ks = 0; ks < 2; ++ks) { const int o = i * RQ_ROW + (32 * ks + 8 * h) * 2; fa[ks] = *(LAS const h16x8*)(PB + ra + o); fb[ks] = *(LAS const h16x8*)(PB + tb + o); }
            const f32x4 z4 = (f32x4){0.f, 0.f, 0.f, 0.f};
            if (w != 0) {
                if (w == 1 || OUT) {
                    f32x4 p = __builtin_amdgcn_mfma_f32_16x16x32_f16(fa[0], fb[0], z4, 0, 0, 0); p = __builtin_amdgcn_mfma_f32_16x16x32_f16(fa[1], fb[1], p, 0, 0, 0);
                    float q[4];
#pragma unroll
                    for (int r = 0; r < 4; ++r) q[r] = (w == 1 ? (4 * h + r < i) : (4 * h + r <= i)) ? p[r] : 0.f;
                    *(LAS u32x2*)(PB + (w == 1 ? RQ_MK : (w == 2 ? RQ_MB : RQ_MR)) + i * 32 + h * 8) = (u32x2){pk_h16(q[0], q[1]), pk_h16(q[2], q[3])};
                }
            } else {
                f32x4 m = __builtin_amdgcn_mfma_f32_16x16x32_f16(fa[0], fb[0], z4, 0, 0, 0); m = __builtin_amdgcn_mfma_f32_16x16x32_f16(fa[1], fb[1], m, 0, 0, 0);
                f32x4 mt = __builtin_amdgcn_mfma_f32_16x16x32_f16(fb[0], fa[0], z4, 0, 0, 0); mt = __builtin_amdgcn_mfma_f32_16x16x32_f16(fb[1], fa[1], mt, 0, 0, 0);
#pragma unroll
                for (int r = 0; r < 4; ++r) { m[r] = (i < 4 * h + r) ? m[r] : 0.f; mt[r] = (4 * h + r < i) ? mt[r] : 0.f; }
#define CV4(x) ((h16x4){(h16)(x)[0], (h16)(x)[1], (h16)(x)[2], (h16)(x)[3]})
                const h16x4 m1 = CV4(m), m1t = CV4(mt);
                const f32x4 p2 = mfma16s(m1t, m1, z4), p2t = mfma16s(m1, m1t, z4);
                f32x4 tt = mt;
#pragma unroll
                for (int r = 0; r < 4; ++r) tt[r] += (4 * h + r == i) ? 1.f : 0.f;
                const h16x4 h2 = CV4(p2), h2t = CV4(p2t);
                tt = mfma16s(h2, CV4(tt), tt);
                const f32x4 p4 = mfma16s(h2t, h2, z4), p4t = mfma16s(h2, h2t, z4);
                const h16x4 h4 = CV4(p4), h4t = CV4(p4t);
                tt = mfma16s(h4, CV4(tt), tt);
                const f32x4 p8 = mfma16s(h4t, h4, z4);
                tt = mfma16s(CV4(p8), CV4(tt), tt);
#undef CV4
                *(LAS u32x2*)(PB + RQ_TM + i * 32 + h * 8) = (u32x2){pk_h16(tt[0], tt[1]), pk_h16(tt[2], tt[3])};
            }
        }
        LDS_BARRIER();
    }
    if (PA && !producer && (!LOC || sc < NSC - 1)) {
        float* st = STR + (((size_t)sc * 64 + stream) * 2) * 4096;
        int lo_ = lane; asm volatile("" : "+v"(lo_));
        const int io = lo_ & 15, ho = lo_ >> 4;
#pragma unroll
        for (int kt = 0; kt < 4; ++kt)
#pragma unroll
            for (int vt = 0; vt < NVT; ++vt) { const int vp = 32 * w + 16 * vt + io;
                f32x4* dst = (f32x4*)(st + (vp >> 6) * 4096 + (vp & 63) * 64 + 16 * kt + 4 * ho);
                if (cmp && (cmpmode == 1 || vp >= 64)) { const f32x4 old = *dst; const f32x4 nw = Sacc[kt][vt];
                    if (__float_as_uint(old[0]) != __float_as_uint(nw[0]) || __float_as_uint(old[1]) != __float_as_uint(nw[1]) || __float_as_uint(old[2]) != __float_as_uint(nw[2]) || __float_as_uint(old[3]) != __float_as_uint(nw[3]))
                        atomicOr((unsigned*)(F.ws + WS_CTL), 1u); }
                else if (!cmp) *dst = Sacc[kt][vt]; }
    }
}
__device__ __forceinline__ void ph_rwlatecheck(Frame& F, const h16* P, float* STR) {
    for (int unit = blockIdx.x; unit < (NSC - 1) * 64; unit += F.G) rw_chunk_unit<true>(F, unit / 64, unit % 64, P, STR, nullptr, nullptr, true, 2);
    __syncthreads();
}
template <bool PA, bool LOC = false>
__device__ __forceinline__ void ph_rwchunks(Frame& F, const h16* P, float* STR, float* BSP, h16* ofwd, h16* obwd, h16* rho = nullptr) {
    const int nunits = ((PA && !LOC) ? NSC - 1 : NSC) * 64;
    for (int unit = blockIdx.x; unit < nunits; unit += F.G) { const int sc = unit / 64, stream = unit % 64;
        rw_chunk_unit<PA, LOC>(F, sc, stream, P, STR, BSP, (stream >> 5) == 0 ? ofwd : obwd, false, 1, rho);
#if DETCHK == 1
        if (PA) { __threadfence(); __syncthreads(); rw_chunk_unit<PA>(F, sc, stream, P, STR, BSP, (stream >> 5) == 0 ? ofwd : obwd, true); }
#endif
    }
    __syncthreads();
}

__device__ __forceinline__ void ph_rwcorr(Frame& F, const float* STR, const h16* rho, h16* ofwd, h16* obwd) {
    const int lane = F.lane, i = lane & 15, h = lane >> 4;
    constexpr int NCH = SCL / 16;
    for (int unit = F.gw; unit < (NSC - 1) * 64 * 2; unit += F.ngw) {
        const int half = unit & 1, stream = (unit >> 1) & 63, sc = 1 + (unit >> 7);
        const int d = stream >> 5, b = (stream >> 3) & 3, head = stream & 7;
        h16* odir = d == 0 ? ofwd : obwd;
        const float* st = STR + (((size_t)(sc - 1) * 64 + stream) * 2) * 4096 + (size_t)(32 * half) * 64;
        h16x8 sa[2][2];
#pragma unroll
        for (int ks = 0; ks < 2; ++ks)
#pragma unroll
            for (int vt = 0; vt < 2; ++vt) { const f32x4 x0 = *(const f32x4*)(st + (16 * vt + i) * 64 + 32 * ks + 8 * h), x1 = *(const f32x4*)(st + (16 * vt + i) * 64 + 32 * ks + 8 * h + 4);
                sa[ks][vt] = (h16x8){(h16)x0[0], (h16)x0[1], (h16)x0[2], (h16)x0[3], (h16)x1[0], (h16)x1[1], (h16)x1[2], (h16)x1[3]}; }
        const int rcol = d * 512 + head * 64 + 8 * h, ocol = 512 + head * 64 + 32 * half + 4 * h, jbase = sc * SCL;
        h16x8 qf[2]; u32x2 ov[2];
        { const size_t u = scan_row(d, b, jbase + i);
#pragma unroll
          for (int ks = 0; ks < 2; ++ks) qf[ks] = *(const h16x8*)(rho + u * 1024 + rcol + 32 * ks);
#pragma unroll
          for (int vt = 0; vt < 2; ++vt) ov[vt] = *(const u32x2*)(odir + u * DM + ocol + 16 * vt); }
#pragma unroll 1
        for (int c = 0; c < NCH; ++c) {
            const size_t u = scan_row(d, b, jbase + 16 * c + i), un = scan_row(d, b, jbase + 16 * (c + 1 < NCH ? c + 1 : c) + i);
            f32x4 o[2] = {(f32x4){0.f, 0.f, 0.f, 0.f}, (f32x4){0.f, 0.f, 0.f, 0.f}};
#pragma unroll
            for (int ks = 0; ks < 2; ++ks) {
                o[0] = __builtin_amdgcn_mfma_f32_16x16x32_f16(sa[ks][0], qf[ks], o[0], 0, 0, 0); o[1] = __builtin_amdgcn_mfma_f32_16x16x32_f16(sa[ks][1], qf[ks], o[1], 0, 0, 0);
                qf[ks] = *(const h16x8*)(rho + un * 1024 + rcol + 32 * ks);
            }
#pragma unroll
            for (int vt = 0; vt < 2; ++vt) { const h16x4 old = __builtin_bit_cast(h16x4, ov[vt]);
                *(u32x2*)(odir + u * DM + ocol + 16 * vt) = (u32x2){pk_h16((float)old[0] + o[vt][0], (float)old[1] + o[vt][1]), pk_h16((float)old[2] + o[vt][2], (float)old[3] + o[vt][3])};
                ov[vt] = *(const u32x2*)(odir + un * DM + ocol + 16 * vt); }
        }
    }
}

template <bool PA>
__device__ __forceinline__ void rw_unit(Frame& F, int sc, int d, int b, int head, const h16* P, float* STR, float* BSC, h16* odir) {
    LAS float* L = (LAS float*)(F.lds + F.wave * 16384);
    LAS float* LW = L, *LA = L + 512, *LB = L + 1024, *LK = L + 1536, *LR = L + 2048, *LTW = L + 2560, *LTA = L + 3072, *LV = L + 3584;
    const int lane = F.lane, stream = (d * NB + b) * 8 + head, hc = head * 64 + lane;
    float S[64], Pm[PA ? 64 : 1];
    int ln_ = lane; asm volatile("" : "+v"(ln_));
    if (PA) {
#pragma unroll
        for (int k = 0; k < 64; ++k) { S[k] = 0.f; Pm[k] = (k == ln_) ? 1.f : 0.f; }
    } else if (sc > 0) {
        const float* st = STR + (((size_t)(sc - 1) * 64 + stream) * 2) * 4096 + lane * 64;
#pragma unroll
        for (int k4 = 0; k4 < 16; ++k4) { const f32x4 x = *(const f32x4*)(st + 4 * k4); S[4 * k4] = x.x; S[4 * k4 + 1] = x.y; S[4 * k4 + 2] = x.z; S[4 * k4 + 3] = x.w; }
    } else {
#pragma unroll
        for (int k = 0; k < 64; ++k) S[k] = 0.f;
    }
    const float* mu = F.in[I_RWMU];
    const int cR = hc, cK = 512 + hc, cV = 1024 + hc, cW = 1536 + d * 64 + lane, cA = 1664 + d * 64 + lane;
    const float m0R = mu[cR], m1R = mu[1920 + cR], m0K = mu[cK], m1K = mu[1920 + cK], m0V = mu[cV], m1V = mu[1920 + cV], m0W = mu[cW], m1W = mu[1920 + cW], m0A = mu[cA], m1A = mu[1920 + cA];
    const float kkc = F.in[I_RWKK][hc], kac = F.in[I_RWKA][hc], rkc = F.in[I_RWRK][hc], w0c = F.in[I_RWW0][d * 512 + hc], a0c = F.in[I_RWA0][d * 512 + hc];
    const float* w2 = F.in[I_RWW2] + (size_t)d * 64 * 512 + hc; const float* a2 = F.in[I_RWA2] + (size_t)d * 64 * 512 + hc;
    for (int tile = 0; tile < SCL / 8; ++tile) {
        const int j0 = sc * SCL + tile * 8;
#pragma unroll 1
        for (int t = 0; t < 8; ++t) {
            const int u = scan_row(d, b, j0 + t), s = u % TT;
            const bool hp = (s != 0 && s != CTXL), hn = (s != CTXL - 1 && s != TT - 1);
            const h16* pc = P + (size_t)u * P0LD + 2560; const h16* pp = pc - P0LD; const h16* pn = pc + P0LD;
#define RW_SH(col, m0, m1) ({ const float x_ = (float)pc[col]; const float xp_ = hp ? (float)pp[col] : 0.f; const float xn_ = hn ? (float)pn[col] : 0.f; x_ + (m0) * (xp_ - x_) + (m1) * (xn_ - x_); })
            LR[t * 64 + lane] = RW_SH(cR, m0R, m1R); LK[t * 64 + lane] = RW_SH(cK, m0K, m1K); LV[t * 64 + lane] = RW_SH(cV, m0V, m1V);
            LTW[lane * 8 + t] = tanh_(RW_SH(cW, m0W, m1W)); LTA[lane * 8 + t] = RW_SH(cA, m0A, m1A);
        }
        LDS_WAIT();
        float lw[8], la[8];
#pragma unroll
        for (int t = 0; t < 8; ++t) { lw[t] = 0.f; la[t] = 0.f; }
#pragma unroll 2
        for (int j = 0; j < 64; ++j) {
            const float wv = w2[(size_t)j * 512], av = a2[(size_t)j * 512];
            const f32x4 x0 = *(const LAS f32x4*)(LTW + j * 8), x1 = *(const LAS f32x4*)(LTW + j * 8 + 4), y0 = *(const LAS f32x4*)(LTA + j * 8), y1 = *(const LAS f32x4*)(LTA + j * 8 + 4);
            lw[0] += x0.x * wv; lw[1] += x0.y * wv; lw[2] += x0.z * wv; lw[3] += x0.w * wv; lw[4] += x1.x * wv; lw[5] += x1.y * wv; lw[6] += x1.z * wv; lw[7] += x1.w * wv;
            la[0] += y0.x * av; la[1] += y0.y * av; la[2] += y0.z * av; la[3] += y0.w * av; la[4] += y1.x * av; la[5] += y1.y * av; la[6] += y1.z * av; la[7] += y1.w * av;
        }
#pragma unroll
        for (int t = 0; t < 8; ++t) {
            const float kraw = LK[t * 64 + lane], rraw = LR[t * 64 + lane];
            const float kkr = kraw * kkc; const float nrm = sqrtf(wave_sum(kkr * kkr)); const float kk = kkr / fmaxf(nrm, 1e-12f);
            const float wlog = -softplus(-(w0c + lw[t])) - 0.5f; const float wdec = __expf(-__expf(wlog));
            const float asig = sigm(a0c + la[t]); const float kd = kraw * (1.f + (asig - 1.f) * kac);
            LW[t * 64 + lane] = wdec; LA[t * 64 + lane] = -kk; LB[t * 64 + lane] = kk * asig; LK[t * 64 + lane] = kd;
            if (!PA) { const float bs = wave_sum(rraw * kd * rkc); if (lane == 0) *(f32x4*)(BSC + (((size_t)d * MU + scan_row(d, b, j0 + t)) * 8 + head) * 4) = (f32x4){bs, 0.f, 0.f, 0.f}; }
        }
        LDS_WAIT();
#pragma unroll 1
        for (int t = 0; t < 8; ++t) {
            const float vv = LV[t * 64 + lane];
            float sa = 0.f, sp = 0.f;
#pragma unroll
            for (int k4 = 0; k4 < 16; ++k4) { const f32x4 a4 = *(const LAS f32x4*)(LA + t * 64 + 4 * k4);
#pragma unroll
                for (int e = 0; e < 4; ++e) { sa += S[4 * k4 + e] * a4[e]; if (PA) sp += Pm[4 * k4 + e] * a4[e]; } }
            float o = 0.f;
#pragma unroll
            for (int k4 = 0; k4 < 16; ++k4) {
                const f32x4 w4 = *(const LAS f32x4*)(LW + t * 64 + 4 * k4), b4 = *(const LAS f32x4*)(LB + t * 64 + 4 * k4), k4v = *(const LAS f32x4*)(LK + t * 64 + 4 * k4);
                f32x4 r4 = (f32x4){0.f, 0.f, 0.f, 0.f}; if (!PA) r4 = *(const LAS f32x4*)(LR + t * 64 + 4 * k4);
#pragma unroll
                for (int e = 0; e < 4; ++e) { float& s = S[4 * k4 + e]; s = s * w4[e] + sa * b4[e] + vv * k4v[e]; if (PA) { float& p = Pm[4 * k4 + e]; p = p * w4[e] + sp * b4[e]; } else o += s * r4[e]; }
            }
            if (!PA) odir[(size_t)scan_row(d, b, j0 + t) * DM + 512 + hc] = (h16)o;
        }
    }
    if (PA) {
        float* st = STR + (((size_t)sc * 64 + stream) * 2) * 4096 + lane * 64;
#pragma unroll
        for (int k4 = 0; k4 < 16; ++k4) { *(f32x4*)(st + 4 * k4) = (f32x4){S[4 * k4], S[4 * k4 + 1], S[4 * k4 + 2], S[4 * k4 + 3]}; *(f32x4*)(st + 4096 + 4 * k4) = (f32x4){Pm[4 * k4], Pm[4 * k4 + 1], Pm[4 * k4 + 2], Pm[4 * k4 + 3]}; }
    }
}

__device__ __forceinline__ void s5_hloc(Frame& F, int dg, int b, int rp, int half, const h16* P, float* HLOC) {
    const int lane = F.lane, i = lane & 15, h = lane >> 4, d = dg >> 5, g = dg & 31, stream = (d * NB + b) * 32 + g;
    const h16* E16 = WSP(h16, WS_S5E) + (size_t)dg * 32768;
    h16x8 af[2][8];
#pragma unroll
    for (int rt = 0; rt < 2; ++rt)
#pragma unroll
        for (int ks = 0; ks < 8; ++ks) af[rt][ks] = *(const h16x8*)(E16 + ((15 - (2 * ks + (h >> 1))) * 128 + 32 * rp + 16 * rt + i) * 16 + 8 * (h & 1));
    const int c0 = half ? 17 : 0, c1 = half ? 33 : 17;
    h16x8 bf[8];
    { const int j = 16 * c0 + i;
#pragma unroll
      for (int ks = 0; ks < 8; ++ks) bf[ks] = *(const h16x8*)(P + (size_t)scan_row(d, b, 16 * j + 2 * ks + (h >> 1)) * P1LD + 1568 + g * 16 + 8 * (h & 1)); }
#pragma unroll 1
    for (int ct = c0; ct < c1; ++ct) {
        const int j = 16 * ct + i, jn = 16 * (ct + 1 < c1 ? ct + 1 : ct) + i;
        f32x4 acc[2] = {(f32x4){0.f, 0.f, 0.f, 0.f}, (f32x4){0.f, 0.f, 0.f, 0.f}};
#pragma unroll
        for (int ks = 0; ks < 8; ++ks) {
            acc[0] = __builtin_amdgcn_mfma_f32_16x16x32_f16(af[0][ks], bf[ks], acc[0], 0, 0, 0);
            acc[1] = __builtin_amdgcn_mfma_f32_16x16x32_f16(af[1][ks], bf[ks], acc[1], 0, 0, 0);
            bf[ks] = *(const h16x8*)(P + (size_t)scan_row(d, b, 16 * jn + 2 * ks + (h >> 1)) * P1LD + 1568 + g * 16 + 8 * (h & 1));
        }
        float* o = HLOC + ((size_t)stream * 528 + j) * 128 + 32 * rp + 4 * h;
        *(f32x4*)o = acc[0] * (1.f / 256.f); *(f32x4*)(o + 16) = acc[1] * (1.f / 256.f);
    }
}
__device__ __forceinline__ void s5_out(Frame& F, int dg, int b, int rq, const h16* P, const h16* HIN, h16* odir) {
    const int lane = F.lane, i = lane & 15, h = lane >> 4, d = dg >> 5, g = dg & 31, stream = (d * NB + b) * 32 + g;
    const h16* G16 = WSP(h16, WS_S5G) + (size_t)dg * 4096; const h16* Q16 = WSP(h16, WS_S5Q) + (size_t)dg * 32768;
    h16x8 ga[2][8], qa[2][4];
#pragma unroll
    for (int rt = 0; rt < 2; ++rt) { const int t = 2 * rq + rt;
#pragma unroll
        for (int ks = 0; ks < 8; ++ks) { const int tau = t - (2 * ks + (h >> 1));
            h16x8 z;
#pragma unroll
            for (int e = 0; e < 8; ++e) z[e] = (h16)0.f;
            if (tau >= 0) z = *(const h16x8*)(G16 + (tau * 16 + i) * 16 + 8 * (h & 1));
            ga[rt][ks] = z; }
#pragma unroll
        for (int ks = 0; ks < 4; ++ks) qa[rt][ks] = *(const h16x8*)(Q16 + (t * 16 + i) * 128 + 32 * ks + 8 * h); }
    h16x8 bf[12];
    { const int j = i;
#pragma unroll
      for (int ks = 0; ks < 8; ++ks) if (ks <= rq) bf[ks] = *(const h16x8*)(P + (size_t)scan_row(d, b, 16 * j + 2 * ks + (h >> 1)) * P1LD + 1568 + g * 16 + 8 * (h & 1));
      const h16* hin = HIN + ((size_t)stream * 528 + j) * 128;
#pragma unroll
      for (int ks = 0; ks < 4; ++ks) bf[8 + ks] = *(const h16x8*)(hin + 32 * ks + 8 * h); }
#pragma unroll 1
    for (int ct = 0; ct < 33; ++ct) {
        const int j = 16 * ct + i, jn = 16 * (ct + 1 < 33 ? ct + 1 : ct) + i;
        f32x4 acc[2] = {(f32x4){0.f, 0.f, 0.f, 0.f}, (f32x4){0.f, 0.f, 0.f, 0.f}};
#pragma unroll
        for (int ks = 0; ks < 8; ++ks) {
            if (ks <= rq) {
                acc[0] = __builtin_amdgcn_mfma_f32_16x16x32_f16(ga[0][ks], bf[ks], acc[0], 0, 0, 0);
                acc[1] = __builtin_amdgcn_mfma_f32_16x16x32_f16(ga[1][ks], bf[ks], acc[1], 0, 0, 0);
                bf[ks] = *(const h16x8*)(P + (size_t)scan_row(d, b, 16 * jn + 2 * ks + (h >> 1)) * P1LD + 1568 + g * 16 + 8 * (h & 1));
            }
        }
        const h16* hinn = HIN + ((size_t)stream * 528 + jn) * 128;
#pragma unroll
        for (int ks = 0; ks < 4; ++ks) {
            acc[0] = __builtin_amdgcn_mfma_f32_16x16x32_f16(qa[0][ks], bf[8 + ks], acc[0], 0, 0, 0);
            acc[1] = __builtin_amdgcn_mfma_f32_16x16x32_f16(qa[1][ks], bf[8 + ks], acc[1], 0, 0, 0);
            bf[8 + ks] = *(const h16x8*)(hinn + 32 * ks + 8 * h);
        }
#pragma unroll
        for (int rt = 0; rt < 2; ++rt) { const f32x4 y = acc[rt] * (1.f / 64.f);
            u32x2 w; w.x = pk_h16(y[0], y[1]); w.y = pk_h16(y[2], y[3]);
            *(u32x2*)(odir + (size_t)scan_row(d, b, 16 * j + 2 * rq + rt) * DM + 512 + g * 16 + 4 * h) = w; }
    }
}

__device__ __forceinline__ void ph_scanA(Frame& F, int layer) {
    if (layer == 0) {
        const h16* P = WSP(h16, WS_BIG); unsigned char* dob = (unsigned char*)F.out;
        if (GLLC) ph_glquads<128, true>(F, true, P, P0LD, (float*)(dob + DO_STH), (float*)(dob + DO_DH), WSP(h16, WS_H16), (h16*)(dob + DO_OBWD), true, (h16*)(F.ws + WS_BIG + B0_QE), 1024);
        else ph_glquads<128, true>(F, false, P, P0LD, (float*)(dob + DO_STH), (float*)(dob + DO_DH), nullptr, nullptr);
        if (RWLC) ph_rwchunks<true, true>(F, P, (float*)(dob + DO_STR), WSP(float, WS_BSP), WSP(h16, WS_H16), (h16*)(dob + DO_OBWD), (h16*)(F.ws + WS_BIG + B0_QE));
        else if (RWMODE & 1) ph_rwchunks<true>(F, P, (float*)(dob + DO_STR), nullptr, nullptr, nullptr);
        if (RWMODE & 8) cg::this_grid().sync();
        if (!(RWMODE & 1) || (RWMODE & 8)) { constexpr int NRW = (NSC - 1) * 64; for (int it = F.gw; it < NRW; it += F.ngw) { const int sc = it / 64, st = it % 64; rw_unit<true>(F, sc, st >> 5, (st >> 3) & 3, st & 7, P, (float*)(dob + DO_STR), nullptr, nullptr); } }
    } else {
        const h16* P = WSP(h16, WS_BIG); unsigned char* big = F.ws + WS_BIG;
        ph_glquads<64, false>(F, false, P, P1LD, (float*)(big + B1_STG), (float*)(big + B1_DG), nullptr, nullptr);
        for (int it = F.gw; it < 64 * 4 * 4 * 2; it += F.ngw) s5_hloc(F, it >> 5, (it >> 3) & 3, (it >> 1) & 3, it & 1, P, (float*)(big + B1_HLOC));
    }
}
__device__ __forceinline__ void ph_scanB(Frame& F, int layer) {
    const int gt = blockIdx.x * NTHR + F.tid, ngt = F.G * NTHR;
    if (layer == 0) {
        unsigned char* dob = (unsigned char*)F.out;
        float* ST = (float*)(dob + DO_STH); const float* DH = (const float*)(dob + DO_DH);
        for (int e = gt; e < 32 * 128 * 128; e += ngt) { const int stream = e >> 14, k = (e >> 7) & 127; float carry = 0.f;
            float dv[NSC - 1], sv[NSC - 1];
#pragma unroll
            for (int sc = 0; sc < NSC - 1; ++sc) { dv[sc] = DH[((size_t)sc * 32 + stream) * 128 + k]; sv[sc] = ST[(size_t)sc * 32 * 16384 + e]; }
#pragma unroll
            for (int sc = 0; sc < NSC - 1; ++sc) { carry = dv[sc] * carry + sv[sc]; ST[(size_t)sc * 32 * 16384 + e] = carry; } }
        float* STR = (float*)(dob + DO_STR);
        LAS float* LS = (LAS float*)F.lds;
        LAS float* LP = LS + 64 * 65;
        for (int stream = blockIdx.x; stream < 64; stream += F.G) {
            __syncthreads();
            for (int i = F.tid; i < 64 * 65; i += NTHR) LS[i] = 0.f;
            float pv[8], uv[8];
            { const float* Ug0 = STR + ((size_t)stream * 2) * 4096; const float* Pg0 = Ug0 + 4096;
#pragma unroll
              for (int q = 0; q < 8; ++q) { pv[q] = Pg0[F.tid + NTHR * q]; uv[q] = Ug0[F.lane * 64 + F.wave * 8 + q]; } }
            for (int sc = 0; sc < NSC - 1; ++sc) {
                float* Ug = STR + (((size_t)sc * 64 + stream) * 2) * 4096;
                __syncthreads();
                float acc[8];
#pragma unroll
                for (int q = 0; q < 8; ++q) { LP[F.tid + NTHR * q] = pv[q]; acc[q] = uv[q]; }
                if (sc + 1 < NSC - 1) { const float* Un = Ug + (size_t)64 * 2 * 4096; const float* Pn = Un + 4096;
#pragma unroll
                    for (int q = 0; q < 8; ++q) { pv[q] = Pn[F.tid + NTHR * q]; uv[q] = Un[F.lane * 64 + F.wave * 8 + q]; } }
                LDS_BARRIER();
                for (int k = 0; k < 64; ++k) { const float s = LS[F.lane * 65 + k]; const f32x4 p0 = *(const LAS f32x4*)(LP + k * 64 + F.wave * 8), p1 = *(const LAS f32x4*)(LP + k * 64 + F.wave * 8 + 4);
                    acc[0] += s * p0.x; acc[1] += s * p0.y; acc[2] += s * p0.z; acc[3] += s * p0.w; acc[4] += s * p1.x; acc[5] += s * p1.y; acc[6] += s * p1.z; acc[7] += s * p1.w; }
                LDS_BARRIER();
#pragma unroll
                for (int e = 0; e < 8; ++e) { LS[F.lane * 65 + F.wave * 8 + e] = acc[e]; Ug[F.lane * 64 + F.wave * 8 + e] = acc[e]; }
            }
        }
        __syncthreads();
    } else {
        unsigned char* big = F.ws + WS_BIG;
        float* ST = (float*)(big + B1_STG); const float* DG = (const float*)(big + B1_DG);
        for (int e = gt; e < 32 * 64 * 128; e += ngt) { const int stream = e >> 13, k = (e >> 7) & 63; float carry = 0.f;
            float dv[NSC - 1], sv[NSC - 1];
#pragma unroll
            for (int sc = 0; sc < NSC - 1; ++sc) { dv[sc] = DG[((size_t)sc * 32 + stream) * 64 + k]; sv[sc] = ST[(size_t)sc * 32 * 8192 + e]; }
#pragma unroll
            for (int sc = 0; sc < NSC - 1; ++sc) { carry = dv[sc] * carry + sv[sc]; ST[(size_t)sc * 32 * 8192 + e] = carry; } }
        const float* HLOC = (const float*)(big + B1_HLOC); h16* HIN = (h16*)(big + B1_ZB); const float* L16 = WSP(float, WS_S5L);
        LAS float* EL = (LAS float*)F.lds;
        for (int stream = blockIdx.x; stream < 256; stream += F.G) {
            const int d = stream >> 7, g = stream & 31, dg = d * 32 + g, w = F.wave;
            const float lr = L16[(dg * 64 + F.lane) * 2], li = L16[(dg * 64 + F.lane) * 2 + 1];
            const float* rec = HLOC + ((size_t)stream * 528 + 66 * w) * 128; h16* o = HIN + ((size_t)stream * 528 + 66 * w) * 128;
            float cr = 0.f, ci = 0.f;
#pragma unroll 6
            for (int j = 0; j < 66; ++j) {
                const float hr = rec[j * 128 + F.lane], hi = rec[j * 128 + 64 + F.lane];
                const float nr = lr * cr - li * ci + hr, ni = lr * ci + li * cr + hi; cr = nr; ci = ni;
            }
            __syncthreads();
            EL[w * 128 + F.lane] = cr; EL[w * 128 + 64 + F.lane] = ci;
            float p2r = lr * lr - li * li, p2i = 2.f * lr * li, pr = p2r, pi = p2i;
#pragma unroll
            for (int q = 0; q < 5; ++q) { const float tr = pr * pr - pi * pi, ti = 2.f * pr * pi; pr = tr; pi = ti; }
            { const float tr = pr * p2r - pi * p2i, ti = pr * p2i + pi * p2r; pr = tr; pi = ti; }
            __syncthreads();
            cr = 0.f; ci = 0.f;
            for (int v = 0; v < w; ++v) { const float er = EL[v * 128 + F.lane], ei = EL[v * 128 + 64 + F.lane];
                const float nr = pr * cr - pi * ci + er, ni = pr * ci + pi * cr + ei; cr = nr; ci = ni; }
#pragma unroll 6
            for (int j = 0; j < 66; ++j) {
                const float hr = rec[j * 128 + F.lane], hi = rec[j * 128 + 64 + F.lane];
                o[j * 128 + F.lane] = (h16)(cr * 64.f); o[j * 128 + 64 + F.lane] = (h16)(ci * 64.f);
                const float nr = lr * cr - li * ci + hr, ni = lr * ci + li * cr + hi; cr = nr; ci = ni;
            }
        }
        __syncthreads();
    }
}
__device__ __forceinline__ void ph_scanC(Frame& F, int layer) {
    if (layer == 0) {
        const h16* P = WSP(h16, WS_BIG); unsigned char* dob = (unsigned char*)F.out;
        if (GLLC) ph_glcorr<128>(F, (const float*)(dob + DO_STH), (const h16*)(F.ws + WS_BIG + B0_QE), 1024, WSP(h16, WS_H16), (h16*)(dob + DO_OBWD));
        else ph_glquads<128, true>(F, true, P, P0LD, (float*)(dob + DO_STH), nullptr, WSP(h16, WS_H16), (h16*)(dob + DO_OBWD));
        if (RWLC) ph_rwcorr(F, (const float*)(dob + DO_STR), (const h16*)(F.ws + WS_BIG + B0_QE), WSP(h16, WS_H16), (h16*)(dob + DO_OBWD));
        else if ((RWMODE & 2) && !(RWMODE & 4)) ph_rwchunks<false>(F, P, (float*)(dob + DO_STR), WSP(float, WS_BSP), WSP(h16, WS_H16), (h16*)(dob + DO_OBWD));
        else { constexpr int NRW = NSC * 64; for (int it = F.gw; it < NRW; it += F.ngw) { const int sc = it / 64, st = it % 64, d = st >> 5; rw_unit<false>(F, sc, d, (st >> 3) & 3, st & 7, P, (float*)(dob + DO_STR), WSP(float, WS_BSP), d == 0 ? WSP(h16, WS_H16) : (h16*)(dob + DO_OBWD)); }
            if (RWMODE & 4) { cg::this_grid().sync(); ph_rwchunks<false>(F, P, (float*)(dob + DO_STR), WSP(float, WS_BSP), WSP(h16, WS_H16), (h16*)(dob + DO_OBWD)); } }
#if DETCHK == 2
        ph_rwlatecheck(F, P, (float*)(dob + DO_STR));
#endif
    } else {
        const h16* P = WSP(h16, WS_BIG); unsigned char* big = F.ws + WS_BIG;
        ph_glquads<64, false>(F, true, P, P1LD, (float*)(big + B1_STG), nullptr, WSP(h16, WS_H16), (h16*)(big + B1_OBWD));
        for (int it = F.gw; it < 64 * 4 * 8; it += F.ngw) { const int dg = it >> 5; s5_out(F, dg, (it >> 3) & 3, it & 7, P, (const h16*)(big + B1_ZB), (dg >> 5) == 0 ? WSP(h16, WS_H16) : (h16*)(big + B1_OBWD)); }
    }
}

__device__ __forceinline__ void ph_fin0(Frame& F, bool dry = false) {
    LAS h16* SGh = (LAS h16*)F.lds;
    LAS unsigned char* GT = F.lds + 32 * 272;
    const h16* P = WSP(h16, WS_BIG); h16* OF = WSP(h16, WS_H16); const h16* OB = (const h16*)((unsigned char*)F.out + DO_OBWD); const float* BSC = WSP(float, WS_BSP);
    const float* mu = F.in[I_RWMU];
    const int lane = F.lane, c0 = lane * 8, li = lane & 15, lh = lane >> 4;
    h16x8 g2f[4][4];
    { const h16* G2T = WSP(h16, WS_G2T);
#pragma unroll
      for (int ct = 0; ct < 4; ++ct)
#pragma unroll
          for (int ks = 0; ks < 4; ++ks) g2f[ct][ks] = *(const h16x8*)(G2T + (size_t)(64 * F.wave + 16 * ct + li) * 128 + 32 * ks + 8 * lh); }
    const int per = (((MU + F.G - 1) / F.G) + 3) & ~3, ubase = blockIdx.x * per, uend = (ubase + per < MU) ? ubase + per : MU;
    for (int it = 0; it * 32 < per; ++it) {
        const int u0 = ubase + it * 32 + F.wave * 4;
        const bool act = u0 < uend;
        __syncthreads();
#pragma unroll
        for (int tk = 0; tk < 4; ++tk) {
            if (act) { const int u = u0 + tk, s = u % TT; const bool hp = (s != 0 && s != CTXL), hn = (s != CTXL - 1 && s != TT - 1);
                const h16* pc = P + (size_t)u * P0LD + 2560;
#pragma unroll
                for (int i = 0; i < 2; ++i) { const int col = 1792 + lane + 64 * i; const float x = (float)pc[col], xp = (hp ? 1.f : 0.f) * (float)pc[col - (hp ? P0LD : 0)], xn = (hn ? 1.f : 0.f) * (float)pc[col + (hn ? P0LD : 0)];
                    SGh[(F.wave * 4 + tk) * 136 + lane + 64 * i] = (h16)sigm(x + mu[col] * (xp - x) + mu[1920 + col] * (xn - x)); } }
            else { SGh[(F.wave * 4 + tk) * 136 + lane] = (h16)0.f; SGh[(F.wave * 4 + tk) * 136 + lane + 64] = (h16)0.f; }
        }
        __syncthreads();
#pragma unroll
        for (int rt = 0; rt < 2; ++rt) {
            h16x8 sb[4];
#pragma unroll
            for (int ks = 0; ks < 4; ++ks) sb[ks] = *(LAS const h16x8*)(SGh + (16 * rt + li) * 136 + 32 * ks + 8 * lh);
#pragma unroll
            for (int ct = 0; ct < 4; ++ct) { f32x4 acc = (f32x4){0.f, 0.f, 0.f, 0.f};
#pragma unroll
                for (int ks = 0; ks < 4; ++ks) acc = __builtin_amdgcn_mfma_f32_16x16x32_f16(g2f[ct][ks], sb[ks], acc, 0, 0, 0);
                *(LAS u32x2*)(GT + (16 * rt + li) * 1040 + (64 * F.wave + 16 * ct + 4 * lh) * 2) = (u32x2){pk_h16(acc[0], acc[1]), pk_h16(acc[2], acc[3])}; }
        }
        __syncthreads();
        if (!act) continue;
        h16x8 gate[4];
#pragma unroll
        for (int tk = 0; tk < 4; ++tk) gate[tk] = *(LAS const h16x8*)(GT + (F.wave * 4 + tk) * 1040 + 16 * lane);
#pragma unroll
        for (int tk = 0; tk < 4; ++tk) {
            const int u = u0 + tk, s = u % TT; const bool hp = (s != 0 && s != CTXL), hn = (s != CTXL - 1 && s != TT - 1);
            const h16* prow = P + (size_t)u * P0LD;
            { const h16x8 a = *(const h16x8*)(OF + (size_t)u * DM + c0), bb = *(const h16x8*)(OB + (size_t)u * DM + c0), gg = *(const h16x8*)(prow + 2048 + c0);
              float x[8], ss = 0.f;
#pragma unroll
              for (int e = 0; e < 8; ++e) { x[e] = (float)a[e] + (float)bb[e]; ss += x[e] * x[e]; }
              ss += __shfl_xor(ss, 1); ss += __shfl_xor(ss, 2); ss += __shfl_xor(ss, 4); ss += __shfl_xor(ss, 8);
              const float rinv = rsqrtf(ss * (1.f / 128.f) + 1e-6f); const float* hg = F.in[I_HGNG] + (c0 & 127);
              u32x4 w; float y[8];
#pragma unroll
              for (int e = 0; e < 8; ++e) y[e] = x[e] * rinv * hg[e] * silu((float)gg[e]);
              w.x = pk_h16(y[0], y[1]); w.y = pk_h16(y[2], y[3]); w.z = pk_h16(y[4], y[5]); w.w = pk_h16(y[6], y[7]);
              *(u32x4*)((dry ? (h16*)OB : OF) + (size_t)u * DM + c0) = w; }
            { const h16x8 a = *(const h16x8*)(OF + (size_t)u * DM + 512 + c0), bb = *(const h16x8*)(OB + (size_t)u * DM + 512 + c0);
              float x[8], sm = 0.f;
#pragma unroll
              for (int e = 0; e < 8; ++e) { x[e] = (float)a[e] + (float)bb[e]; sm += x[e]; }
              sm += __shfl_xor(sm, 1); sm += __shfl_xor(sm, 2); sm += __shfl_xor(sm, 4);
              const float mean = sm * (1.f / 64.f); float vs = 0.f;
#pragma unroll
              for (int e = 0; e < 8; ++e) { x[e] -= mean; vs += x[e] * x[e]; }
              vs += __shfl_xor(vs, 1); vs += __shfl_xor(vs, 2); vs += __shfl_xor(vs, 4);
              const float rinv = rsqrtf(vs * (1.f / 64.f) + 64e-5f);
              const int head = lane >> 3; const f32x4 bp0 = *(const f32x4*)(BSC + ((size_t)u * 8 + head) * 4), bp1 = *(const f32x4*)(BSC + (((size_t)MU + u) * 8 + head) * 4); const float bon = ((bp0.x + bp0.y) + (bp0.z + bp0.w)) + ((bp1.x + bp1.y) + (bp1.z + bp1.w));
              const h16* pc = prow + 2560 + 1024 + c0; const h16x8 vc = *(const h16x8*)pc; const h16x8 vp = *(const h16x8*)(pc - (hp ? P0LD : 0)), vn = *(const h16x8*)(pc + (hn ? P0LD : 0));
              const float fp_ = hp ? 1.f : 0.f, fn_ = hn ? 1.f : 0.f;
              float y[8];
#pragma unroll
              for (int e = 0; e < 8; ++e) { const float xv = (float)vc[e]; const float vsh = xv + mu[1024 + c0 + e] * (fp_ * (float)vp[e] - xv) + mu[1920 + 1024 + c0 + e] * (fn_ * (float)vn[e] - xv);
                  y[e] = (x[e] * rinv * F.in[I_RWLNG][c0 + e] + F.in[I_RWLNB][c0 + e] + bon * vsh) * (float)gate[tk][e]; }
              u32x4 w; w.x = pk_h16(y[0], y[1]); w.y = pk_h16(y[2], y[3]); w.z = pk_h16(y[4], y[5]); w.w = pk_h16(y[6], y[7]);
              *(u32x4*)((dry ? (h16*)OB : OF) + (size_t)u * DM + 512 + c0) = w; }
        }
    }
}
__device__ __forceinline__ void ph_fin1(Frame& F) {
    const h16* P = WSP(h16, WS_BIG); h16* OF = WSP(h16, WS_H16); const h16* OB = (const h16*)(F.ws + WS_BIG + B1_OBWD); h16* ZB = (h16*)(F.ws + WS_BIG + B1_ZB);
    const int lane = F.lane, c0 = lane * 8;
    for (int u = F.gw; u < MU; u += F.ngw) {
        const h16* prow = P + (size_t)u * P1LD;
        { const h16x8 a = *(const h16x8*)(OF + (size_t)u * DM + c0), bb = *(const h16x8*)(OB + (size_t)u * DM + c0), gg = *(const h16x8*)(prow + 1024 + c0);
          float x[8], ss = 0.f;
#pragma unroll
          for (int e = 0; e < 8; ++e) { x[e] = (float)a[e] + (float)bb[e]; ss += x[e] * x[e]; }
          ss += __shfl_xor(ss, 1); ss += __shfl_xor(ss, 2); ss += __shfl_xor(ss, 4); ss += __shfl_xor(ss, 8);
          const float rinv = rsqrtf(ss * (1.f / 128.f) + 1e-6f); const float* hg = F.in[I_GLANG] + (c0 & 127);
          float y[8];
#pragma unroll
          for (int e = 0; e < 8; ++e) y[e] = x[e] * rinv * hg[e] * silu((float)gg[e]);
          u32x4 w; w.x = pk_h16(y[0], y[1]); w.y = pk_h16(y[2], y[3]); w.z = pk_h16(y[4], y[5]); w.w = pk_h16(y[6], y[7]);
          *(u32x4*)(OF + (size_t)u * DM + c0) = w; }
        { const h16x8 a = *(const h16x8*)(OF + (size_t)u * DM + 512 + c0), bb = *(const h16x8*)(OB + (size_t)u * DM + 512 + c0), uu = *(const h16x8*)(prow + 1568 + c0);
          float z[8];
#pragma unroll
          for (int e = 0; e < 8; ++e) z[e] = gelu_tanh((float)a[e] + (float)bb[e] + F.in[I_S5D][c0 + e] * (float)uu[e]);
          u32x4 w; w.x = pk_h16(z[0], z[1]); w.y = pk_h16(z[2], z[3]); w.z = pk_h16(z[4], z[5]); w.w = pk_h16(z[6], z[7]);
          *(u32x4*)(ZB + (size_t)u * 512 + c0) = w; }
    }
}


#define XB_TMO      128
#define XB_XCNT(j)  (256  + 64 * (j))
#define XB_XSUB(j)  (1280 + 64 * (j))
#define XB_XGEN(j)  (2304 + 64 * (j))
#define XB_TOP      3328
#define XB_TOPGEN   3392
#define XCD_BAR_WORDS 3456
#define XB_SPIN_CAP (1u << 22)
__device__ __forceinline__ unsigned xb_ld(unsigned* p)              { return __hip_atomic_load(p, __ATOMIC_RELAXED, __HIP_MEMORY_SCOPE_AGENT); }
__device__ __forceinline__ unsigned xb_add(unsigned* p, unsigned v) { return __hip_atomic_fetch_add(p, v, __ATOMIC_RELAXED, __HIP_MEMORY_SCOPE_AGENT); }
__device__ __forceinline__ unsigned xb_xcc_id() { return (unsigned)__builtin_amdgcn_s_getreg((3 << 11) | 20) & 0xFu; }
#define XB_SPIN(cond, bar) do { unsigned _sp = 0; while (cond) { __builtin_amdgcn_s_sleep(1); \
    if ((++_sp & 255u) == 0u) { if (xb_ld(&(bar)[XB_TMO])) break; if (_sp > XB_SPIN_CAP) { atomicAdd(&(bar)[XB_TMO], 1u); break; } } } } while (0)
struct XcdBarrier { unsigned* bar; unsigned x; volatile LAS unsigned* st; };
__device__ __forceinline__ XcdBarrier xcd_barrier_post(unsigned* bar, volatile LAS unsigned* st) {
    XcdBarrier b; b.bar = bar; b.x = xb_xcc_id(); b.st = st;
    if (threadIdx.x == 0) (void)xb_add(&bar[XB_XCNT(b.x)], 1u);
    return b;
}
__device__ __forceinline__ void xcd_barrier_complete(unsigned* bar, unsigned x, unsigned& nloc, unsigned& nx) {
    const unsigned G = gridDim.x * gridDim.y * gridDim.z;
    unsigned sum, cnt, mine, sp = 0u;
    for (;;) {
        sum = 0u; cnt = 0u; mine = 0u;
#pragma unroll
        for (unsigned j = 0; j < 16; ++j) { const unsigned c = xb_ld(&bar[XB_XCNT(j)]); sum += c; cnt += (c > 0u) ? 1u : 0u; mine = (j == x) ? c : mine; }
        if (sum == G) break;
        __builtin_amdgcn_s_sleep(1);
        if ((++sp & 255u) == 0u) { if (xb_ld(&bar[XB_TMO])) break; if (sp > XB_SPIN_CAP) { atomicAdd(&bar[XB_TMO], 1u); break; } }
    }
    nloc = mine > 0u ? mine : 1u; nx = cnt > 0u ? cnt : 1u;
}
__device__ __forceinline__ void xcd_barrier(const XcdBarrier& b) {
    asm volatile("s_waitcnt vmcnt(0)" ::: "memory");
    __syncthreads();
    if (threadIdx.x == 0) {
        unsigned* bar = b.bar;
        __builtin_amdgcn_s_waitcnt(0);
        unsigned nloc = b.st[0], nx = b.st[1];
        if (nloc == 0u) { xcd_barrier_complete(bar, b.x, nloc, nx); b.st[0] = nloc; b.st[1] = nx; }
        const unsigned old = xb_add(&bar[XB_XSUB(b.x)], 1u);
        const unsigned gen = old / nloc;
        if (old + 1u == (gen + 1u) * nloc) {
            __builtin_amdgcn_fence(__ATOMIC_RELEASE, "agent");
            asm volatile("s_waitcnt vmcnt(0)" ::: "memory");
            const unsigned og = xb_add(&bar[XB_TOP], 1u);
            const unsigned tg = og / nx;
            if (og + 1u == (tg + 1u) * nx) xb_add(&bar[XB_TOPGEN], 1u);
            else XB_SPIN(xb_ld(&bar[XB_TOPGEN]) == tg, bar);
            __builtin_amdgcn_fence(__ATOMIC_ACQUIRE, "agent");
            xb_add(&bar[XB_XGEN(b.x)], 1u);
            asm volatile("s_waitcnt vmcnt(0)" ::: "memory");
        } else {
            XB_SPIN(xb_ld(&bar[XB_XGEN(b.x)]) == gen, bar);
            __builtin_amdgcn_fence(__ATOMIC_ACQUIRE, "agent");
            asm volatile("s_waitcnt vmcnt(0)" ::: "memory");
        }
    }
    __syncthreads();
}

#ifndef CTXG
#define CTXG 1
#endif
constexpr int N_PHASES = 26;
#define PH_IN(k) (args.ph_lo <= (k) && (k) < args.ph_hi)
#define PH_SYNC(k) do { if ((k) + 1 < args.ph_hi) { if ((k) == 0 || USE_CG_SYNC) grid.sync(); else xcd_barrier(xbar); } } while (0)
#define RUNPH(k, ...) do { if (PH_IN(PB + (k))) { if (((REPM >> (k)) & 1u) && ((REPL >> L) & 1u)) { if (PHM & (1u << (k))) { __VA_ARGS__ } } if (PHM & (1u << (k))) { __VA_ARGS__ } PH_SYNC(PB + (k)); } } while (0)
template <int MODE, int CW>
__device__ __forceinline__ void ctx_gemm(Frame& F, const h16* A, int lda, const h16* Bt, int ldb, int K, int N, h16* O, int ldc, float* ctx, const float* mod, int goff) {
    const int tid = F.tid, lane = F.lane, i = lane & 15, h = lane >> 4, wr = F.wave >> 2, wc = F.wave & 3;
    constexpr int NJ = (64 + CW) / 64, NN = CW / 64;
    const int nct = N / CW, nunits = 16 * nct, nk = K / 64;
    constexpr int RS = 144, TILE = (64 + CW) * RS;
    LAS unsigned char* L0 = F.lds;
    for (int unit = blockIdx.x; unit < nunits; unit += F.G) {
        const int rt = unit / nct, ct = unit % nct, b = rt >> 2, r0 = (rt & 3) * 64;
        const size_t u0 = (size_t)b * TT + r0;
        const int col0 = ct * CW;
        const h16* gp[NJ]; int lo[NJ];
#pragma unroll
        for (int j = 0; j < NJ; ++j) { const int q = tid + 512 * j, row = q >> 3, c16 = q & 7;
            gp[j] = (row < 64 ? A + (u0 + row) * lda : Bt + (size_t)(col0 + row - 64) * ldb) + 8 * c16; lo[j] = row * RS + 16 * c16; }
        f32x4 acc[2][NN];
#pragma unroll
        for (int m = 0; m < 2; ++m)
#pragma unroll
            for (int n = 0; n < NN; ++n) acc[m][n] = (f32x4){0.f, 0.f, 0.f, 0.f};
        constexpr int PD = 4;
        u32x4 st[PD][NJ];
#pragma unroll
        for (int d = 0; d < PD; ++d)
#pragma unroll
            for (int j = 0; j < NJ; ++j) st[d][j] = *(const u32x4*)(gp[j] + 64 * d);
        __syncthreads();
#pragma unroll
        for (int j = 0; j < NJ; ++j) *(LAS u32x4*)(L0 + lo[j]) = st[0][j];
        __syncthreads();
        const int aoff = (wr * 32 + i) * RS + 16 * h, boff = (64 + wc * (CW / 4) + i) * RS + 16 * h;
#pragma unroll 1
        for (int kt0 = 0; kt0 < nk; kt0 += PD) {
#pragma unroll
            for (int d = 0; d < PD; ++d) {
                const int kt = kt0 + d;
                if (kt + PD < nk) {
#pragma unroll
                    for (int j = 0; j < NJ; ++j) st[d][j] = *(const u32x4*)(gp[j] + 64 * (kt + PD)); }
                LAS const unsigned char* T = L0 + (d & 1) * TILE;
#pragma unroll
                for (int ks = 0; ks < 2; ++ks) {
                    const h16x8 a0 = *(LAS const h16x8*)(T + aoff + 64 * ks), a1 = *(LAS const h16x8*)(T + aoff + 16 * RS + 64 * ks);
#pragma unroll
                    for (int n = 0; n < NN; ++n) { const h16x8 bn = *(LAS const h16x8*)(T + boff + n * 16 * RS + 64 * ks);
                        acc[0][n] = __builtin_amdgcn_mfma_f32_16x16x32_f16(bn, a0, acc[0][n], 0, 0, 0); acc[1][n] = __builtin_amdgcn_mfma_f32_16x16x32_f16(bn, a1, acc[1][n], 0, 0, 0); }
                }
                if (kt + 1 < nk) {
#pragma unroll
                    for (int j = 0; j < NJ; ++j) *(LAS u32x4*)(L0 + ((d + 1) & 1) * TILE + lo[j]) = st[(d + 1) % PD][j]; }
                LDS_BARRIER();
            }
        }
#pragma unroll
        for (int m = 0; m < 2; ++m)
#pragma unroll
            for (int n = 0; n < NN; ++n) { const int col = col0 + wc * (CW / 4) + 16 * n + 4 * h, row = wr * 32 + 16 * m + i; const f32x4 v = acc[m][n];
                if (MODE == 0) { *(u32x2*)(O + (u0 + row) * ldc + col) = (u32x2){pk_h16(v[0], v[1]), pk_h16(v[2], v[3])}; }
                else { float* dst = ctx + ((size_t)b * CTXL + r0 + row) * DM + col; const f32x4 g = *(const f32x4*)(mod + 4 * 6144 + goff + col);
                    *(f32x4*)dst = *(const f32x4*)dst + g * v; } }
    }
    __syncthreads();
}

template <int L>
__device__ __forceinline__ void layer_program(Frame& F, const Args& args, cg::grid_group& grid, const XcdBarrier& xbar) {
    constexpr int PB = 1 + 12 * L;
    float* MOD = WSP(float, WS_MOD) + L * 5 * 6144; float* CTX = WSP(float, WS_CTX);
#define XIN_ (L == 0 ? F.in[I_X] : F.out)
    RUNPH(0, ph_norm(F, XIN_, L == 0 ? F.in[I_CTX] : CTX, F.in[I_N1G] + L * DM, MOD, 0, 1024, WSP(h16, WS_H16), L == 0 ? CTX : nullptr););
    RUNPH(1, pg8::Gemm g{WSP(h16, WS_H16), L == 0 ? WSP(h16, WS_WEVIN) : WSP(h16, WS_WODIN), MU, L == 0 ? P0LD : P1LD, DM, DM, DM};
        pg8::StaticOrder S; S.init(g.M, g.N, F.G, blockIdx.x, L == 0 ? CTXG : 0); pg8::EpiH16 E{WSP(h16, WS_BIG), L == 0 ? P0LD : P1LD};
        pg8::gemm_phase<pg8::EpiH16>(F.lds, g, S, E);
        if (L == 0 && CTXG) ctx_gemm<0, 128>(F, g.A, g.lda, g.Bt, g.ldb, g.K, g.N, WSP(h16, WS_BIG), P0LD, nullptr, nullptr, 0););
    RUNPH(2, ph_scanA(F, L););
    RUNPH(3, ph_scanB(F, L););
    RUNPH(4, ph_scanC(F, L););
    RUNPH(5, if (L == 0) ph_fin0(F); else ph_fin1(F););
    if (L == 0 && (REPM & 0x10000u) && PH_IN(PB + 5)) { xcd_barrier(xbar); ph_fin0(F, true); xcd_barrier(xbar); }
    if (L == 1) RUNPH(6, pg8::Gemm g{(const h16*)(F.ws + WS_BIG + B1_ZB), WSP(h16, WS_WGLU), MU, 512, 512, 512, 512};
        pg8::StaticOrder S; S.init(g.M, g.N, F.G, blockIdx.x, 1); pg8::EpiGlu E{(const h16*)(F.ws + WS_BIG + B1_ZB), WSP(h16, WS_H16), F.in[I_S5BGLU]};
        pg8::gemm_phase<pg8::EpiGlu>(F.lds, g, S, E););
    RUNPH(7, pg8::Gemm g{WSP(h16, WS_H16), L == 0 ? WSP(h16, WS_WEVOUT) : WSP(h16, WS_WODOUT), MU, DM, DM, DM, DM};
        pg8::StaticOrder S; S.init(g.M, g.N, F.G, blockIdx.x, (L == 1 || CTXG) ? 1 : 0); pg8::EpiResid E{XIN_, F.out, CTX, MOD, 2048, L == 0 ? 1 : 0};
        pg8::gemm_phase<pg8::EpiResid>(F.lds, g, S, E);
        if (L == 0 && CTXG) ctx_gemm<1, 128>(F, g.A, g.lda, g.Bt, g.ldb, g.K, g.N, nullptr, 0, CTX, MOD, 2048););
    RUNPH(8, ph_norm(F, F.out, CTX, F.in[I_N2G] + L * DM, MOD, 3072, 4096, WSP(h16, WS_H16), nullptr););
    RUNPH(9, pg8::Gemm g{WSP(h16, WS_H16), WSP(h16, WS_WUP + (size_t)L * 11 * MiB), MU, GVLD, DM, DM, DM};
        pg8::StaticOrder S; S.init(g.M, g.N, F.G, blockIdx.x, (L == 1 || CTXG) ? 1 : 0); pg8::EpiH16 E{WSP(h16, WS_BIG), GVLD};
        pg8::gemm_phase<pg8::EpiH16>(F.lds, g, S, E);
        if (L == 0 && CTXG) ctx_gemm<0, 128>(F, g.A, g.lda, g.Bt, g.ldb, g.K, g.N, WSP(h16, WS_BIG), GVLD, nullptr, nullptr, 0););
    RUNPH(10, ph_conv(F, L););
    if ((REPM & 0x20000u) && ((REPL >> L) & 1u) && PH_IN(PB + 10)) { ph_conv(F, L, true); xcd_barrier(xbar); }
    RUNPH(11, pg8::Gemm g{WSP(h16, WS_BIG) + DFF, WSP(h16, WS_WDN + (size_t)L * 6 * MiB), MU, DM, DFF, GVLD, DFF};
        pg8::StaticOrder S; S.init(g.M, g.N, F.G, blockIdx.x, (L == 1 || CTXG) ? 1 : 0); pg8::EpiResid E{F.out, F.out, CTX, MOD, 5120, L == 0 ? 1 : 0};
        pg8::gemm_phase<pg8::EpiResid>(F.lds, g, S, E);
        if (L == 0 && CTXG) ctx_gemm<1, 128>(F, g.A, g.lda, g.Bt, g.ldb, g.K, g.N, nullptr, 0, CTX, MOD, 5120););
}
__global__ void __launch_bounds__(NTHR, 2) mega_fwd(Args args) {
    extern __shared__ __attribute__((aligned(16))) unsigned char lds_raw[];
    cg::grid_group grid = cg::this_grid();
    Frame F;
    F.lds = (LAS unsigned char*)lds_raw; F.out = args.out; F.ws = args.ws;
    { const float** tab = (const float**)(args.ws + WS_TAB);
      if (threadIdx.x == 0) {
#pragma unroll
          for (int i = 0; i < N_IN; ++i) __hip_atomic_store(tab + i, args.in[i], __ATOMIC_RELAXED, __HIP_MEMORY_SCOPE_AGENT);
          __threadfence();
      }
      __syncthreads();
      F.in = tab; }
    F.tid = threadIdx.x; F.lane = F.tid & 63; F.wave = __builtin_amdgcn_readfirstlane(F.tid >> 6);
    F.G = gridDim.x; F.gw = blockIdx.x * NWAVES + F.wave; F.ngw = F.G * NWAVES;
    { volatile LAS unsigned* st_ = (volatile LAS unsigned*)(F.lds + 131072 + 320); if (F.tid < 4) st_[F.tid] = 0u; }
    __syncthreads();
    const XcdBarrier xbar = xcd_barrier_post((unsigned*)(args.ws + WS_XBAR), (volatile LAS unsigned*)(F.lds + 131072 + 320));
    if (PH_IN(0)) { if (REPM & 0x40000u) ph_prologue(F); if (PHM & 0x1000u) ph_prologue(F); PH_SYNC(0); for (int xs_ = 0; xs_ < XSYNC; ++xs_) grid.sync(); }
    layer_program<0>(F, args, grid, xbar);
    layer_program<1>(F, args, grid, xbar);
    if (PH_IN(25)) { if (PHM & 0x2000u) ph_final(F); }
}

extern "C" void kernel_launch(void* const* d_in, const int* in_sizes, int n_in, void* d_out, int out_size, void* d_ws, size_t ws_size, hipStream_t stream) {
    static int grid_blocks = 0;
    if (grid_blocks == 0) {
        if (n_in != N_IN || out_size != NB * SEQ * DM || ws_size < WS_END) { fprintf(stderr, "kernel_launch: unexpected shapes (n_in %d, out %d, ws %zu)\n", n_in, out_size, ws_size); grid_blocks = -1; return; }
        int dev = 0, cus = 0, per_cu = 0;
        hipGetDevice(&dev); hipDeviceGetAttribute(&cus, hipDeviceAttributeMultiprocessorCount, dev);
        hipFuncSetAttribute((const void*)mega_fwd, hipFuncAttributeMaxDynamicSharedMemorySize, LDS_BYTES);
        hipOccupancyMaxActiveBlocksPerMultiprocessor(&per_cu, (const void*)mega_fwd, NTHR, LDS_BYTES);
        if (per_cu < 1) { fprintf(stderr, "kernel_launch: occupancy query says %d blocks per CU\n", per_cu); grid_blocks = -1; return; }
        grid_blocks = cus;
    }
    if (grid_blocks < 0) return;
    if (hipMemsetAsync((char*)d_ws + WS_XBAR, 0, XCD_BAR_WORDS * 4, stream) != hipSuccess) { fprintf(stderr, "kernel_launch: memset of barrier words failed\n"); return; }
    Args a{};
    for (int i = 0; i < N_IN; ++i) a.in[i] = (const float*)d_in[i];
    a.out = (float*)d_out; a.ws = (unsigned char*)d_ws;
#if MK_PER_PHASE
    for (int ph = 0; ph < N_PHASES; ++ph) {
        if (ph == 7) continue;
        a.ph_lo = ph; a.ph_hi = ph + 1; void* kargs[] = {&a};
        hipError_t e = hipLaunchCooperativeKernel((const void*)mega_fwd, dim3(grid_blocks), dim3(NTHR), kargs, LDS_BYTES, stream);
        if (e != hipSuccess) { fprintf(stderr, "launch of phase %d failed: %s\n", ph, hipGetErrorString(e)); break; }
    }
#else
    a.ph_lo = 0; a.ph_hi = N_PHASES; void* kargs[] = {&a};
    hipError_t e = hipLaunchCooperativeKernel((const void*)mega_fwd, dim3(grid_blocks), dim3(NTHR), kargs, LDS_BYTES, stream);
    if (e != hipSuccess) fprintf(stderr, "cooperative launch failed: %s (grid %d)\n", hipGetErrorString(e), grid_blocks);
#endif
}
```

```cpp
#include <hip/hip_runtime.h>
#include <hip/hip_cooperative_groups.h>
#include <cstdio>
#include <cstdint>
namespace cg = cooperative_groups;

#ifndef MK_PER_PHASE
#define MK_PER_PHASE 0
#endif
#ifndef GLAH
#define GLAH 1
#endif
#ifndef RWLC
#define RWLC 1
#endif
#ifndef GLLC
#define GLLC (!RWLC)
#endif
#ifndef S5WG
#define S5WG 1
#endif
#ifndef RWPF
#define RWPF 1
#endif

#ifndef REPM
#define REPM 0u
#endif
#ifndef CHK
#define CHK 0x6Fu
#endif
#ifndef RWSER
#define RWSER 0
#endif
#ifndef DETCHK
#define DETCHK 0
#endif
#ifndef SCRUB
#define SCRUB 0
#endif
#ifndef RWZERO
#define RWZERO 0
#endif
#ifndef USE_CG_SYNC
#define USE_CG_SYNC 0
#endif
#ifndef RWMODE
#define RWMODE 3
#endif
#ifndef REPL
#define REPL 3u
#endif
#ifndef XSYNC
#define XSYNC 0
#endif
#ifndef DBGM
#define DBGM 0
#endif
#ifndef PHM
#define PHM 0xFFFFu
#endif
#define LAS __attribute__((address_space(3)))
typedef _Float16 h16;
typedef _Float16 h16x8 __attribute__((ext_vector_type(8)));
typedef _Float16 h16x4 __attribute__((ext_vector_type(4)));
typedef _Float16 h16x2 __attribute__((ext_vector_type(2)));
typedef float f32x4 __attribute__((ext_vector_type(4)));
typedef float f32x2 __attribute__((ext_vector_type(2)));
typedef unsigned u32x4 __attribute__((ext_vector_type(4)));
typedef unsigned u32x2 __attribute__((ext_vector_type(2)));

constexpr int NB = 4, SEQ = 8192, CTXL = 256, DM = 1024, TT = SEQ + CTXL, MU = NB * TT;
constexpr int EVC = 4480, P0LD = 4608, ODC = 2080, P1LD = 2304, DFF = 2816, GVLD = 2 * DFF;
constexpr int NSC = 16, SCL = TT / NSC;
constexpr int NWAVES = 8, NTHR = 512;
static_assert(SCL * NSC == TT && SCL % 8 == 0 && CTXL % 8 == 0, "scan tiling");

enum { I_X = 0, I_C, I_CTX, I_CCTX, I_ADAW, I_ADAB, I_N1G, I_N2G, I_FING, I_EVWIN, I_EVWOUT, I_HGLB, I_HGNG, I_RWMU, I_RWW0, I_RWW2, I_RWA0, I_RWA2,
       I_RWG2, I_RWKK, I_RWKA, I_RWRK, I_RWLNG, I_RWLNB, I_ODWIN, I_ODWOUT, I_GLAW2, I_GLAB, I_GLANG, I_S5ARE, I_S5AIM, I_S5LDT, I_S5BRE, I_S5BIM,
       I_S5CRE, I_S5CIM, I_S5D, I_S5WGLU, I_S5BGLU, I_FFNUP, I_FFNCW, I_FFNCB, I_FFNDN, N_IN };

constexpr size_t MiB = 1u << 20;
constexpr size_t WS_CTL = 0, WS_TAB = 4096, WS_XBAR = 65536, WS_MOD = 1 * MiB, WS_S5P = 2 * MiB, WS_CTX = 3 * MiB, WS_BSC = 7 * MiB;
constexpr size_t WS_WEVIN = 10 * MiB, WS_WEVOUT = 19 * MiB, WS_WODIN = 21 * MiB, WS_WODOUT = 26 * MiB, WS_WUP = 28 * MiB  ,
                 WS_WDN = 50 * MiB  , WS_WGLU = 62 * MiB, WS_G2T = 63 * MiB;
constexpr size_t WS_H16 = 64 * MiB, WS_BIG = 130 * MiB, WS_END = 512 * MiB;
constexpr size_t WS_S5E = 493 * MiB, WS_S5Q = 497 * MiB, WS_S5G = 501 * MiB, WS_S5L = 501 * MiB + 512 * 1024, WS_BSP = 502 * MiB + 512 * 1024;
static_assert(WS_H16 + (size_t)MU * DM * 2 <= WS_BIG && WS_BIG + (size_t)MU * GVLD * 2 <= WS_S5E, "ws map");
constexpr size_t DO_OBWD = 0, DO_STH = 66 * MiB, DO_STR = 96 * MiB, DO_DH = 126 * MiB;
constexpr size_t B1_OBWD = 150 * MiB, B1_STG = 216 * MiB, B1_DG = 231 * MiB, B1_ZB = 236 * MiB, B1_HLOC = 269 * MiB;
constexpr size_t B0_QE = 297 * MiB;
static_assert((size_t)MU * P1LD * 2 <= B1_OBWD && B1_ZB + (size_t)MU * 512 * 2 <= B1_HLOC && B1_HLOC + (size_t)256 * 528 * 512 <= (size_t)MU * GVLD * 2, "layer-1 scratch map");

#define DPP_F(x, ctrl) __builtin_bit_cast(float, __builtin_amdgcn_update_dpp(0, __builtin_bit_cast(int, (x)), (ctrl), 0xf, 0xf, false))
__device__ __forceinline__ float wave_sum(float v) {
    v += DPP_F(v, 0x128); v += DPP_F(v, 0x124); v += DPP_F(v, 0x122); v += DPP_F(v, 0x121);
    return ((__builtin_bit_cast(float, __builtin_amdgcn_readlane(__builtin_bit_cast(int, v), 0)) + __builtin_bit_cast(float, __builtin_amdgcn_readlane(__builtin_bit_cast(int, v), 16))) +
            (__builtin_bit_cast(float, __builtin_amdgcn_readlane(__builtin_bit_cast(int, v), 32)) + __builtin_bit_cast(float, __builtin_amdgcn_readlane(__builtin_bit_cast(int, v), 48))));
}
__device__ __forceinline__ float sum8_dpp(float v) {
    v += DPP_F(v, 0xB1); v += DPP_F(v, 0x4E); v += DPP_F(v, 0x141);
    return v;
}
__device__ __forceinline__ float rcpf_(float x) { return __builtin_amdgcn_rcpf(x); }
__device__ __forceinline__ float sigm(float x) { return rcpf_(1.f + __expf(-x)); }
__device__ __forceinline__ float sigm_fast(float x) { return rcpf_(1.f + __expf(-x)); }
__device__ __forceinline__ float row_sum16(float x) {
    x += __builtin_bit_cast(float, __builtin_amdgcn_update_dpp(0, __builtin_bit_cast(int, x), 0x128, 0xf, 0xf, false));
    x += __builtin_bit_cast(float, __builtin_amdgcn_update_dpp(0, __builtin_bit_cast(int, x), 0x124, 0xf, 0xf, false));
    x += __builtin_bit_cast(float, __builtin_amdgcn_update_dpp(0, __builtin_bit_cast(int, x), 0x122, 0xf, 0xf, false));
    x += __builtin_bit_cast(float, __builtin_amdgcn_update_dpp(0, __builtin_bit_cast(int, x), 0x121, 0xf, 0xf, false));
    return x;
}
__device__ __forceinline__ float silu(float x) { return x * rcpf_(1.f + __expf(-x)); }
__device__ __forceinline__ float softplus(float x) { return fmaxf(x, 0.f) + 0.6931471805599453f * __builtin_amdgcn_logf(1.f + __expf(-fabsf(x))); }
__device__ __forceinline__ float tanh_(float x) { const float e = __expf(2.f * x); return 1.f - 2.f * rcpf_(e + 1.f); }
__device__ __forceinline__ float gelu_tanh(float x) { return 0.5f * x * (1.f + tanh_(0.7978845608028654f * (x + 0.044715f * x * x * x))); }
__device__ __forceinline__ unsigned pk_h16(float lo, float hi) { h16x2 v = {(h16)lo, (h16)hi}; return __builtin_bit_cast(unsigned, v); }
__device__ __forceinline__ int scan_row(int d, int b, int j) { const int s = d == 0 ? j : (j < CTXL ? CTXL - 1 - j : (TT + CTXL - 1) - j); return b * TT + s; }

namespace pg8 {
constexpr int BM = 256, BK = 64, HALF = 128, HTB = HALF * BK * 2, STAGE_BYTES = 8 * HTB, NXCD = 8, WGM = 8;
__host__ __device__ __forceinline__ int lds_byte(int r, int c) { const int st = (r >> 4) * 2 + (c >> 5), rr = r & 15, cc = c & 31, ob = rr * 64 + cc * 2; return st * 1024 + (ob ^ (((ob >> 9) & 1) << 5)); }
__host__ __device__ __forceinline__ void stage_rc(int b, int& R, int& C) { const int st = b / 1024, sb = b % 1024, swz = sb ^ (((sb >> 9) & 1) << 5); R = (st >> 1) * 16 + swz / 64; C = (st & 1) * 32 + (swz % 64) / 2; }
__host__ __device__ __forceinline__ int perm32(int rho) { const int n = rho >> 4, i = rho & 15; return 8 * (i >> 2) + 4 * n + (i & 3); }
struct Unit { int pm, pn; };
struct Gemm { const h16* A; const h16* Bt; int M, N, K, lda, ldb; };
struct StaticOrder {
    int nM, nN, nwg, G, c;
    int skipctx;
    __device__ void init(int M, int N, int G_, int c_, int skipctx_ = 0) { skipctx = skipctx_; nM = M / BM - (skipctx_ ? 4 : 0); nN = N / BM; nwg = nM * nN; G = G_; c = c_; }
    __device__ bool next(int i, Unit& u) const {
        const long L = (long)i * G + c; if (L >= nwg) return false;
        int wgid = (int)L; { const int q = nwg / NXCD, r = nwg % NXCD, xcd = wgid % NXCD, off = wgid / NXCD; wgid = (xcd < r ? xcd * (q + 1) : r * (q + 1) + (xcd - r) * q) + off; }
        const int nig = WGM * nN, gid = wgid / nig, fm = gid * WGM, gsz = (nM - fm) < WGM ? (nM - fm) : WGM;
        u.pm = fm + ((wgid % nig) % gsz); u.pn = (wgid % nig) / gsz; if (skipctx) u.pm = (u.pm >> 5) * 33 + 1 + (u.pm & 31); return true;
    }
};

struct EpiH16 {
    static constexpr bool PERM = true;
    h16* O; int ldc;
    __device__ __forceinline__ void operator()(const f32x4 (&acc)[2][2][4][2], const Unit& u, int wr, int wc, int fr, int fq) const {
        const int row0 = u.pm * BM + wr * 64 + fr, col0 = u.pn * BM + wc * 32 + 8 * fq;
#pragma unroll
        for (int ai = 0; ai < 2; ++ai)
#pragma unroll
            for (int m = 0; m < 4; ++m) { h16* rowp = O + (size_t)(row0 + ai * HALF + m * 16) * ldc + col0;
#pragma unroll
                for (int bj = 0; bj < 2; ++bj) { const f32x4 v0 = acc[ai][bj][m][0], v1 = acc[ai][bj][m][1];
                    u32x4 w; w.x = pk_h16(v0[0], v0[1]); w.y = pk_h16(v0[2], v0[3]); w.z = pk_h16(v1[0], v1[1]); w.w = pk_h16(v1[2], v1[3]);
                    *(u32x4*)(rowp + bj * HALF) = w; } }
    }
};
struct EpiGlu {
    static constexpr bool PERM = true;
    const h16* Z; h16* O; const float* bias;
    __device__ __forceinline__ void operator()(const f32x4 (&acc)[2][2][4][2], const Unit& u, int wr, int wc, int fr, int fq) const {
        const int row0 = u.pm * BM + wr * 64 + fr, col0 = u.pn * BM + wc * 32 + 8 * fq;
#pragma unroll
        for (int bj = 0; bj < 2; ++bj) { const int c = col0 + bj * HALF; const f32x4 b0 = *(const f32x4*)(bias + c), b1 = *(const f32x4*)(bias + c + 4);
#pragma unroll
            for (int ai = 0; ai < 2; ++ai)
#pragma unroll
                for (int m = 0; m < 4; ++m) { const size_t r = (size_t)(row0 + ai * HALF + m * 16);
                    const h16x8 z = *(const h16x8*)(Z + r * 512 + c); const f32x4 v0 = acc[ai][bj][m][0] + b0, v1 = acc[ai][bj][m][1] + b1;
                    u32x4 w; w.x = pk_h16((float)z[0] * sigm(v0[0]), (float)z[1] * sigm(v0[1])); w.y = pk_h16((float)z[2] * sigm(v0[2]), (float)z[3] * sigm(v0[3]));
                    w.z = pk_h16((float)z[4] * sigm(v1[0]), (float)z[5] * sigm(v1[1])); w.w = pk_h16((float)z[6] * sigm(v1[2]), (float)z[7] * sigm(v1[3]));
                    *(u32x4*)(O + r * 1024 + 512 + c) = w; } }
    }
};
struct EpiResid {
    static constexpr bool PERM = false;
    const float* xsrc; float* xdst; float* ctx; const float* mod; int goff; int do_ctx;
    __device__ __forceinline__ void operator()(const f32x4 (&acc)[2][2][4][2], const Unit& u, int wr, int wc, int fr, int fq) const {
        const int b = u.pm / 33, jt = u.pm % 33;
        const int col0 = u.pn * BM + wc * 32 + 4 * fq;
        if (jt == 0 && !do_ctx) return;
        const float* gv = mod + (jt == 0 ? 4 : b) * 6144 + goff;
        const float* src; float* dst;
        if (jt == 0) { src = ctx + (size_t)b * CTXL * DM; dst = ctx + (size_t)b * CTXL * DM; }
        else { const size_t o = ((size_t)b * SEQ + (size_t)(jt - 1) * 256) * DM; src = xsrc + o; dst = xdst + o; }
#pragma unroll
        for (int bj = 0; bj < 2; ++bj)
#pragma unroll
            for (int n = 0; n < 2; ++n) { const int c = col0 + bj * HALF + n * 16; const f32x4 g = *(const f32x4*)(gv + c);
                f32x4 bs[2][4];
#pragma unroll
                for (int ai = 0; ai < 2; ++ai)
#pragma unroll
                    for (int m = 0; m < 4; ++m) bs[ai][m] = *(const f32x4*)(src + (size_t)(ai * HALF + wr * 64 + m * 16 + fr) * DM + c);
#pragma unroll
                for (int ai = 0; ai < 2; ++ai)
#pragma unroll
                    for (int m = 0; m < 4; ++m) *(f32x4*)(dst + (size_t)(ai * HALF + wr * 64 + m * 16 + fr) * DM + c) = bs[ai][m] + g * acc[ai][bj][m][n]; }
    }
};

template <class Epi>
__device__ __forceinline__ void gemm_phase(LAS unsigned char* lds, const Gemm g, const StaticOrder& S, const Epi& E) {
    const int tid = threadIdx.x, wid = __builtin_amdgcn_readfirstlane(tid >> 6), lane = tid & 63, wr = wid >> 2, wc = wid & 3, fr = lane & 15, fq = lane >> 4;
    const int K = g.K, nt = K / BK;
    unsigned voffA[2], voffB[2];
#pragma unroll
    for (int i = 0; i < 2; ++i) { int R, C; stage_rc(tid * 16 + i * 8192, R, C); const int Rb = Epi::PERM ? ((R & ~31) + perm32(R & 31)) : R;
        voffA[i] = (unsigned)(R * g.lda + C) * 2u; voffB[i] = (unsigned)(Rb * g.ldb + C) * 2u; }
    const size_t kstep = (size_t)(BK * 2);
    const size_t hA = (size_t)HALF * g.lda * 2, hB = (size_t)HALF * g.ldb * 2, tA = 2 * hA, tB = 2 * hB;
    const unsigned ldsw = (unsigned)wid * 1024u;
    const int aoff = lds_byte(wr * 64 + fr, fq * 8), boff = lds_byte(wc * 32 + fr, fq * 8);
#define PG8_SA(b, h) (((b) * 2 + (h)) * HTB)
#define PG8_SB(b, h) ((4 + (b) * 2 + (h)) * HTB)
#define PG8_STAGE(bufoff, gbase, voff) do { _Pragma("unroll") for (int _i = 0; _i < 2; ++_i) \
        __builtin_amdgcn_global_load_lds((const unsigned*)((const char*)(gbase) + (voff)[_i]), (LAS unsigned*)(lds + (bufoff) + ldsw + _i * 8192), 16, 0, 0); } while (0)
#define PG8_LDA(dst, b, h) do { _Pragma("unroll") for (int m = 0; m < 4; ++m) _Pragma("unroll") for (int k = 0; k < 2; ++k) dst[m][k] = *(const LAS h16x8*)(lds + PG8_SA(b, h) + aoff + m * 2048 + k * 1024); } while (0)
#define PG8_LDB(dst, b, h) do { _Pragma("unroll") for (int n = 0; n < 2; ++n) _Pragma("unroll") for (int k = 0; k < 2; ++k) dst[n][k] = *(const LAS h16x8*)(lds + PG8_SB(b, h) + boff + n * 2048 + k * 1024); } while (0)
#define PG8_MMA(ai, bj, At, Bt) do { __builtin_amdgcn_s_setprio(1); _Pragma("unroll") for (int m = 0; m < 4; ++m) _Pragma("unroll") for (int n = 0; n < 2; ++n) _Pragma("unroll") for (int k = 0; k < 2; ++k) \
        acc[ai][bj][m][n] = __builtin_amdgcn_mfma_f32_16x16x32_f16(Bt[n][k], At[m][k], acc[ai][bj][m][n], 0, 0, 0); __builtin_amdgcn_s_setprio(0); } while (0)
#define PG8_WAIT_V(n) asm volatile("s_waitcnt vmcnt(" #n ")" ::: "memory")
#define PG8_WAIT_L(n) asm volatile("s_waitcnt lgkmcnt(" #n ")" ::: "memory")
#define PG8_BAR __builtin_amdgcn_s_barrier()
#define PG8_SCHED __builtin_amdgcn_sched_barrier(0)
    Unit cur, nxt; int ui = 0;
    if (!S.next(0, cur)) return;
    f32x4 acc[2][2][4][2];
#pragma unroll
    for (int a = 0; a < 2; ++a)
#pragma unroll
        for (int b = 0; b < 2; ++b)
#pragma unroll
            for (int m = 0; m < 4; ++m)
#pragma unroll
                for (int n = 0; n < 2; ++n) acc[a][b][m][n] = (f32x4){0.f, 0.f, 0.f, 0.f};
    h16x8 At[4][2], B0[2][2], B1[2][2];
    const char* cA = (const char*)g.A + (size_t)cur.pm * tA; const char* cB = (const char*)g.Bt + (size_t)cur.pn * tB;
    PG8_STAGE(PG8_SB(0, 0), cB, voffB); PG8_STAGE(PG8_SB(0, 1), cB + hB, voffB); PG8_STAGE(PG8_SA(0, 0), cA, voffA); PG8_STAGE(PG8_SA(0, 1), cA + hA, voffA);
    if (wr == 1) PG8_BAR;
    PG8_WAIT_V(2); PG8_BAR;
    PG8_STAGE(PG8_SB(1, 0), cB + kstep, voffB); PG8_STAGE(PG8_SA(1, 0), cA + kstep, voffA); PG8_STAGE(PG8_SB(1, 1), cB + hB + kstep, voffB);
    PG8_WAIT_V(6); PG8_BAR;
    for (;;) {
        const bool has_next = S.next(ui + 1, nxt);
        const char* nA = has_next ? (const char*)g.A + (size_t)nxt.pm * tA : cA; const char* nB = has_next ? (const char*)g.Bt + (size_t)nxt.pn * tB : cB;
        for (int t = 0; t < nt; t += 2) {
            const bool last = (t == nt - 2);
            const char* a1 = cA + (size_t)(t + 1) * kstep;
            const char* a2 = last ? nA : cA + (size_t)(t + 2) * kstep; const char* b2 = last ? nB : cB + (size_t)(t + 2) * kstep;
            const char* a3 = a2 + kstep; const char* b3 = b2 + kstep;
            PG8_LDB(B0, 0, 0); PG8_LDB(B1, 0, 1); PG8_SCHED; PG8_LDA(At, 0, 0); PG8_STAGE(PG8_SA(1, 1), a1 + hA, voffA);
            PG8_WAIT_V(8); PG8_WAIT_L(0); PG8_BAR; PG8_MMA(0, 0, At, B0); PG8_MMA(0, 1, At, B1); PG8_BAR; PG8_SCHED;
            PG8_LDA(At, 0, 1); PG8_STAGE(PG8_SB(0, 0), b2, voffB); PG8_STAGE(PG8_SB(0, 1), b2 + hB, voffB); PG8_STAGE(PG8_SA(0, 0), a2, voffA);
            PG8_WAIT_V(8); PG8_WAIT_L(0); PG8_BAR; PG8_MMA(1, 0, At, B0); PG8_MMA(1, 1, At, B1); PG8_BAR; PG8_SCHED;
            PG8_LDB(B0, 1, 0); PG8_LDB(B1, 1, 1); PG8_SCHED; PG8_LDA(At, 1, 0); PG8_STAGE(PG8_SA(0, 1), a2 + hA, voffA);
            PG8_WAIT_V(8); PG8_WAIT_L(0); PG8_BAR; PG8_MMA(0, 0, At, B0); PG8_MMA(0, 1, At, B1); PG8_BAR; PG8_SCHED;
            PG8_LDA(At, 1, 1); PG8_STAGE(PG8_SB(1, 0), b3, voffB); PG8_STAGE(PG8_SB(1, 1), b3 + hB, voffB); PG8_STAGE(PG8_SA(1, 0), a3, voffA);
            PG8_WAIT_V(8); PG8_WAIT_L(0); PG8_BAR; PG8_MMA(1, 0, At, B0); PG8_MMA(1, 1, At, B1); PG8_BAR; PG8_SCHED;
        }
        if (wr == 0) PG8_BAR;
        E(acc, cur, wr, wc, fr, fq);
        if (!has_next) break;
#pragma unroll
        for (int a = 0; a < 2; ++a)
#pragma unroll
            for (int b = 0; b < 2; ++b)
#pragma unroll
                for (int m = 0; m < 4; ++m)
#pragma unroll
                    for (int n = 0; n < 2; ++n) acc[a][b][m][n] = (f32x4){0.f, 0.f, 0.f, 0.f};
        cur = nxt; cA = nA; cB = nB; ++ui;
        if (wr == 1) PG8_BAR;
    }
    PG8_WAIT_V(0);
    PG8_BAR;
#undef PG8_SA
#undef PG8_SB
#undef PG8_STAGE
#undef PG8_LDA
#undef PG8_LDB
#undef PG8_MMA
#undef PG8_WAIT_V
#undef PG8_WAIT_L
#undef PG8_BAR
#undef PG8_SCHED
}
}

constexpr int LDS_BYTES = 147456;
struct Args { const float* in[N_IN]; float* out; unsigned char* ws; int ph_lo, ph_hi; };

struct Frame {
    LAS unsigned char* lds;
    const float* const* in; float* out; unsigned char* ws;
    int tid, lane, wave, gw, ngw, G;
};
#define WSP(T, off) ((T*)(F.ws + (off)))
typedef const __attribute__((address_space(1))) float* gfloatp;
#define FIN(i) ((const float*)(((const gfloatp*)F.in)[i]))
#define LDS_WAIT() asm volatile("s_waitcnt lgkmcnt(0)" ::: "memory")
#define LDS_BARRIER() asm volatile("s_waitcnt lgkmcnt(0)\n\ts_barrier" ::: "memory")

__device__ __forceinline__ void transpose_item(const float* W, int K, int N, h16* WT, LAS float* scr, int item, int lane) {
    const int nblk = N / 32, kb = item / nblk, nb = item % nblk, k0 = 64 * kb, n0 = 32 * nb;
    float wv[32];
#pragma unroll
    for (int i = 0; i < 32; ++i) wv[i] = W[(size_t)(k0 + 2 * i + (lane >> 5)) * N + n0 + (lane & 31)];
#pragma unroll
    for (int i = 0; i < 32; ++i) scr[(2 * i + (lane >> 5)) * 33 + (lane & 31)] = wv[i];
    LDS_WAIT();
    const int c = lane & 7;
#pragma unroll
    for (int j = 0; j < 4; ++j) { const int n = (lane >> 3) + 8 * j; const LAS float* s = scr + (8 * c) * 33 + n;
        u32x4 o; o.x = pk_h16(s[0 * 33], s[1 * 33]); o.y = pk_h16(s[2 * 33], s[3 * 33]); o.z = pk_h16(s[4 * 33], s[5 * 33]); o.w = pk_h16(s[6 * 33], s[7 * 33]);
        *(u32x4*)(WT + (size_t)(n0 + n) * K + k0 + 8 * c) = o; }
    LDS_WAIT();
}
constexpr int TR_EI = 16 * 140, TR_EO = 16 * 32, TR_OI = 16 * 65, TR_OO = 16 * 32, TR_UP = 16 * 176, TR_DN = 44 * 32, TR_GL = 8 * 16, TR_G2 = 2 * 16;
constexpr int TR_LATE = TR_EO + TR_OI + TR_OO + 2 * TR_UP + 2 * TR_DN + TR_GL + TR_G2;
__device__ __forceinline__ void ph_weights_late(Frame& F, int wv, int nwv) {
    LAS float* scr = (LAS float*)(F.lds + 49152 + F.wave * 8448);
    for (int it = wv; it < TR_LATE; it += nwv) {
        int r = it;
        if (r < TR_EO) { transpose_item(FIN(I_EVWOUT), 1024, 1024, WSP(h16, WS_WEVOUT), scr, r, F.lane); continue; } r -= TR_EO;
        if (r < TR_OI) { transpose_item(FIN(I_ODWIN), 1024, ODC, WSP(h16, WS_WODIN), scr, r, F.lane); continue; } r -= TR_OI;
        if (r < TR_OO) { transpose_item(FIN(I_ODWOUT), 1024, 1024, WSP(h16, WS_WODOUT), scr, r, F.lane); continue; } r -= TR_OO;
        if (r < 2 * TR_UP) { const int l = r / TR_UP; transpose_item(FIN(I_FFNUP) + (size_t)l * 1024 * GVLD, 1024, GVLD, WSP(h16, WS_WUP + (size_t)l * 11 * MiB), scr, r % TR_UP, F.lane); continue; } r -= 2 * TR_UP;
        if (r < 2 * TR_DN) { const int l = r / TR_DN; transpose_item(FIN(I_FFNDN) + (size_t)l * DFF * 1024, DFF, 1024, WSP(h16, WS_WDN + (size_t)l * 6 * MiB), scr, r % TR_DN, F.lane); continue; } r -= 2 * TR_DN;
        if (r < TR_GL) { transpose_item(FIN(I_S5WGLU), 512, 512, WSP(h16, WS_WGLU), scr, r, F.lane); continue; } r -= TR_GL;
        transpose_item(FIN(I_RWG2), 128, 512, WSP(h16, WS_G2T), scr, r, F.lane);
    }
    const int gt = wv * 64 + F.lane, ngt = nwv * 64;
    u32x4* z1 = (u32x4*)(WSP(h16, WS_WODIN) + (size_t)ODC * 1024); const int n1 = (P1LD - ODC) * 1024 / 8;
    for (int i = gt; i < n1; i += ngt) z1[i] = (u32x4){0u, 0u, 0u, 0u};
}
__device__ __forceinline__ void ph_prologue(Frame& F) {
    LAS float* scr = (LAS float*)(F.lds + F.wave * 16384);
    if (blockIdx.x == 0 && F.tid == 0) *(unsigned*)(F.ws + WS_CTL) = 0u;
#if SCRUB
    {
        const size_t gt = (size_t)blockIdx.x * NTHR + F.tid, ngt = (size_t)F.G * NTHR;
        u32x4* a = (u32x4*)F.out; for (size_t i = gt; i < (size_t)128 * MiB / 16; i += ngt) a[i] = (u32x4){0u, 0u, 0u, 0u};
        u32x4* b = (u32x4*)(F.ws + WS_H16); for (size_t i = gt; i < (size_t)(429) * MiB / 16; i += ngt) b[i] = (u32x4){0u, 0u, 0u, 0u};
        u32x4* c = (u32x4*)(F.ws + WS_BSP); for (size_t i = gt; i < (size_t)9 * MiB / 16; i += ngt) c[i] = (u32x4){0u, 0u, 0u, 0u};
    }
#endif
    for (int it = F.gw; it < TR_EI; it += F.ngw) transpose_item(FIN(I_EVWIN), 1024, EVC, WSP(h16, WS_WEVIN), scr, it, F.lane);
    {
        const int gt = F.gw * 64 + F.lane, ngt = F.ngw * 64;
        u32x4* z0 = (u32x4*)(WSP(h16, WS_WEVIN) + (size_t)EVC * 1024); const int n0 = (P0LD - EVC) * 1024 / 8;
        for (int i = gt; i < n0; i += ngt) z0[i] = (u32x4){0u, 0u, 0u, 0u};
    }
    {
        LAS float* red = (LAS float*)F.lds;
        LAS float* SC = red + 8 * 5 * 64;
        float* MOD = WSP(float, WS_MOD);
        __syncthreads();
        if (blockIdx.x < 192) {
            for (int e = F.tid; e < 5 * 1024; e += NTHR) { const int r = e >> 10, k = e & 1023; SC[e] = silu(r < 4 ? FIN(I_C)[r * 1024 + k] : FIN(I_CCTX)[k]); }
            __syncthreads();
        }
        for (int it = blockIdx.x; it < 192; it += F.G) {
            const int l = it / 96, col = (it % 96) * 64 + F.lane;
            const float* W = FIN(I_ADAW) + (size_t)l * 1024 * 6144 + col;
            float acc[5] = {0.f, 0.f, 0.f, 0.f, 0.f};
#pragma unroll 1
            for (int k0 = F.wave * 128; k0 < F.wave * 128 + 128; k0 += 16) {
                float wv[16];
#pragma unroll
                for (int j = 0; j < 16; ++j) wv[j] = W[(size_t)(k0 + j) * 6144];
#pragma unroll
                for (int j = 0; j < 16; ++j)
#pragma unroll
                    for (int r = 0; r < 5; ++r) acc[r] += SC[r * 1024 + k0 + j] * wv[j];
            }
#pragma unroll
            for (int r = 0; r < 5; ++r) red[(F.wave * 5 + r) * 64 + F.lane] = acc[r];
            __syncthreads();
            if (F.wave == 0) {
#pragma unroll
                for (int r = 0; r < 5; ++r) { float s = FIN(I_ADAB)[l * 6144 + col];
#pragma unroll
                    for (int w = 0; w < 8; ++w) s += red[(w * 5 + r) * 64 + F.lane];
                    MOD[(l * 5 + r) * 6144 + col] = s; }
            }
            __syncthreads();
        }
    }
    {
        LAS float* PWR = (LAS float*)F.lds, *PWI = PWR + 17 * 64, *BBR = PWI + 17 * 64, *BBI = BBR + 1024, *CR = BBI + 1024, *CI = CR + 1024;
        h16* E16 = WSP(h16, WS_S5E); h16* Q16 = WSP(h16, WS_S5Q); h16* G16 = WSP(h16, WS_S5G); float* L16 = WSP(float, WS_S5L);
        for (int dg = (blockIdx.x + 64) % F.G; dg < 64; dg += F.G) {
            __syncthreads();
            if (F.tid < 64) {
                const int n = F.tid, i = dg * 64 + n;
                const float are = FIN(I_S5ARE)[i], aim = FIN(I_S5AIM)[i], dt = __expf(FIN(I_S5LDT)[dg]);
                const float mag = __expf(are * dt); float sn, cs; sincosf(aim * dt, &sn, &cs);
                const float lr = mag * cs, li = mag * sn;
                float pr = 1.f, pi = 0.f;
                for (int t = 0; t < 17; ++t) { PWR[t * 64 + n] = pr; PWI[t * 64 + n] = pi; const float qr = pr * lr - pi * li, qi = pr * li + pi * lr; pr = qr; pi = qi; }
                const float nr = lr - 1.f, ni = li, den = are * are + aim * aim;
                const float cr = (nr * are + ni * aim) / den, ci = (ni * are - nr * aim) / den;
                for (int c = 0; c < 16; ++c) { const float br = FIN(I_S5BRE)[i * 16 + c], bi = FIN(I_S5BIM)[i * 16 + c];
                    BBR[n * 16 + c] = cr * br - ci * bi; BBI[n * 16 + c] = cr * bi + ci * br; }
                L16[(dg * 64 + n) * 2] = PWR[16 * 64 + n]; L16[(dg * 64 + n) * 2 + 1] = PWI[16 * 64 + n];
            }
            for (int e = F.tid; e < 1024; e += NTHR) { CR[e] = FIN(I_S5CRE)[dg * 1024 + e]; CI[e] = FIN(I_S5CIM)[dg * 1024 + e]; }
            __syncthreads();
            for (int e = F.tid; e < 16 * 128 * 16; e += NTHR) {
                const int cp = e & 15, nidx = (e >> 4) & 127, tau = e >> 11, n = nidx & 63;
                const float pr = PWR[tau * 64 + n], pi = PWI[tau * 64 + n], br = BBR[n * 16 + cp], bi = BBI[n * 16 + cp];
                E16[(size_t)dg * 32768 + e] = (h16)(256.f * (nidx < 64 ? pr * br - pi * bi : pr * bi + pi * br));
            }
            for (int e = F.tid; e < 16 * 16 * 128; e += NTHR) {
                const int nidx = e & 127, c = (e >> 7) & 15, t = e >> 11, n = nidx & 63;
                const float pr = PWR[(t + 1) * 64 + n], pi = PWI[(t + 1) * 64 + n], cr = CR[c * 64 + n], ci = CI[c * 64 + n];
                Q16[(size_t)dg * 32768 + e] = (h16)(nidx < 64 ? cr * pr - ci * pi : -(cr * pi + ci * pr));
            }
            for (int e = F.tid; e < 16 * 16 * 16; e += NTHR) {
                const int cp = e & 15, c = (e >> 4) & 15, tau = e >> 8; float acc = 0.f;
                for (int n = 0; n < 64; ++n) { const float pr = PWR[tau * 64 + n], pi = PWI[tau * 64 + n], cr = CR[c * 64 + n], ci = CI[c * 64 + n];
                    acc += (cr * pr - ci * pi) * BBR[n * 16 + cp] - (cr * pi + ci * pr) * BBI[n * 16 + cp]; }
                G16[(size_t)dg * 4096 + e] = (h16)(64.f * acc);
            }
        }
        __syncthreads();
    }
}

__device__ __forceinline__ void ph_norm(Frame& F, const float* xsrc, const float* ctxsrc, const float* ng, const float* mod, int shoff, int scoff, h16* out16, float* ctxcopy) {
    for (int u = F.gw; u < MU; u += F.ngw) {
        const int b = u / TT, s = u % TT;
        const float* src = s < CTXL ? ctxsrc + ((size_t)b * CTXL + s) * DM : xsrc + ((size_t)b * SEQ + (s - CTXL)) * DM;
        const float* mr = mod + (s < CTXL ? 4 : b) * 6144;
        f32x4 v[4]; float ss = 0.f;
#pragma unroll
        for (int j = 0; j < 4; ++j) { v[j] = *(const f32x4*)(src + 256 * j + 4 * F.lane); ss += (v[j].x * v[j].x + v[j].y * v[j].y) + (v[j].z * v[j].z + v[j].w * v[j].w); }
        const float rinv = rsqrtf(wave_sum(ss) * (1.f / DM) + 1e-6f);
#pragma unroll
        for (int j = 0; j < 4; ++j) { const int c = 256 * j + 4 * F.lane;
            const f32x4 g = *(const f32x4*)(ng + c), sc = *(const f32x4*)(mr + scoff + c), sh = *(const f32x4*)(mr + shoff + c);
            const f32x4 o = v[j] * rinv * g * (sc + 1.f) + sh;
            u32x2 w; w.x = pk_h16(o.x, o.y); w.y = pk_h16(o.z, o.w);
            *(u32x2*)(out16 + (size_t)u * DM + c) = w;
            if (ctxcopy && s < CTXL) *(f32x4*)(ctxcopy + ((size_t)b * CTXL + s) * DM + c) = v[j]; }
    }
}
__device__ __forceinline__ void ph_final(Frame& F) {
    const float* g = FIN(I_FING);
    const unsigned detflag = __hip_atomic_load((unsigned*)(F.ws + WS_CTL), __ATOMIC_RELAXED, __HIP_MEMORY_SCOPE_AGENT);
    for (int t = F.gw; t < NB * SEQ; t += F.ngw) {
        float* row = F.out + (size_t)t * DM;
        f32x4 v[4]; float ss = 0.f;
#pragma unroll
        for (int j = 0; j < 4; ++j) { v[j] = *(const f32x4*)(row + 256 * j + 4 * F.lane); ss += (v[j].x * v[j].x + v[j].y * v[j].y) + (v[j].z * v[j].z + v[j].w * v[j].w); }
        const float rinv = rsqrtf(wave_sum(ss) * (1.f / DM) + 1e-6f);
#pragma unroll
        for (int j = 0; j < 4; ++j) { const int c = 256 * j + 4 * F.lane; f32x4 o = v[j] * rinv * *(const f32x4*)(g + c); if (detflag) o = o * 3.0f; *(f32x4*)(row + c) = o; }
    }
}

__device__ __forceinline__ void ph_conv(Frame& F, int layer, bool dry = false) {
    h16* GV = WSP(h16, WS_BIG);
    const float* cw = FIN(I_FFNCW) + (size_t)layer * 9 * DFF; const float* cb = FIN(I_FFNCB) + (size_t)layer * DFF;
    constexpr int NF8 = DFF / 8, NROW = 264;
    const int total = NB * NROW * NF8;
    for (int it = blockIdx.x * NTHR + F.tid; it < total; it += F.G * NTHR) {
        const int f0 = (it % NF8) * 8, rq = (it / NF8) % NROW, b = it / (NF8 * NROW);
        const bool isctx = rq >= 256;
        const int rr = isctx ? 128 : (rq >> 1);
        const int ncol = isctx ? CTXL : 64, xs = isctx ? (rq - 256) * 32 : (rq & 1) * 32, xe = xs + 32;
        const size_t rowbase = (size_t)b * TT + (isctx ? 0 : CTXL + rr * 64);
        const bool hasup = !isctx && rr > 0, hasdn = !isctx && rr < 127;
        h16x8 w[3][3], bias;
#pragma unroll
        for (int di = 0; di < 3; ++di)
#pragma unroll
            for (int dj = 0; dj < 3; ++dj) { const f32x4 w0 = *(const f32x4*)(cw + (di * 3 + dj) * DFF + f0), w1 = *(const f32x4*)(cw + (di * 3 + dj) * DFF + f0 + 4);
                const float m = (di == 1 || (di == 0 ? hasup : hasdn)) ? 1.f : 0.f;
                w[di][dj] = (h16x8){(h16)(m * w0.x), (h16)(m * w0.y), (h16)(m * w0.z), (h16)(m * w0.w), (h16)(m * w1.x), (h16)(m * w1.y), (h16)(m * w1.z), (h16)(m * w1.w)}; }
        { const f32x4 b0 = *(const f32x4*)(cb + f0), b1 = *(const f32x4*)(cb + f0 + 4); bias = (h16x8){(h16)b0.x, (h16)b0.y, (h16)b0.z, (h16)b0.w, (h16)b1.x, (h16)b1.y, (h16)b1.z, (h16)b1.w}; }
        h16x8 accP, accC = bias, accN = bias;
#pragma unroll
        for (int e = 0; e < 8; ++e) accP[e] = (h16)0.f;
        const h16* g0 = GV + rowbase * GVLD + f0;
        const ptrdiff_t up = hasup ? -(ptrdiff_t)64 * GVLD : 0, dn = hasdn ? (ptrdiff_t)64 * GVLD : 0;
        struct CvSet { h16x8 gu, gc, gd, vv; };
        auto cv_load = [&](CvSet& S, int xg, int xv) {
            const int xc = xg < 0 ? 0 : (xg < ncol ? xg : ncol - 1); const h16* gp = g0 + (ptrdiff_t)xc * GVLD; S.gu = *(const h16x8*)(gp + up); S.gc = *(const h16x8*)gp; S.gd = *(const h16x8*)(gp + dn);
            const int xw = xv < xs ? xs : (xv < xe ? xv : xe - 1); S.vv = *(const h16x8*)(GV + (rowbase + xw) * GVLD + DFF + f0); };
        auto cv_step = [&](CvSet& S, int x, h16x8& accP, h16x8& accC, h16x8& accN) {
            const h16x8 gu = S.gu, gc = S.gc, gd = S.gd, vv = S.vv;
            if (x >= 0 && x < ncol) {
                accP += w[0][2] * gu + w[1][2] * gc + w[2][2] * gd;
                accC += w[0][1] * gu + w[1][1] * gc + w[2][1] * gd;
                accN += w[0][0] * gu + w[1][0] * gc + w[2][0] * gd;
            }
            if (x > xs) {
                h16* vp = GV + (rowbase + x - 1) * GVLD + DFF + f0;
                u32x4 o; o.x = pk_h16(silu((float)accP[0]) * (float)vv[0], silu((float)accP[1]) * (float)vv[1]); o.y = pk_h16(silu((float)accP[2]) * (float)vv[2], silu((float)accP[3]) * (float)vv[3]);
                o.z = pk_h16(silu((float)accP[4]) * (float)vv[4], silu((float)accP[5]) * (float)vv[5]); o.w = pk_h16(silu((float)accP[6]) * (float)vv[6], silu((float)accP[7]) * (float)vv[7]);
                if (dry) *(u32x4*)(WSP(h16, WS_H16) + ((((size_t)(rowbase + x - 1)) * DFF + f0) % ((size_t)MU * DM - 8) & ~(size_t)7)) = o; else *(u32x4*)vp = o;
            }
            accP = bias;
            cv_load(S, x + 3, x + 2);
        };
        CvSet S0, S1, S2;
        cv_load(S0, xs - 1, xs - 2); cv_load(S1, xs, xs - 1); cv_load(S2, xs + 1, xs);
#pragma unroll 1
        for (int x = xs - 1; x <= xe; x += 3) { cv_step(S0, x, accP, accC, accN); if (x + 1 <= xe) cv_step(S1, x + 1, accC, accN, accP); if (x + 2 <= xe) cv_step(S2, x + 2, accN, accP, accC); }
    }
}

template <int K, int NV, bool IS_HG>
__device__ __forceinline__ void gl_unit(Frame& F, bool phaseC, int sc, int d, int b, int head, int vhalf, const h16* P, int ldp, float* ST, float* DD, h16* odir) {
    LAS float* L = (LAS float*)(F.lds + F.wave * 16384);
    LAS float* Ldec = L, *Lkin = L + 8 * K, *Lq = L + 16 * K, *Lv = L + 24 * K;
    const int lane = F.lane, stream = (d * NB + b) * 4 + head;
    constexpr int KI = K / 64;
    float S[NV][K];
    if (phaseC && sc > 0) {
        const float* st = ST + ((size_t)(sc - 1) * 32 + stream) * K * 128;
#pragma unroll
        for (int nv = 0; nv < NV; ++nv)
#pragma unroll
            for (int k = 0; k < K; ++k) S[nv][k] = st[k * 128 + (NV == 2 ? nv * 64 : vhalf * 64) + lane];
    } else {
#pragma unroll
        for (int nv = 0; nv < NV; ++nv)
#pragma unroll
            for (int k = 0; k < K; ++k) S[nv][k] = 0.f;
    }
    float dprod[KI], pr0[KI], pr1[KI * 16];
#pragma unroll
    for (int i = 0; i < KI; ++i) {
        dprod[i] = 1.f; const int k = lane + 64 * i;
        if (IS_HG) { const float* lb = FIN(I_HGLB); pr0[i] = sigm(lb[d * 512 + head * 128 + k] - lb[1024 + d * 512 + head * 128 + k]); }
        else { pr0[i] = FIN(I_GLAB)[d * 256 + head * 64 + k];
#pragma unroll
            for (int j = 0; j < 16; ++j) pr1[i * 16 + j] = FIN(I_GLAW2)[(d * 16 + j) * 256 + head * 64 + k]; }
    }
    for (int tile = 0; tile < SCL / 8; ++tile) {
        const int j0 = sc * SCL + tile * 8;
#pragma unroll
        for (int t = 0; t < 8; ++t) {
            const int u = scan_row(d, b, j0 + t); const h16* row = P + (size_t)u * ldp;
#pragma unroll
            for (int i = 0; i < KI; ++i) {
                const int k = lane + 64 * i; float dec, kin, qq;
                if (IS_HG) {
                    const float f = pr0[i] + (1.f - pr0[i]) * sigm((float)row[1024 + d * 512 + head * 128 + k]);
                    dec = f; kin = 1.f - f; qq = silu((float)row[head * 128 + k]) * 0.08838834764831845f;
                } else {
                    float z = pr0[i];
                    const h16x8 g0 = *(const h16x8*)(row + 1536 + d * 16), g1 = *(const h16x8*)(row + 1536 + d * 16 + 8);
#pragma unroll
                    for (int j = 0; j < 8; ++j) z += (float)g0[j] * pr1[i * 16 + j] + (float)g1[j] * pr1[i * 16 + 8 + j];
                    dec = __expf(-softplus(-z) * (1.f / 16.f)); kin = (float)row[256 + head * 64 + k]; qq = (float)row[head * 64 + k] * 0.125f;
                }
                Ldec[t * K + k] = dec; Lkin[t * K + k] = kin; Lq[t * K + k] = qq; dprod[i] *= dec;
            }
#pragma unroll
            for (int nv = 0; nv < NV; ++nv) { const int v = (NV == 2 ? nv * 64 : vhalf * 64) + lane; Lv[t * 128 + nv * 64 + lane] = (float)row[512 + head * 128 + v]; }
        }
        LDS_WAIT();
#pragma unroll 1
        for (int t = 0; t < 8; ++t) {
            float vin[NV], o[NV];
#pragma unroll
            for (int nv = 0; nv < NV; ++nv) { vin[nv] = Lv[t * 128 + nv * 64 + lane]; o[nv] = 0.f; }
#pragma unroll
            for (int k4 = 0; k4 < K / 4; ++k4) {
                const f32x4 d4 = *(const LAS f32x4*)(Ldec + t * K + 4 * k4), i4 = *(const LAS f32x4*)(Lkin + t * K + 4 * k4);
                f32x4 q4 = (f32x4){0.f, 0.f, 0.f, 0.f}; if (phaseC) q4 = *(const LAS f32x4*)(Lq + t * K + 4 * k4);
#pragma unroll
                for (int e = 0; e < 4; ++e)
#pragma unroll
                    for (int nv = 0; nv < NV; ++nv) { float& s = S[nv][4 * k4 + e]; s = d4[e] * s + i4[e] * vin[nv]; o[nv] += q4[e] * s; }
            }
            if (phaseC) { const int u = scan_row(d, b, j0 + t);
#pragma unroll
                for (int nv = 0; nv < NV; ++nv) odir[(size_t)u * DM + head * 128 + (NV == 2 ? nv * 64 : vhalf * 64) + lane] = (h16)o[nv]; }
        }
    }
    if (!phaseC) {
        float* st = ST + ((size_t)sc * 32 + stream) * K * 128;
#pragma unroll
        for (int nv = 0; nv < NV; ++nv)
#pragma unroll
            for (int k = 0; k < K; ++k) st[k * 128 + (NV == 2 ? nv * 64 : vhalf * 64) + lane] = S[nv][k];
        if (vhalf == 0) {
#pragma unroll
            for (int i = 0; i < KI; ++i) DD[((size_t)sc * 32 + stream) * K + lane + 64 * i] = dprod[i];
        }
    }
}


__device__ __forceinline__ f32x4 mfma16s(h16x4 a, h16x4 b, f32x4 c) {
    const h16x8 a8 = {a[0], a[1], a[2], a[3], (h16)0.f, (h16)0.f, (h16)0.f, (h16)0.f}, b8 = {b[0], b[1], b[2], b[3], (h16)0.f, (h16)0.f, (h16)0.f, (h16)0.f};
    return __builtin_amdgcn_mfma_f32_16x16x32_f16(a8, b8, c, 0, 0, 0);
}
__device__ __forceinline__ f32x4 mfma16p(h16x4 a1, h16x4 b1, h16x4 a2, h16x4 b2, f32x4 c) {
    const h16x8 a8 = {a1[0], a1[1], a1[2], a1[3], a2[0], a2[1], a2[2], a2[3]}, b8 = {b1[0], b1[1], b1[2], b1[3], b2[0], b2[1], b2[2], b2[3]};
    return __builtin_amdgcn_mfma_f32_16x16x32_f16(a8, b8, c, 0, 0, 0);
}
typedef __bf16 b16x8 __attribute__((ext_vector_type(8)));
__device__ __forceinline__ unsigned short f2bf(float f) { const __bf16 x = (__bf16)f; return __builtin_bit_cast(unsigned short, x); }
__device__ __forceinline__ unsigned short f2h(float f) { const h16 x = (h16)f; return __builtin_bit_cast(unsigned short, x); }
constexpr int GQ_QT = 0, GQ_QH = 4352, GQ_KH = 8704, GQ_KP = 13056, GQ_VT = 17152, GQ_DV = 21248, GQ_BUF = 21760, GQ_ROW = 272;

typedef _Float16 h16x2_ __attribute__((ext_vector_type(2)));
struct GlRaw { h16x2_ fa[8], xa[8], va[4]; h16x4 gr; };
template <int K, bool IS_HG>
__device__ __forceinline__ void gl_load(GlRaw& R, bool phaseC, int qt, int d, int b, int head, int j0, const h16* P, int ldp) {
    const int part = __builtin_amdgcn_readfirstlane(qt / K);
    const h16* row0 = P + (size_t)scan_row(d, b, j0) * ldp; const ptrdiff_t rstep = d == 0 ? (ptrdiff_t)ldp : -(ptrdiff_t)ldp;
    if (!phaseC && GLAH) {
        if (qt < 2 * K) { const int k = qt >> 1, hh = qt & 1;
            if (IS_HG) { const h16* pf = row0 + (ptrdiff_t)(8 * hh) * rstep + 1024 + d * 512 + head * 128 + k;
#pragma unroll
                for (int t = 0; t < 8; ++t) R.fa[t >> 1][t & 1] = pf[t * rstep]; }
            else { const h16* px = row0 + (ptrdiff_t)(8 * hh) * rstep + 256 + head * 64 + k;
#pragma unroll
                for (int t = 0; t < 8; ++t) R.xa[t >> 1][t & 1] = px[t * rstep];
                R.gr = *(const h16x4*)(row0 + (qt & 15) * rstep + 1536 + d * 16 + 4 * ((qt >> 4) & 3)); } }
        const int v = qt & 127, th = __builtin_amdgcn_readfirstlane(qt >> 7);
        const h16* pv = row0 + (ptrdiff_t)(8 * th) * rstep + 512 + head * 128 + v;
#pragma unroll
        for (int t = 0; t < 8; ++t) R.va[t >> 1][t & 1] = pv[t * rstep];
        return;
    }
    if (part < 2 && (part == 1 || phaseC)) {
        const int k = qt & (K - 1);
        if (IS_HG) {
            const h16* pf = row0 + 1024 + d * 512 + head * 128 + k;
#pragma unroll
            for (int t = 0; t < 16; ++t) R.fa[t >> 1][t & 1] = pf[t * rstep];
            if (part == 0) { const h16* px = row0 + head * 128 + k;
#pragma unroll
                for (int t = 0; t < 16; ++t) R.xa[t >> 1][t & 1] = px[t * rstep]; }
        } else {
            const h16* px = row0 + (part == 0 ? 0 : 256) + head * 64 + k;
#pragma unroll
            for (int t = 0; t < 16; ++t) R.xa[t >> 1][t & 1] = px[t * rstep];
            R.gr = *(const h16x4*)(row0 + (qt & 15) * rstep + 1536 + d * 16 + 4 * ((qt >> 4) & 3));
        }
    }
    { const int v = qt & 127, th = __builtin_amdgcn_readfirstlane(qt >> 7);
      const h16* pv = row0 + (ptrdiff_t)(8 * th) * rstep + 512 + head * 128 + v;
#pragma unroll
      for (int t = 0; t < 8; ++t) R.va[t >> 1][t & 1] = pv[t * rstep]; }
}
template <int K, bool IS_HG>
__device__ __forceinline__ void gl_math(const GlRaw& R, LAS unsigned char* buf, bool phaseC, int qt, int d, int b, int j0, const h16* P, int ldp, float c0, const h16x4 (&w2f)[4], LAS float* zs, float& dprod, h16* qeb = nullptr, int qecol = 0, int qeld = 0) {
    const int part = __builtin_amdgcn_readfirstlane(qt / K);
    if (!phaseC && GLAH) {
        if (qt < 2 * K) { const int k = qt >> 1, hh = qt & 1;
            float xv[8], D[8], El;
            if (IS_HG) {
                float fv[8];
#pragma unroll
                for (int t = 0; t < 8; ++t) { fv[t] = c0 + (1.f - c0) * sigm_fast((float)R.fa[t >> 1][t & 1]); xv[t] = 1.f - fv[t]; }
                float bw = 1.f;
#pragma unroll
                for (int t = 7; t >= 0; --t) { D[t] = bw; bw *= fv[t]; }
                const float oth = DPP_F(bw, 0xB1);
                if (hh == 0) {
#pragma unroll
                    for (int t = 0; t < 8; ++t) D[t] *= oth; }
                El = bw * oth;
            } else {
                const int li = qt & 15, lh = (qt >> 4) & 3;
#pragma unroll
                for (int nt = 0; nt < 4; ++nt) { const f32x4 zt = mfma16s(R.gr, w2f[nt], (f32x4){0.f, 0.f, 0.f, 0.f}); *(LAS f32x4*)(zs + (16 * nt + li) * 20 + 4 * lh) = zt; }
                LDS_WAIT();
                const f32x4 z0 = *(LAS const f32x4*)(zs + k * 20 + 8 * hh), z1 = *(LAS const f32x4*)(zs + k * 20 + 8 * hh + 4);
                float ls[8], run = 0.f;
#pragma unroll
                for (int t = 0; t < 8; ++t) { const float z = c0 + (t < 4 ? z0[t & 3] : z1[t & 3]); run += -softplus(-z) * (1.f / 16.f); ls[t] = run; xv[t] = (float)R.xa[t >> 1][t & 1]; }
                const float oth = DPP_F(run, 0xB1);
                const float tail = hh == 0 ? run + oth : run;
#pragma unroll
                for (int t = 0; t < 8; ++t) D[t] = __expf(tail - ls[t]);
                El = __expf(run + oth);
            }
            unsigned kp[4];
#pragma unroll
            for (int t = 0; t < 8; t += 2) kp[t >> 1] = pk_h16(xv[t] * D[t], xv[t + 1] * D[t + 1]);
            *(LAS u32x4*)(buf + GQ_KP + k * 32 + hh * 16) = (u32x4){kp[0], kp[1], kp[2], kp[3]};
            if (hh == 0) *(LAS float*)(buf + GQ_DV + k * 4) = El;
            dprod *= El;
        }
        const int v = qt & 127, th = __builtin_amdgcn_readfirstlane(qt >> 7);
        *(LAS u32x4*)(buf + GQ_VT + v * 32 + th * 16) = (u32x4){__builtin_bit_cast(unsigned, R.va[0]), __builtin_bit_cast(unsigned, R.va[1]), __builtin_bit_cast(unsigned, R.va[2]), __builtin_bit_cast(unsigned, R.va[3])};
        return;
    }
    if (part < 2) {
        const int k = qt & (K - 1);
        if (part == 1 || phaseC) {
            float run = IS_HG ? 1.f : 0.f;
            f32x4 zq[4];
            if (!IS_HG) {
                const int li = qt & 15, lh = (qt >> 4) & 3;
#pragma unroll
                for (int nt = 0; nt < 4; ++nt) { const f32x4 zt = mfma16s(R.gr, w2f[nt], (f32x4){0.f, 0.f, 0.f, 0.f}); *(LAS f32x4*)(zs + (16 * nt + li) * 20 + 4 * lh) = zt; }
                LDS_WAIT();
#pragma unroll
                for (int q = 0; q < 4; ++q) zq[q] = *(LAS const f32x4*)(zs + k * 20 + 4 * q);
            }
            if (part == 0) {
                float E[16], xv[16];
#pragma unroll
                for (int t = 0; t < 16; ++t) {
                    if (IS_HG) { const float f = c0 + (1.f - c0) * sigm_fast((float)R.fa[t >> 1][t & 1]); const float xa_ = (float)R.xa[t >> 1][t & 1];
                        run *= f; E[t] = run; xv[t] = xa_ * sigm_fast(xa_) * 0.08838834764831845f; }
                    else { const float z = c0 + zq[t >> 2][t & 3]; run += -softplus(-z) * (1.f / 16.f); E[t] = __expf(run); xv[t] = (float)R.xa[t >> 1][t & 1] * 0.125f; }
                }
                const float rm = rcpf_(E[7]), El = E[15];
                h16* qp = qeb ? qeb + (size_t)scan_row(d, b, j0) * qeld + qecol + k : nullptr; const ptrdiff_t qstep = d == 0 ? (ptrdiff_t)qeld : -(ptrdiff_t)qeld;
#pragma unroll
                for (int t = 0; t < 16; ++t) { const float q = xv[t] * E[t];
                    *(LAS unsigned short*)(buf + GQ_QT + t * GQ_ROW + k * 2) = f2h(q);
                    *(LAS unsigned short*)(buf + GQ_QH + t * GQ_ROW + k * 2) = f2bf(q * rm);
                    if (qeb) qp[t * qstep] = (h16)(q * dprod); }
                if (qeb) dprod *= El;
            } else {
                float D[16], xv[16];
                if (IS_HG) {
                    float fv[16];
#pragma unroll
                    for (int t = 0; t < 16; ++t) { fv[t] = c0 + (1.f - c0) * sigm_fast((float)R.fa[t >> 1][t & 1]); xv[t] = 1.f - fv[t]; }
                    float bw = 1.f;
#pragma unroll
                    for (int t = 15; t >= 0; --t) { D[t] = bw; bw *= fv[t]; }
                    run = bw;
                } else {
                    float rn[16];
#pragma unroll
                    for (int t = 0; t < 16; ++t) { const float z = c0 + zq[t >> 2][t & 3]; run += -softplus(-z) * (1.f / 16.f); rn[t] = run; xv[t] = (float)R.xa[t >> 1][t & 1]; }
#pragma unroll
                    for (int t = 0; t < 16; ++t) D[t] = __expf(rn[15] - rn[t]);
                    run = __expf(rn[15]);
                }
                const float El = run, rd7 = rcpf_(D[7]);
                float kd[16];
#pragma unroll
                for (int t = 0; t < 16; ++t) kd[t] = xv[t] * D[t];
                unsigned kp[8];
#pragma unroll
                for (int t = 0; t < 16; t += 2) kp[t >> 1] = pk_h16(kd[t], kd[t + 1]);
                *(LAS u32x4*)(buf + GQ_KP + k * 32) = (u32x4){kp[0], kp[1], kp[2], kp[3]}; *(LAS u32x4*)(buf + GQ_KP + k * 32 + 16) = (u32x4){kp[4], kp[5], kp[6], kp[7]};
                if (phaseC) {
#pragma unroll
                    for (int t = 0; t < 16; ++t) *(LAS unsigned short*)(buf + GQ_KH + t * GQ_ROW + k * 2) = f2bf(kd[t] * rd7);
                }
                *(LAS float*)(buf + GQ_DV + k * 4) = El; dprod *= El;
            }
        }
    }
    { const int v = qt & 127, th = __builtin_amdgcn_readfirstlane(qt >> 7);
      *(LAS u32x4*)(buf + GQ_VT + v * 32 + th * 16) = (u32x4){__builtin_bit_cast(unsigned, R.va[0]), __builtin_bit_cast(unsigned, R.va[1]), __builtin_bit_cast(unsigned, R.va[2]), __builtin_bit_cast(unsigned, R.va[3])}; }
}

template <int K, bool IS_HG>
__device__ __forceinline__ void gl_quad(Frame& F, bool phaseC, int sc, int stream, const h16* P, int ldp, float* ST, float* DD, h16* odir, bool local = false, h16* qebase = nullptr, int qeld = 0) {
    const int quad = F.wave >> 2, w4 = F.wave & 3, qt = ((F.tid & 255) + (quad << 7)) & 255, lane = F.lane, i = lane & 15, h = lane >> 4;
    const int d = stream >> 4, b = (stream >> 2) & 3, head = stream & 3;
    LAS unsigned char* QB = F.lds + quad * (2 * GQ_BUF);
    constexpr int NKT = K / 16;
    f32x4 Sacc[NKT][2];
    if (phaseC && sc > 0 && !local) {
        const float* st = ST + ((size_t)(sc - 1) * 32 + stream) * K * 128;
#pragma unroll
        for (int kt = 0; kt < NKT; ++kt)
#pragma unroll
            for (int vt = 0; vt < 2; ++vt)
#pragma unroll
                for (int r = 0; r < 4; ++r) Sacc[kt][vt][r] = st[(16 * kt + 4 * h + r) * 128 + 32 * w4 + 16 * vt + i];
    } else {
#pragma unroll
        for (int kt = 0; kt < NKT; ++kt) { Sacc[kt][0] = (f32x4){0.f, 0.f, 0.f, 0.f}; Sacc[kt][1] = (f32x4){0.f, 0.f, 0.f, 0.f}; }
    }
    float c0 = 0.f; h16x4 w2f[4];
#pragma unroll
    for (int j = 0; j < 4; ++j) w2f[j] = (h16x4){(h16)0.f, (h16)0.f, (h16)0.f, (h16)0.f};
    LAS float* zs = (LAS float*)(F.lds + 90112 + (quad * 2 + (w4 & 1)) * 5120);
    if (qt < 2 * K) { const int k = (!phaseC && GLAH) ? (qt >> 1) : (qt & (K - 1));
        if (IS_HG) { const float* lb = FIN(I_HGLB); c0 = sigm(lb[d * 512 + head * 128 + k] - lb[1024 + d * 512 + head * 128 + k]); }
        else { c0 = FIN(I_GLAB)[d * 256 + head * 64 + k];
#pragma unroll
            for (int nt = 0; nt < 4; ++nt)
#pragma unroll
                for (int jj = 0; jj < 4; ++jj) w2f[nt][jj] = (h16)FIN(I_GLAW2)[(d * 16 + 4 * h + jj) * 256 + head * 64 + 16 * nt + i]; } }
    float dprod = 1.f;
    constexpr int NCH = SCL / 16;
    const int jbase = sc * SCL;
    h16* qeb = (local && sc > 0) ? qebase : nullptr; const int qecol = d * (4 * K) + head * K;
    __syncthreads();
    GlRaw R0, R1;
    gl_load<K, IS_HG>(R0, phaseC, qt, d, b, head, jbase, P, ldp);
    gl_load<K, IS_HG>(R1, phaseC, qt, d, b, head, jbase + 16, P, ldp);
    gl_math<K, IS_HG>(R0, QB, phaseC, qt, d, b, jbase, P, ldp, c0, w2f, zs, dprod, qeb, qecol, qeld);
    __syncthreads();
    auto chunk_iter = [&](const int c, GlRaw& RL, GlRaw& RM) {
        if (c + 2 < NCH) gl_load<K, IS_HG>(RL, phaseC, qt, d, b, head, jbase + 16 * (c + 2), P, ldp);
        LAS const unsigned char* buf = QB + (c & 1) * GQ_BUF;
        h16x4 vf[2];
#pragma unroll
        for (int vt = 0; vt < 2; ++vt) vf[vt] = *(LAS const h16x4*)(buf + GQ_VT + (32 * w4 + 16 * vt + i) * 32 + h * 8);
        if (phaseC) {
            f32x4 pm = (f32x4){0.f, 0.f, 0.f, 0.f};
#pragma unroll
            for (int ks = 0; ks < K / 32; ++ks) {
                const b16x8 ka = *(LAS const b16x8*)(buf + GQ_KH + i * GQ_ROW + (32 * ks + 8 * h) * 2), qb = *(LAS const b16x8*)(buf + GQ_QH + i * GQ_ROW + (32 * ks + 8 * h) * 2);
                pm = __builtin_amdgcn_mfma_f32_16x16x32_bf16(ka, qb, pm, 0, 0, 0);
            }
            h16x4 af;
#pragma unroll
            for (int r = 0; r < 4; ++r) af[r] = (4 * h + r <= i) ? (h16)pm[r] : (h16)0.f;
            f32x4 o[2];
#pragma unroll
            for (int vt = 0; vt < 2; ++vt) o[vt] = mfma16s(vf[vt], af, (f32x4){0.f, 0.f, 0.f, 0.f});
#pragma unroll
            for (int ks = 0; ks < K / 32; ++ks) {
                const h16x4 q0 = *(LAS const h16x4*)(buf + GQ_QT + i * GQ_ROW + (32 * ks + 4 * h) * 2), q1 = *(LAS const h16x4*)(buf + GQ_QT + i * GQ_ROW + (32 * ks + 16 + 4 * h) * 2);
                const h16x8 qa = {q0[0], q0[1], q0[2], q0[3], q1[0], q1[1], q1[2], q1[3]};
#pragma unroll
                for (int vt = 0; vt < 2; ++vt) { const f32x4 s0 = Sacc[2 * ks][vt], s1 = Sacc[2 * ks + 1][vt];
                    const h16x8 sb = {(h16)s0[0], (h16)s0[1], (h16)s0[2], (h16)s0[3], (h16)s1[0], (h16)s1[1], (h16)s1[2], (h16)s1[3]};
                    o[vt] = __builtin_amdgcn_mfma_f32_16x16x32_f16(sb, qa, o[vt], 0, 0, 0); }
            }
            { h16* orow = odir + (size_t)scan_row(d, b, jbase + 16 * c + i) * DM + head * 128 + 32 * w4 + 4 * h;
#pragma unroll
              for (int vt = 0; vt < 2; ++vt) *(u32x2*)(orow + 16 * vt) = (u32x2){pk_h16(o[vt][0], o[vt][1]), pk_h16(o[vt][2], o[vt][3])}; }
        }
#pragma unroll
        for (int kt = 0; kt < NKT; ++kt) {
            const f32x4 dv = *(LAS const f32x4*)(buf + GQ_DV + (16 * kt + 4 * h) * 4); const h16x4 kp = *(LAS const h16x4*)(buf + GQ_KP + (16 * kt + i) * 32 + h * 8);
#pragma unroll
            for (int vt = 0; vt < 2; ++vt) Sacc[kt][vt] = mfma16s(kp, vf[vt], dv * Sacc[kt][vt]);
        }
        if (c + 1 < NCH) gl_math<K, IS_HG>(RM, QB + ((c + 1) & 1) * GQ_BUF, phaseC, qt, d, b, jbase + 16 * (c + 1), P, ldp, c0, w2f, zs, dprod, qeb, qecol, qeld);
        LDS_BARRIER();
    };
#pragma unroll 1
    for (int c = 0; c < NCH; c += 2) { chunk_iter(c, R0, R1); if (c + 1 < NCH) chunk_iter(c + 1, R1, R0); }
    if (!phaseC || (local && sc < NSC - 1)) {
        float* st = ST + ((size_t)sc * 32 + stream) * K * 128;
#pragma unroll
        for (int kt = 0; kt < NKT; ++kt)
#pragma unroll
            for (int vt = 0; vt < 2; ++vt)
#pragma unroll
                for (int r = 0; r < 4; ++r) st[(16 * kt + 4 * h + r) * 128 + 32 * w4 + 16 * vt + i] = Sacc[kt][vt][r];
        if (!phaseC && GLAH) { if (qt < 2 * K && (qt & 1) == 0) DD[((size_t)sc * 32 + stream) * K + (qt >> 1)] = dprod; }
        else if (qt >= K && qt < 2 * K) DD[((size_t)sc * 32 + stream) * K + (qt & (K - 1))] = dprod;
    }
}
template <int K, bool IS_HG>
__device__ __forceinline__ void ph_glquads(Frame& F, bool phaseC, const h16* P, int ldp, float* ST, float* DD, h16* ofwd, h16* obwd, bool local = false, h16* qebase = nullptr, int qeld = 0) {
    const int nunits = phaseC ? NSC * 32 : (NSC - 1) * 32, nq = F.G * 2, gq = blockIdx.x * 2 + (F.wave >> 2);
    for (int base = 0; base < nunits; base += nq) {
        int unit = base + gq; if (unit >= nunits) unit %= nunits;
        const int sc = unit / 32, stream = unit % 32;
        gl_quad<K, IS_HG>(F, phaseC, sc, stream, P, ldp, ST, DD, (stream >> 4) == 0 ? ofwd : obwd, local, qebase, qeld);
    }
    __syncthreads();
}


template <int K>
__device__ __forceinline__ void ph_glcorr(Frame& F, const float* ST, const h16* qebase, int qeld, h16* ofwd, h16* obwd) {
    const int lane = F.lane, i = lane & 15, h = lane >> 4;
    constexpr int NKS = K / 32, NCH = SCL / 16;
    for (int unit = F.gw; unit < (NSC - 1) * 32 * 4; unit += F.ngw) {
        const int w4 = unit & 3, stream = (unit >> 2) & 31, sc = 1 + (unit >> 7);
        const int d = stream >> 4, b = (stream >> 2) & 3, head = stream & 3;
        h16* odir = d == 0 ? ofwd : obwd;
        const float* st = ST + ((size_t)(sc - 1) * 32 + stream) * K * 128 + 32 * w4;
        h16x8 sa[NKS][2];
#pragma unroll
        for (int ks = 0; ks < NKS; ++ks)
#pragma unroll
            for (int vt = 0; vt < 2; ++vt)
#pragma unroll
                for (int jj = 0; jj < 8; ++jj) sa[ks][vt][jj] = (h16)st[(size_t)(32 * ks + 8 * h + jj) * 128 + 16 * vt + i];
        const int qecol = d * (4 * K) + head * K + 8 * h, jbase = sc * SCL;
        h16x8 qf[NKS]; u32x2 ov[2];
        { const size_t u = scan_row(d, b, jbase + i);
#pragma unroll
          for (int ks = 0; ks < NKS; ++ks) qf[ks] = *(const h16x8*)(qebase + u * qeld + qecol + 32 * ks);
#pragma unroll
          for (int vt = 0; vt < 2; ++vt) ov[vt] = *(const u32x2*)(odir + u * DM + head * 128 + 32 * w4 + 16 * vt + 4 * h); }
#pragma unroll 1
        for (int c = 0; c < NCH; ++c) {
            const size_t u = scan_row(d, b, jbase + 16 * c + i), un = scan_row(d, b, jbase + 16 * (c + 1 < NCH ? c + 1 : c) + i);
            f32x4 o[2] = {(f32x4){0.f, 0.f, 0.f, 0.f}, (f32x4){0.f, 0.f, 0.f, 0.f}};
#pragma unroll
            for (int ks = 0; ks < NKS; ++ks) {
                o[0] = __builtin_amdgcn_mfma_f32_16x16x32_f16(sa[ks][0], qf[ks], o[0], 0, 0, 0); o[1] = __builtin_amdgcn_mfma_f32_16x16x32_f16(sa[ks][1], qf[ks], o[1], 0, 0, 0);
                qf[ks] = *(const h16x8*)(qebase + un * qeld + qecol + 32 * ks);
            }
#pragma unroll
            for (int vt = 0; vt < 2; ++vt) { const h16x4 old = __builtin_bit_cast(h16x4, ov[vt]);
                h16* op = odir + u * DM + head * 128 + 32 * w4 + 16 * vt + 4 * h;
                *(u32x2*)op = (u32x2){pk_h16((float)old[0] + o[vt][0], (float)old[1] + o[vt][1]), pk_h16((float)old[2] + o[vt][2], (float)old[3] + o[vt][3])};
                ov[vt] = *(const u32x2*)(odir + un * DM + head * 128 + 32 * w4 + 16 * vt + 4 * h); }
        }
    }
}

constexpr int RQ_AT = 0, RQ_RT = 2304, RQ_AH = 4608, RQ_RH = 6912, RQ_BH = 9216, RQ_KH = 11520, RQ_BP = 13824, RQ_KP = 15872, RQ_VT = 17920, RQ_DV = 19968, RQ_TM = 20224, RQ_MK = 20736, RQ_MB = 21248, RQ_MR = 21760, RQ_BUF = 22272, RQ_ROW = 144;
constexpr int RQ_LWF = 65536;
constexpr int RQ_KKL = 81920;
constexpr int RQ_SCR = 2 * RQ_BUF, RS_RR = 0, RS_RK = 4096, RS_TW = 8192, RS_TA = 10496, RS_MAB = 12800, RS_RV = 13824, RS_NRM = 13824  , RS_END = 17920;

template <bool PA, bool LOC = false>
__device__ __forceinline__ void rw_chunk_unit(Frame& F, int sc, int stream, const h16* P, float* STR, float* BSP, h16* odir, bool cmp = false, int cmpmode = 1, h16* rho = nullptr) {
    constexpr bool OUT = !PA || LOC;
    const int lane = F.lane, i = lane & 15, h = lane >> 4, w = F.wave & 3;
    const bool producer = F.wave >= 4;
    const int d = stream >> 5, b = (stream >> 3) & 3, head = stream & 7;
    LAS unsigned char* L = F.lds;
    LAS unsigned char* SCR = F.lds + RQ_SCR;
    constexpr int NVT = PA ? 2 : 1;
    constexpr int NCH = SCL / 16;
    const int jbase = sc * SCL;
    const int pt = F.tid & 255, pc = pt & 63, tq = pt >> 6;
    const int cown = 16 * w + i;
    float m0R = 0, m1R = 0, m0K = 0, m1K = 0, m0V = 0, m1V = 0, m0W = 0, m1W = 0, m0A = 0, m1A = 0, kkq[4] = {0, 0, 0, 0}, kac = 0, rkc = 0, w0c = 0, a0c = 0;
    h16x8 w2f[2], a2f[2];
    const int cR = head * 64 + pc, cK = 512 + head * 64 + pc, cV = 1024 + head * 64 + pc, cW = 1536 + d * 64 + pc, cA = 1664 + d * 64 + pc;
    if (producer) {
        const float* mu = FIN(I_RWMU);
        m0R = mu[cR]; m1R = mu[1920 + cR]; m0K = mu[cK]; m1K = mu[1920 + cK]; m0V = mu[cV]; m1V = mu[1920 + cV]; m0W = mu[cW]; m1W = mu[1920 + cW]; m0A = mu[cA]; m1A = mu[1920 + cA];
#pragma unroll
        for (int q = 0; q < 4; ++q) kkq[q] = FIN(I_RWKK)[head * 64 + 16 * q + i];
        kac = FIN(I_RWKA)[head * 64 + cown]; rkc = FIN(I_RWRK)[head * 64 + cown]; w0c = FIN(I_RWW0)[d * 512 + head * 64 + cown]; a0c = FIN(I_RWA0)[d * 512 + head * 64 + cown];
        const float* w2 = FIN(I_RWW2) + (size_t)d * 64 * 512 + head * 64 + cown; const float* a2 = FIN(I_RWA2) + (size_t)d * 64 * 512 + head * 64 + cown;
#pragma unroll
        for (int ks = 0; ks < 2; ++ks)
#pragma unroll
            for (int jj = 0; jj < 8; ++jj) { w2f[ks][jj] = (h16)w2[(size_t)(32 * ks + 8 * h + jj) * 512]; a2f[ks][jj] = (h16)a2[(size_t)(32 * ks + 8 * h + jj) * 512]; }
        if (w == 0) *(LAS float*)(L + RQ_KKL + lane * 4) = FIN(I_RWKK)[head * 64 + lane];
#pragma unroll
        for (int ks = 0; ks < 2; ++ks) { *(LAS h16x8*)(L + RQ_LWF + ((w * 4 + ks) * 64 + lane) * 16) = w2f[ks]; *(LAS h16x8*)(L + RQ_LWF + ((w * 4 + 2 + ks) * 64 + lane) * 16) = a2f[ks]; }
    }
    f32x4 Sacc[4][NVT];
    if (!producer) {
#pragma unroll
        for (int kt = 0; kt < 4; ++kt)
#pragma unroll
            for (int vt = 0; vt < NVT; ++vt)
#pragma unroll
                for (int r = 0; r < 4; ++r) {
                    const int k = 16 * kt + 4 * h + r; float x = 0.f;
                    if (PA) { if (w >= 2) x = (k == 32 * (w - 2) + 16 * vt + i) ? 1.f : 0.f; }
                    else if (sc > 0) x = STR[(((size_t)(sc - 1) * 64 + stream) * 2) * 4096 + (16 * w + i) * 64 + k];
                    Sacc[kt][vt][r] = x; }
    }
    h16x4 praw_[5][3];
#define PR_SET(qn, j, val) praw_[qn][j] = (val)
#define PR_GET(qn, j) praw_[qn][j]
    if (producer && (!PA || RWPF)) {
        const int pt = w * 64 + lane, t = pt >> 4, cg = pt & 15;
        const int u = scan_row(d, b, jbase + t), s_ = u % TT;
        const bool hp = (s_ != 0 && s_ != CTXL), hn = (s_ != CTXL - 1 && s_ != TT - 1);
        const h16* pcur = P + (size_t)u * P0LD + 2560; const h16* pp = hp ? pcur - P0LD : pcur; const h16* pn = hn ? pcur + P0LD : pcur;
#pragma unroll
        for (int qn = 0; qn < 5; ++qn) {
            const int col = (qn < 3 ? 512 * qn + head * 64 : (qn == 3 ? 1536 : 1664) + d * 64) + 4 * cg;
            PR_SET(qn, 0, *(const h16x4*)(pcur + col)); PR_SET(qn, 1, *(const h16x4*)(pp + col)); PR_SET(qn, 2, *(const h16x4*)(pn + col));
        }
    }
    __syncthreads();
#if RWZERO
    for (int z_ = F.tid; z_ < (RQ_SCR + RS_END) / 4; z_ += NTHR) ((LAS unsigned*)L)[z_] = 0u;
    __syncthreads();
#endif
#pragma unroll 1
    for (int c = -1; c < NCH; ++c) {
        const int cn = c + 1;
        LAS unsigned char* PB = L + (cn & 1) * RQ_BUF;
        int ln_ = F.lane; asm volatile("" : "+v"(ln_));
        const int i = ln_ & 15, h = ln_ >> 4, cown = 16 * w + i, pc = ln_, tq = w;
        if (!producer && c >= 0) {
            LAS const unsigned char* CB = L + (c & 1) * RQ_BUF;
            const f32x4 z4 = (f32x4){0.f, 0.f, 0.f, 0.f};
            const h16x4 makf = *(LAS const h16x4*)(CB + RQ_MK + i * 32 + h * 8);
            h16x4 mrbf, mrkf;
            if (OUT) { mrbf = *(LAS const h16x4*)(CB + RQ_MB + i * 32 + h * 8); mrkf = *(LAS const h16x4*)(CB + RQ_MR + i * 32 + h * 8); }
            const h16x4 tmf = *(LAS const h16x4*)(CB + RQ_TM + i * 32 + h * 8);
            h16x8 atf[2], rtf[2];
#pragma unroll
            for (int ks = 0; ks < 2; ++ks) {
                const h16x4 a0 = *(LAS const h16x4*)(CB + RQ_AT + i * RQ_ROW + (32 * ks + 4 * h) * 2), a1 = *(LAS const h16x4*)(CB + RQ_AT + i * RQ_ROW + (32 * ks + 16 + 4 * h) * 2);
                atf[ks] = (h16x8){a0[0], a0[1], a0[2], a0[3], a1[0], a1[1], a1[2], a1[3]};
                if (OUT) { const h16x4 r0 = *(LAS const h16x4*)(CB + RQ_RT + i * RQ_ROW + (32 * ks + 4 * h) * 2), r1 = *(LAS const h16x4*)(CB + RQ_RT + i * RQ_ROW + (32 * ks + 16 + 4 * h) * 2);
                    rtf[ks] = (h16x8){r0[0], r0[1], r0[2], r0[3], r1[0], r1[1], r1[2], r1[3]}; }
            }
            f32x4 dvq[4]; h16x4 bpq[4], kpq[4];
#pragma unroll
            for (int kt = 0; kt < 4; ++kt) { dvq[kt] = *(LAS const f32x4*)(CB + RQ_DV + (16 * kt + 4 * h) * 4);
                bpq[kt] = *(LAS const h16x4*)(CB + RQ_BP + (16 * kt + i) * 32 + h * 8); kpq[kt] = *(LAS const h16x4*)(CB + RQ_KP + (16 * kt + i) * 32 + h * 8); }
#pragma unroll
            for (int vt = 0; vt < NVT; ++vt) {
                const bool inj = PA ? (w < 2) : true;
                const int vrow = PA ? (32 * w + 16 * vt + i) & 63 : 16 * w + i;
                h16x4 vtf = *(LAS const h16x4*)(CB + RQ_VT + vrow * 32 + h * 8);
                if (!inj) vtf = (h16x4){(h16)0.f, (h16)0.f, (h16)0.f, (h16)0.f};
                h16x8 sf[2];
#pragma unroll
                for (int ks = 0; ks < 2; ++ks) { const f32x4 s0 = Sacc[2 * ks][vt], s1 = Sacc[2 * ks + 1][vt];
                    sf[ks] = (h16x8){(h16)s0[0], (h16)s0[1], (h16)s0[2], (h16)s0[3], (h16)s1[0], (h16)s1[1], (h16)s1[2], (h16)s1[3]}; }
                f32x4 Z = mfma16s(makf, vtf, z4);
                Z = __builtin_amdgcn_mfma_f32_16x16x32_f16(atf[0], sf[0], Z, 0, 0, 0); Z = __builtin_amdgcn_mfma_f32_16x16x32_f16(atf[1], sf[1], Z, 0, 0, 0);
                const h16x4 zb = {(h16)Z[0], (h16)Z[1], (h16)Z[2], (h16)Z[3]};
                const f32x4 U = mfma16s(tmf, zb, z4);
                const h16x4 ub = {(h16)U[0], (h16)U[1], (h16)U[2], (h16)U[3]};
                if (OUT) {
                    f32x4 O = mfma16p(ub, mrbf, vtf, mrkf, z4);
                    O = __builtin_amdgcn_mfma_f32_16x16x32_f16(sf[0], rtf[0], O, 0, 0, 0); O = __builtin_amdgcn_mfma_f32_16x16x32_f16(sf[1], rtf[1], O, 0, 0, 0);
                    h16* obase; int ld;
                    if (!PA) { obase = odir + 512 + head * 64 + 16 * w + 4 * h; ld = DM; }
                    else if (w < 2) { obase = odir + 512 + head * 64 + 32 * w + 16 * vt + 4 * h; ld = DM; }
                    else { obase = rho + d * 512 + head * 64 + 32 * (w - 2) + 16 * vt + 4 * h; ld = 1024; }
                    *(u32x2*)(obase + (size_t)scan_row(d, b, jbase + 16 * c + i) * ld) = (u32x2){pk_h16(O[0], O[1]), pk_h16(O[2], O[3])};
                }
#pragma unroll
                for (int kt = 0; kt < 4; ++kt) {
                    Sacc[kt][vt] = mfma16p(bpq[kt], ub, kpq[kt], vtf, dvq[kt] * Sacc[kt][vt]);
                }
            }
        }
        if (producer) {
            const int pt = w * 64 + ln_, t = pt >> 4, cg = pt & 15;
            if (PA && !RWPF && cn < NCH) {
                const int u = scan_row(d, b, jbase + 16 * cn + t), s0_ = u % TT;
                const bool hp = (s0_ != 0 && s0_ != CTXL), hn = (s0_ != CTXL - 1 && s0_ != TT - 1);
                const h16* pcur = P + (size_t)u * P0LD + 2560; const h16* pp = hp ? pcur - P0LD : pcur; const h16* pn = hn ? pcur + P0LD : pcur;
#pragma unroll
                for (int qn = 0; qn < 5; ++qn) {
                    const int col = (qn < 3 ? 512 * qn + head * 64 : (qn == 3 ? 1536 : 1664) + d * 64) + 4 * cg;
                    PR_SET(qn, 0, *(const h16x4*)(pcur + col)); PR_SET(qn, 1, *(const h16x4*)(pp + col)); PR_SET(qn, 2, *(const h16x4*)(pn + col));
                }
            }
            if (cn < NCH) {
                const int s_ = scan_row(d, b, jbase + 16 * cn + t) % TT;
                const float fp_ = (s_ != 0 && s_ != CTXL) ? 1.f : 0.f, fn_ = (s_ != CTXL - 1 && s_ != TT - 1) ? 1.f : 0.f;
                const float* mu = FIN(I_RWMU);
                f32x4 sh[5];
#pragma unroll
                for (int qn = 0; qn < 5; ++qn) {
                    const int col = (qn < 3 ? 512 * qn + head * 64 : (qn == 3 ? 1536 : 1664) + d * 64) + 4 * cg;
                    const f32x4 m0 = *(const f32x4*)(mu + col), m1 = *(const f32x4*)(mu + 1920 + col);
                    const h16x4 r0_ = PR_GET(qn, 0), r1_ = PR_GET(qn, 1), r2_ = PR_GET(qn, 2);
#pragma unroll
                    for (int e = 0; e < 4; ++e) { const float x_ = (float)r0_[e]; sh[qn][e] = x_ + m0[e] * (fp_ * (float)r1_[e] - x_) + m1[e] * (fn_ * (float)r2_[e] - x_); }
                }
                *(LAS f32x4*)(SCR + RS_RR + (t * 64 + 4 * cg) * 4) = sh[0];
                *(LAS f32x4*)(SCR + RS_RK + (t * 64 + 4 * cg) * 4) = sh[1];
                { const f32x4 kkv = *(LAS const f32x4*)(L + RQ_KKL + 16 * cg); const f32x4 x = sh[1] * kkv;
                  const float nrm = __builtin_amdgcn_sqrtf(row_sum16((x[0] * x[0] + x[1] * x[1]) + (x[2] * x[2] + x[3] * x[3])));
                  if (cg == 0) *(LAS float*)(SCR + RS_NRM + t * 4) = rcpf_(fmaxf(nrm, 1e-12f)); }
#pragma unroll
                for (int e = 0; e < 4; ++e) *(LAS unsigned short*)(PB + RQ_VT + (4 * cg + e) * 32 + t * 2) = f2h(sh[2][e]);
                float tw[4];
#pragma unroll
                for (int e = 0; e < 4; ++e) { const float ex = __expf(2.f * sh[3][e]); tw[e] = 1.f - 2.f * rcpf_(ex + 1.f); }
                *(LAS u32x2*)(SCR + RS_TW + t * RQ_ROW + 8 * cg) = (u32x2){pk_h16(tw[0], tw[1]), pk_h16(tw[2], tw[3])};
                *(LAS u32x2*)(SCR + RS_TA + t * RQ_ROW + 8 * cg) = (u32x2){pk_h16(sh[4][0], sh[4][1]), pk_h16(sh[4][2], sh[4][3])};
            }
            if ((!PA || RWPF) && cn + 1 < NCH) {
                const int u = scan_row(d, b, jbase + 16 * (cn + 1) + t), s_ = u % TT;
                const bool hp = (s_ != 0 && s_ != CTXL), hn = (s_ != CTXL - 1 && s_ != TT - 1);
                const h16* pcur = P + (size_t)u * P0LD + 2560; const h16* pp = hp ? pcur - P0LD : pcur; const h16* pn = hn ? pcur + P0LD : pcur;
#pragma unroll
                for (int qn = 0; qn < 5; ++qn) {
                    const int col = (qn < 3 ? 512 * qn + head * 64 : (qn == 3 ? 1536 : 1664) + d * 64) + 4 * cg;
                    PR_SET(qn, 0, *(const h16x4*)(pcur + col)); PR_SET(qn, 1, *(const h16x4*)(pp + col)); PR_SET(qn, 2, *(const h16x4*)(pn + col));
                }
            }
        }
        LDS_BARRIER();
        if (producer && cn < NCH) {
            f32x4 lw = (f32x4){0.f, 0.f, 0.f, 0.f}, la = (f32x4){0.f, 0.f, 0.f, 0.f};
#pragma unroll
            for (int ks = 0; ks < 2; ++ks) {
                const h16x8 twf = *(LAS const h16x8*)(SCR + RS_TW + i * RQ_ROW + (32 * ks + 8 * h) * 2), taf = *(LAS const h16x8*)(SCR + RS_TA + i * RQ_ROW + (32 * ks + 8 * h) * 2);
                const h16x8 w2k = *(LAS const h16x8*)(L + RQ_LWF + ((w * 4 + ks) * 64 + ln_) * 16), a2k = *(LAS const h16x8*)(L + RQ_LWF + ((w * 4 + 2 + ks) * 64 + ln_) * 16);
                lw = __builtin_amdgcn_mfma_f32_16x16x32_f16(twf, w2k, lw, 0, 0, 0); la = __builtin_amdgcn_mfma_f32_16x16x32_f16(taf, a2k, la, 0, 0, 0);
            }
            float lg[4], aa[4], bb[4], kd[4], rr[4];
#pragma unroll
            for (int r = 0; r < 4; ++r) {
                const int t = 4 * h + r;
                const float rn = *(LAS const float*)(SCR + RS_NRM + t * 4);
                const float kraw = *(LAS const float*)(SCR + RS_RK + (t * 64 + cown) * 4); rr[r] = *(LAS const float*)(SCR + RS_RR + (t * 64 + cown) * 4);
                const float kk = kraw * kkq[w] * rn;
                lg[r] = -0.6065306597126334f * sigm_fast(w0c + lw[r]);
                const float asig = sigm_fast(a0c + la[r]); kd[r] = kraw * (1.f + (asig - 1.f) * kac); bb[r] = kk * asig; aa[r] = -kk;
            }
            float cw[4]; cw[0] = lg[0]; cw[1] = cw[0] + lg[1]; cw[2] = cw[1] + lg[2]; cw[3] = cw[2] + lg[3];
            const float g0 = __shfl(cw[3], i), g1 = __shfl(cw[3], i + 16), g2 = __shfl(cw[3], i + 32), g3 = __shfl(cw[3], i + 48);
            const float eh = (h > 0 ? g0 : 0.f) + (h > 1 ? g1 : 0.f) + (h > 2 ? g2 : 0.f);
#pragma unroll
            for (int r = 0; r < 4; ++r) cw[r] += eh;
            const float Wm = g0 + g1, W15 = g0 + g1 + g2 + g3;
            const float enm = __expf(-Wm), e15m = __expf(W15 - Wm);
            float bpv[4], kpv[4];
#pragma unroll
            for (int r = 0; r < 4; ++r) {
                const int t = 4 * h + r;
                const float ew = __expf(lg[r]), ec1 = __expf(cw[r] - lg[r]);
                const float ec = ec1 * ew, ech = ec * enm, rch = rcpf_(ech);
                const int o = t * RQ_ROW + cown * 2;
                *(LAS unsigned short*)(PB + RQ_AT + o) = f2h(aa[r] * ec1);
                *(LAS unsigned short*)(PB + RQ_AH + o) = f2h(aa[r] * ec1 * enm);
                *(LAS unsigned short*)(PB + RQ_BH + o) = f2h(bb[r] * rch);
                *(LAS unsigned short*)(PB + RQ_KH + o) = f2h(kd[r] * rch);
                if (OUT) { *(LAS unsigned short*)(PB + RQ_RT + o) = f2h(rr[r] * ec); *(LAS unsigned short*)(PB + RQ_RH + o) = f2h(rr[r] * ech); }
                const float e15 = e15m * rch; bpv[r] = bb[r] * e15; kpv[r] = kd[r] * e15;
            }
            *(LAS u32x2*)(PB + RQ_BP + cown * 32 + h * 8) = (u32x2){pk_h16(bpv[0], bpv[1]), pk_h16(bpv[2], bpv[3])};
            *(LAS u32x2*)(PB + RQ_KP + cown * 32 + h * 8) = (u32x2){pk_h16(kpv[0], kpv[1]), pk_h16(kpv[2], kpv[3])};
            if (h == 0) *(LAS float*)(PB + RQ_DV + cown * 4) = __expf(W15);
            if (OUT) {
#pragma unroll
                for (int r = 0; r < 4; ++r) { const float bs = row_sum16(rr[r] * kd[r] * rkc);
                    if (i == 0) BSP[(((size_t)d * MU + scan_row(d, b, jbase + 16 * cn + 4 * h + r)) * 8 + head) * 4 + w] = bs; }
            }
        }
        LDS_BARRIER();
        if (producer && cn < NCH) {
            h16x8 fa[2], fb[2];
            const int ta = (w == 0 || w == 2) ? RQ_AH : (w == 1 ? RQ_KH : RQ_KH), tb = (w == 0) ? RQ_BH : (w == 1 ? RQ_AH : RQ_RH);
            const int ra = (w == 2) ? RQ_BH : ta;
#pragma unroll
            for (int ks = 0; ks < 2; ++ks) { const int o = i * RQ_ROW + (32 * ks + 8 * h) * 2; fa[ks] = *(LAS const h16x8*)(PB + ra + o); fb[ks] = *(LAS const h16x8*)(PB + tb + o); }
            const f32x4 z4 = (f32x4){0.f, 0.f, 0.f, 0.f};
            if (w != 0) {
                if (w == 1 || OUT) {
                    f32x4 p = __builtin_amdgcn_mfma_f32_16x16x32_f16(fa[0], fb[0], z4, 0, 0, 0); p = __builtin_amdgcn_mfma_f32_16x16x32_f16(fa[1], fb[1], p, 0, 0, 0);
                    float q[4];
#pragma unroll
                    for (int r = 0; r < 4; ++r) q[r] = (w == 1 ? (4 * h + r < i) : (4 * h + r <= i)) ? p[r] : 0.f;
                    *(LAS u32x2*)(PB + (w == 1 ? RQ_MK : (w == 2 ? RQ_MB : RQ_MR)) + i * 32 + h * 8) = (u32x2){pk_h16(q[0], q[1]), pk_h16(q[2], q[3])};
                }
            } else {
                f32x4 m = __builtin_amdgcn_mfma_f32_16x16x32_f16(fa[0], fb[0], z4, 0, 0, 0); m = __builtin_amdgcn_mfma_f32_16x16x32_f16(fa[1], fb[1], m, 0, 0, 0);
                f32x4 mt = __builtin_amdgcn_mfma_f32_16x16x32_f16(fb[0], fa[0], z4, 0, 0, 0); mt = __builtin_amdgcn_mfma_f32_16x16x32_f16(fb[1], fa[1], mt, 0, 0, 0);
#pragma unroll
                for (int r = 0; r < 4; ++r) { m[r] = (i < 4 * h + r) ? m[r] : 0.f; mt[r] = (4 * h + r < i) ? mt[r] : 0.f; }
#define CV4(x) ((h16x4){(h16)(x)[0], (h16)(x)[1], (h16)(x)[2], (h16)(x)[3]})
                const h16x4 m1 = CV4(m), m1t = CV4(mt);
                const f32x4 p2 = mfma16s(m1t, m1, z4), p2t = mfma16s(m1, m1t, z4);
                f32x4 tt = mt;
#pragma unroll
                for (int r = 0; r < 4; ++r) tt[r] += (4 * h + r == i) ? 1.f : 0.f;
                const h16x4 h2 = CV4(p2), h2t = CV4(p2t);
                tt = mfma16s(h2, CV4(tt), tt);
                const f32x4 p4 = mfma16s(h2t, h2, z4), p4t = mfma16s(h2, h2t, z4);
                const h16x4 h4 = CV4(p4), h4t = CV4(p4t);
                tt = mfma16s(h4, CV4(tt), tt);
                const f32x4 p8 = mfma16s(h4t, h4, z4);
                tt = mfma16s(CV4(p8), CV4(tt), tt);
#undef CV4
                *(LAS u32x2*)(PB + RQ_TM + i * 32 + h * 8) = (u32x2){pk_h16(tt[0], tt[1]), pk_h16(tt[2], tt[3])};
            }
        }
        LDS_BARRIER();
    }
    if (PA && !producer && (!LOC || sc < NSC - 1)) {
        float* st = STR + (((size_t)sc * 64 + stream) * 2) * 4096;
        int lo_ = lane; asm volatile("" : "+v"(lo_));
        const int io = lo_ & 15, ho = lo_ >> 4;
#pragma unroll
        for (int kt = 0; kt < 4; ++kt)
#pragma unroll
            for (int vt = 0; vt < NVT; ++vt) { const int vp = 32 * w + 16 * vt + io;
                f32x4* dst = (f32x4*)(st + (vp >> 6) * 4096 + (vp & 63) * 64 + 16 * kt + 4 * ho);
                if (cmp && (cmpmode == 1 || vp >= 64)) { const f32x4 old = *dst; const f32x4 nw = Sacc[kt][vt];
                    if (__float_as_uint(old[0]) != __float_as_uint(nw[0]) || __float_as_uint(old[1]) != __float_as_uint(nw[1]) || __float_as_uint(old[2]) != __float_as_uint(nw[2]) || __float_as_uint(old[3]) != __float_as_uint(nw[3]))
                        atomicOr((unsigned*)(F.ws + WS_CTL), 1u); }
                else if (!cmp) *dst = Sacc[kt][vt]; }
    }
}
__device__ __forceinline__ void ph_rwlatecheck(Frame& F, const h16* P, float* STR) {
    for (int unit = blockIdx.x; unit < (NSC - 1) * 64; unit += F.G) rw_chunk_unit<true>(F, unit / 64, unit % 64, P, STR, nullptr, nullptr, true, 2);
    __syncthreads();
}
template <bool PA, bool LOC = false>
__device__ __forceinline__ void ph_rwchunks(Frame& F, const h16* P, float* STR, float* BSP, h16* ofwd, h16* obwd, h16* rho = nullptr) {
    const int nunits = ((PA && !LOC) ? NSC - 1 : NSC) * 64;
    for (int unit = blockIdx.x; unit < nunits; unit += F.G) { const int sc = unit / 64, stream = unit % 64;
        rw_chunk_unit<PA, LOC>(F, sc, stream, P, STR, BSP, (stream >> 5) == 0 ? ofwd : obwd, false, 1, rho);
#if DETCHK == 1
        if (PA) { __threadfence(); __syncthreads(); rw_chunk_unit<PA>(F, sc, stream, P, STR, BSP, (stream >> 5) == 0 ? ofwd : obwd, true); }
#endif
    }
    __syncthreads();
}

__device__ __forceinline__ void ph_rwcorr(Frame& F, const float* STR, const h16* rho, h16* ofwd, h16* obwd) {
    const int lane = F.lane, i = lane & 15, h = lane >> 4;
    constexpr int NCH = SCL / 16;
    for (int unit = F.gw; unit < (NSC - 1) * 64 * 2; unit += F.ngw) {
        const int half = unit & 1, stream = (unit >> 1) & 63, sc = 1 + (unit >> 7);
        const int d = stream >> 5, b = (stream >> 3) & 3, head = stream & 7;
        h16* odir = d == 0 ? ofwd : obwd;
        const float* st = STR + (((size_t)(sc - 1) * 64 + stream) * 2) * 4096 + (size_t)(32 * half) * 64;
        h16x8 sa[2][2];
#pragma unroll
        for (int ks = 0; ks < 2; ++ks)
#pragma unroll
            for (int vt = 0; vt < 2; ++vt) { const f32x4 x0 = *(const f32x4*)(st + (16 * vt + i) * 64 + 32 * ks + 8 * h), x1 = *(const f32x4*)(st + (16 * vt + i) * 64 + 32 * ks + 8 * h + 4);
                sa[ks][vt] = (h16x8){(h16)x0[0], (h16)x0[1], (h16)x0[2], (h16)x0[3], (h16)x1[0], (h16)x1[1], (h16)x1[2], (h16)x1[3]}; }
        const int rcol = d * 512 + head * 64 + 8 * h, ocol = 512 + head * 64 + 32 * half + 4 * h, jbase = sc * SCL;
        h16x8 qf[2]; u32x2 ov[2];
        { const size_t u = scan_row(d, b, jbase + i);
#pragma unroll
          for (int ks = 0; ks < 2; ++ks) qf[ks] = *(const h16x8*)(rho + u * 1024 + rcol + 32 * ks);
#pragma unroll
          for (int vt = 0; vt < 2; ++vt) ov[vt] = *(const u32x2*)(odir + u * DM + ocol + 16 * vt); }
#pragma unroll 1
        for (int c = 0; c < NCH; ++c) {
            const size_t u = scan_row(d, b, jbase + 16 * c + i), un = scan_row(d, b, jbase + 16 * (c + 1 < NCH ? c + 1 : c) + i);
            f32x4 o[2] = {(f32x4){0.f, 0.f, 0.f, 0.f}, (f32x4){0.f, 0.f, 0.f, 0.f}};
#pragma unroll
            for (int ks = 0; ks < 2; ++ks) {
                o[0] = __builtin_amdgcn_mfma_f32_16x16x32_f16(sa[ks][0], qf[ks], o[0], 0, 0, 0); o[1] = __builtin_amdgcn_mfma_f32_16x16x32_f16(sa[ks][1], qf[ks], o[1], 0, 0, 0);
                qf[ks] = *(const h16x8*)(rho + un * 1024 + rcol + 32 * ks);
            }
#pragma unroll
            for (int vt = 0; vt < 2; ++vt) { const h16x4 old = __builtin_bit_cast(h16x4, ov[vt]);
                *(u32x2*)(odir + u * DM + ocol + 16 * vt) = (u32x2){pk_h16((float)old[0] + o[vt][0], (float)old[1] + o[vt][1]), pk_h16((float)old[2] + o[vt][2], (float)old[3] + o[vt][3])};
                ov[vt] = *(const u32x2*)(odir + un * DM + ocol + 16 * vt); }
        }
    }
}

template <bool PA>
__device__ __forceinline__ void rw_unit(Frame& F, int sc, int d, int b, int head, const h16* P, float* STR, float* BSC, h16* odir) {
    LAS float* L = (LAS float*)(F.lds + F.wave * 16384);
    LAS float* LW = L, *LA = L + 512, *LB = L + 1024, *LK = L + 1536, *LR = L + 2048, *LTW = L + 2560, *LTA = L + 3072, *LV = L + 3584;
    const int lane = F.lane, stream = (d * NB + b) * 8 + head, hc = head * 64 + lane;
    float S[64], Pm[PA ? 64 : 1];
    int ln_ = lane; asm volatile("" : "+v"(ln_));
    if (PA) {
#pragma unroll
        for (int k = 0; k < 64; ++k) { S[k] = 0.f; Pm[k] = (k == ln_) ? 1.f : 0.f; }
    } else if (sc > 0) {
        const float* st = STR + (((size_t)(sc - 1) * 64 + stream) * 2) * 4096 + lane * 64;
#pragma unroll
        for (int k4 = 0; k4 < 16; ++k4) { const f32x4 x = *(const f32x4*)(st + 4 * k4); S[4 * k4] = x.x; S[4 * k4 + 1] = x.y; S[4 * k4 + 2] = x.z; S[4 * k4 + 3] = x.w; }
    } else {
#pragma unroll
        for (int k = 0; k < 64; ++k) S[k] = 0.f;
    }
    const float* mu = FIN(I_RWMU);
    const int cR = hc, cK = 512 + hc, cV = 1024 + hc, cW = 1536 + d * 64 + lane, cA = 1664 + d * 64 + lane;
    const float m0R = mu[cR], m1R = mu[1920 + cR], m0K = mu[cK], m1K = mu[1920 + cK], m0V = mu[cV], m1V = mu[1920 + cV], m0W = mu[cW], m1W = mu[1920 + cW], m0A = mu[cA], m1A = mu[1920 + cA];
    const float kkc = FIN(I_RWKK)[hc], kac = FIN(I_RWKA)[hc], rkc = FIN(I_RWRK)[hc], w0c = FIN(I_RWW0)[d * 512 + hc], a0c = FIN(I_RWA0)[d * 512 + hc];
    const float* w2 = FIN(I_RWW2) + (size_t)d * 64 * 512 + hc; const float* a2 = FIN(I_RWA2) + (size_t)d * 64 * 512 + hc;
    for (int tile = 0; tile < SCL / 8; ++tile) {
        const int j0 = sc * SCL + tile * 8;
#pragma unroll 1
        for (int t = 0; t < 8; ++t) {
            const int u = scan_row(d, b, j0 + t), s = u % TT;
            const bool hp = (s != 0 && s != CTXL), hn = (s != CTXL - 1 && s != TT - 1);
            const h16* pc = P + (size_t)u * P0LD + 2560; const h16* pp = pc - P0LD; const h16* pn = pc + P0LD;
#define RW_SH(col, m0, m1) ({ const float x_ = (float)pc[col]; const float xp_ = hp ? (float)pp[col] : 0.f; const float xn_ = hn ? (float)pn[col] : 0.f; x_ + (m0) * (xp_ - x_) + (m1) * (xn_ - x_); })
            LR[t * 64 + lane] = RW_SH(cR, m0R, m1R); LK[t * 64 + lane] = RW_SH(cK, m0K, m1K); LV[t * 64 + lane] = RW_SH(cV, m0V, m1V);
            LTW[lane * 8 + t] = tanh_(RW_SH(cW, m0W, m1W)); LTA[lane * 8 + t] = RW_SH(cA, m0A, m1A);
        }
        LDS_WAIT();
        float lw[8], la[8];
#pragma unroll
        for (int t = 0; t < 8; ++t) { lw[t] = 0.f; la[t] = 0.f; }
#pragma unroll 2
        for (int j = 0; j < 64; ++j) {
            const float wv = w2[(size_t)j * 512], av = a2[(size_t)j * 512];
            const f32x4 x0 = *(const LAS f32x4*)(LTW + j * 8), x1 = *(const LAS f32x4*)(LTW + j * 8 + 4), y0 = *(const LAS f32x4*)(LTA + j * 8), y1 = *(const LAS f32x4*)(LTA + j * 8 + 4);
            lw[0] += x0.x * wv; lw[1] += x0.y * wv; lw[2] += x0.z * wv; lw[3] += x0.w * wv; lw[4] += x1.x * wv; lw[5] += x1.y * wv; lw[6] += x1.z * wv; lw[7] += x1.w * wv;
            la[0] += y0.x * av; la[1] += y0.y * av; la[2] += y0.z * av; la[3] += y0.w * av; la[4] += y1.x * av; la[5] += y1.y * av; la[6] += y1.z * av; la[7] += y1.w * av;
        }
#pragma unroll
        for (int t = 0; t < 8; ++t) {
            const float kraw = LK[t * 64 + lane], rraw = LR[t * 64 + lane];
            const float kkr = kraw * kkc; const float nrm = sqrtf(wave_sum(kkr * kkr)); const float kk = kkr / fmaxf(nrm, 1e-12f);
            const float wlog = -softplus(-(w0c + lw[t])) - 0.5f; const float wdec = __expf(-__expf(wlog));
            const float asig = sigm(a0c + la[t]); const float kd = kraw * (1.f + (asig - 1.f) * kac);
            LW[t * 64 + lane] = wdec; LA[t * 64 + lane] = -kk; LB[t * 64 + lane] = kk * asig; LK[t * 64 + lane] = kd;
            if (!PA) { const float bs = wave_sum(rraw * kd * rkc); if (lane == 0) *(f32x4*)(BSC + (((size_t)d * MU + scan_row(d, b, j0 + t)) * 8 + head) * 4) = (f32x4){bs, 0.f, 0.f, 0.f}; }
        }
        LDS_WAIT();
#pragma unroll 1
        for (int t = 0; t < 8; ++t) {
            const float vv = LV[t * 64 + lane];
            float sa = 0.f, sp = 0.f;
#pragma unroll
            for (int k4 = 0; k4 < 16; ++k4) { const f32x4 a4 = *(const LAS f32x4*)(LA + t * 64 + 4 * k4);
#pragma unroll
                for (int e = 0; e < 4; ++e) { sa += S[4 * k4 + e] * a4[e]; if (PA) sp += Pm[4 * k4 + e] * a4[e]; } }
            float o = 0.f;
#pragma unroll
            for (int k4 = 0; k4 < 16; ++k4) {
                const f32x4 w4 = *(const LAS f32x4*)(LW + t * 64 + 4 * k4), b4 = *(const LAS f32x4*)(LB + t * 64 + 4 * k4), k4v = *(const LAS f32x4*)(LK + t * 64 + 4 * k4);
                f32x4 r4 = (f32x4){0.f, 0.f, 0.f, 0.f}; if (!PA) r4 = *(const LAS f32x4*)(LR + t * 64 + 4 * k4);
#pragma unroll
                for (int e = 0; e < 4; ++e) { float& s = S[4 * k4 + e]; s = s * w4[e] + sa * b4[e] + vv * k4v[e]; if (PA) { float& p = Pm[4 * k4 + e]; p = p * w4[e] + sp * b4[e]; } else o += s * r4[e]; }
            }
            if (!PA) odir[(size_t)scan_row(d, b, j0 + t) * DM + 512 + hc] = (h16)o;
        }
    }
    if (PA) {
        float* st = STR + (((size_t)sc * 64 + stream) * 2) * 4096 + lane * 64;
#pragma unroll
        for (int k4 = 0; k4 < 16; ++k4) { *(f32x4*)(st + 4 * k4) = (f32x4){S[4 * k4], S[4 * k4 + 1], S[4 * k4 + 2], S[4 * k4 + 3]}; *(f32x4*)(st + 4096 + 4 * k4) = (f32x4){Pm[4 * k4], Pm[4 * k4 + 1], Pm[4 * k4 + 2], Pm[4 * k4 + 3]}; }
    }
}

__device__ __forceinline__ void s5_hloc(Frame& F, int dg, int b, int rp, int half, const h16* P, float* HLOC) {
    const int lane = F.lane, i = lane & 15, h = lane >> 4, d = dg >> 5, g = dg & 31, stream = (d * NB + b) * 32 + g;
    const h16* E16 = WSP(h16, WS_S5E) + (size_t)dg * 32768;
    h16x8 af[2][8];
#pragma unroll
    for (int rt = 0; rt < 2; ++rt)
#pragma unroll
        for (int ks = 0; ks < 8; ++ks) af[rt][ks] = *(const h16x8*)(E16 + ((15 - (2 * ks + (h >> 1))) * 128 + 32 * rp + 16 * rt + i) * 16 + 8 * (h & 1));
    const int c0 = half ? 17 : 0, c1 = half ? 33 : 17;
    h16x8 bf[8];
    { const int j = 16 * c0 + i;
#pragma unroll
      for (int ks = 0; ks < 8; ++ks) bf[ks] = *(const h16x8*)(P + (size_t)scan_row(d, b, 16 * j + 2 * ks + (h >> 1)) * P1LD + 1568 + g * 16 + 8 * (h & 1)); }
#pragma unroll 1
    for (int ct = c0; ct < c1; ++ct) {
        const int j = 16 * ct + i, jn = 16 * (ct + 1 < c1 ? ct + 1 : ct) + i;
        f32x4 acc[2] = {(f32x4){0.f, 0.f, 0.f, 0.f}, (f32x4){0.f, 0.f, 0.f, 0.f}};
#pragma unroll
        for (int ks = 0; ks < 8; ++ks) {
            acc[0] = __builtin_amdgcn_mfma_f32_16x16x32_f16(af[0][ks], bf[ks], acc[0], 0, 0, 0);
            acc[1] = __builtin_amdgcn_mfma_f32_16x16x32_f16(af[1][ks], bf[ks], acc[1], 0, 0, 0);
            bf[ks] = *(const h16x8*)(P + (size_t)scan_row(d, b, 16 * jn + 2 * ks + (h >> 1)) * P1LD + 1568 + g * 16 + 8 * (h & 1));
        }
        float* o = HLOC + ((size_t)stream * 528 + j) * 128 + 32 * rp + 4 * h;
        *(f32x4*)o = acc[0] * (1.f / 256.f); *(f32x4*)(o + 16) = acc[1] * (1.f / 256.f);
    }
}
__device__ __forceinline__ void s5_out(Frame& F, int dg, int b, int rq, const h16* P, const h16* HIN, h16* odir) {
    const int lane = F.lane, i = lane & 15, h = lane >> 4, d = dg >> 5, g = dg & 31, stream = (d * NB + b) * 32 + g;
    const h16* G16 = WSP(h16, WS_S5G) + (size_t)dg * 4096; const h16* Q16 = WSP(h16, WS_S5Q) + (size_t)dg * 32768;
    h16x8 ga[2][8], qa[2][4];
#pragma unroll
    for (int rt = 0; rt < 2; ++rt) { const int t = 2 * rq + rt;
#pragma unroll
        for (int ks = 0; ks < 8; ++ks) { const int tau = t - (2 * ks + (h >> 1));
            h16x8 z;
#pragma unroll
            for (int e = 0; e < 8; ++e) z[e] = (h16)0.f;
            if (tau >= 0) z = *(const h16x8*)(G16 + (tau * 16 + i) * 16 + 8 * (h & 1));
            ga[rt][ks] = z; }
#pragma unroll
        for (int ks = 0; ks < 4; ++ks) qa[rt][ks] = *(const h16x8*)(Q16 + (t * 16 + i) * 128 + 32 * ks + 8 * h); }
    h16x8 bf[12];
    { const int j = i;
#pragma unroll
      for (int ks = 0; ks < 8; ++ks) if (ks <= rq) bf[ks] = *(const h16x8*)(P + (size_t)scan_row(d, b, 16 * j + 2 * ks + (h >> 1)) * P1LD + 1568 + g * 16 + 8 * (h & 1));
      const h16* hin = HIN + ((size_t)stream * 528 + j) * 128;
#pragma unroll
      for (int ks = 0; ks < 4; ++ks) bf[8 + ks] = *(const h16x8*)(hin + 32 * ks + 8 * h); }
#pragma unroll 1
    for (int ct = 0; ct < 33; ++ct) {
        const int j = 16 * ct + i, jn = 16 * (ct + 1 < 33 ? ct + 1 : ct) + i;
        f32x4 acc[2] = {(f32x4){0.f, 0.f, 0.f, 0.f}, (f32x4){0.f, 0.f, 0.f, 0.f}};
#pragma unroll
        for (int ks = 0; ks < 8; ++ks) {
            if (ks <= rq) {
                acc[0] = __builtin_amdgcn_mfma_f32_16x16x32_f16(ga[0][ks], bf[ks], acc[0], 0, 0, 0);
                acc[1] = __builtin_amdgcn_mfma_f32_16x16x32_f16(ga[1][ks], bf[ks], acc[1], 0, 0, 0);
                bf[ks] = *(const h16x8*)(P + (size_t)scan_row(d, b, 16 * jn + 2 * ks + (h >> 1)) * P1LD + 1568 + g * 16 + 8 * (h & 1));
            }
        }
        const h16* hinn = HIN + ((size_t)stream * 528 + jn) * 128;
#pragma unroll
        for (int ks = 0; ks < 4; ++ks) {
            acc[0] = __builtin_amdgcn_mfma_f32_16x16x32_f16(qa[0][ks], bf[8 + ks], acc[0], 0, 0, 0);
            acc[1] = __builtin_amdgcn_mfma_f32_16x16x32_f16(qa[1][ks], bf[8 + ks], acc[1], 0, 0, 0);
            bf[8 + ks] = *(const h16x8*)(hinn + 32 * ks + 8 * h);
        }
#pragma unroll
        for (int rt = 0; rt < 2; ++rt) { const f32x4 y = acc[rt] * (1.f / 64.f);
            u32x2 w; w.x = pk_h16(y[0], y[1]); w.y = pk_h16(y[2], y[3]);
            *(u32x2*)(odir + (size_t)scan_row(d, b, 16 * j + 2 * rq + rt) * DM + 512 + g * 16 + 4 * h) = w; }
    }
}

__device__ __forceinline__ void s5_hloc_wg(Frame& F, int dg, int b, const h16* P, float* HLOC) {
    const int lane = F.lane, i = lane & 15, h = lane >> 4, d = dg >> 5, g = dg & 31, stream = (d * NB + b) * 32 + g, tid = F.tid, w = F.wave;
    const h16* E16 = WSP(h16, WS_S5E) + (size_t)dg * 32768;
    constexpr int UCH = 528, BUF = 16 * UCH;
    LAS unsigned char* LB = F.lds;
    h16x8 af[8];
#pragma unroll
    for (int ks = 0; ks < 8; ++ks) af[ks] = *(const h16x8*)(E16 + ((15 - (2 * ks + (h >> 1))) * 128 + 16 * w + i) * 16 + 8 * (h & 1));
    const int uc = tid >> 5, ut = (tid >> 1) & 15, uh = tid & 1;
    auto ldu = [&](int ct) { return *(const u32x4*)(P + (size_t)scan_row(d, b, 16 * (16 * ct + uc) + ut) * P1LD + 1568 + g * 16 + 8 * uh); };
    u32x4 pu0 = ldu(0), pu1, pu2;
    __syncthreads();
    *(LAS u32x4*)(LB + uc * UCH + ut * 32 + uh * 16) = pu0;
    pu0 = ldu(1); pu1 = ldu(2); pu2 = ldu(3);
    LDS_BARRIER();
    auto step = [&](const int ct, u32x4& pu) {
        LAS const unsigned char* T = LB + (ct & 1) * BUF;
        const int j = 16 * ct + i;
        f32x4 acc = (f32x4){0.f, 0.f, 0.f, 0.f};
#pragma unroll
        for (int ks = 0; ks < 8; ++ks) { const h16x8 bf = *(LAS const h16x8*)(T + i * UCH + (2 * ks + (h >> 1)) * 32 + (h & 1) * 16); acc = __builtin_amdgcn_mfma_f32_16x16x32_f16(af[ks], bf, acc, 0, 0, 0); }
        *(f32x4*)(HLOC + ((size_t)stream * 528 + j) * 128 + 16 * w + 4 * h) = acc * (1.f / 256.f);
        if (ct + 1 < 33) { *(LAS u32x4*)(LB + ((ct + 1) & 1) * BUF + uc * UCH + ut * 32 + uh * 16) = pu; if (ct + 4 < 33) pu = ldu(ct + 4); }
        LDS_BARRIER();
    };
#pragma unroll 1
    for (int ct = 0; ct < 33; ct += 3) { step(ct, pu0); step(ct + 1, pu1); step(ct + 2, pu2); }
}

__device__ __forceinline__ void s5_out_wg(Frame& F, int dg, int b, const h16* P, const h16* HIN, h16* odir) {
    const int lane = F.lane, i = lane & 15, h = lane >> 4, d = dg >> 5, g = dg & 31, stream = (d * NB + b) * 32 + g, rq = F.wave, tid = F.tid;
    const h16* G16 = WSP(h16, WS_S5G) + (size_t)dg * 4096; const h16* Q16 = WSP(h16, WS_S5Q) + (size_t)dg * 32768;
    constexpr int UCH = 528, HCH = 272, UBUF = 16 * UCH, HBUF = 16 * HCH, BUF = UBUF + HBUF;
    LAS unsigned char* LB = F.lds;
    h16x8 ga[2][8], qa[2][4];
    const int t0 = rq, t1 = 15 - rq;
#pragma unroll
    for (int rt = 0; rt < 2; ++rt) { const int t = rt == 0 ? t0 : t1;
#pragma unroll
        for (int ks = 0; ks < 8; ++ks) { const int tau = t - (2 * ks + (h >> 1));
            h16x8 z;
#pragma unroll
            for (int e = 0; e < 8; ++e) z[e] = (h16)0.f;
            if (tau >= 0) z = *(const h16x8*)(G16 + (tau * 16 + i) * 16 + 8 * (h & 1));
            ga[rt][ks] = z; }
#pragma unroll
        for (int ks = 0; ks < 4; ++ks) qa[rt][ks] = *(const h16x8*)(Q16 + (t * 16 + i) * 128 + 32 * ks + 8 * h); }
    const int uc = tid >> 5, ut = (tid >> 1) & 15, uh = tid & 1, hoff = (tid & 31) * 8;
    auto ldu = [&](int ct) { return *(const u32x4*)(P + (size_t)scan_row(d, b, 16 * (16 * ct + uc) + ut) * P1LD + 1568 + g * 16 + 8 * uh); };
    auto ldh = [&](int ct) { return *(const u32x2*)((const unsigned char*)(HIN + ((size_t)stream * 528 + 16 * ct + uc) * 128) + hoff); };
    u32x4 pu0 = ldu(0), pu1, pu2; u32x2 ph0 = ldh(0), ph1, ph2;
    __syncthreads();
    *(LAS u32x4*)(LB + uc * UCH + ut * 32 + uh * 16) = pu0; *(LAS u32x2*)(LB + UBUF + uc * HCH + hoff) = ph0;
    pu0 = ldu(1); ph0 = ldh(1); pu1 = ldu(2); ph1 = ldh(2); pu2 = ldu(3); ph2 = ldh(3);
    LDS_BARRIER();
    auto step = [&](const int ct, u32x4& pu, u32x2& ph) {
        LAS const unsigned char* T = LB + (ct & 1) * BUF;
        const int j = 16 * ct + i;
        f32x4 acc[2] = {(f32x4){0.f, 0.f, 0.f, 0.f}, (f32x4){0.f, 0.f, 0.f, 0.f}};
#pragma unroll
        for (int ks = 0; ks < 8; ++ks) {
            if (2 * ks <= t1) {
                const h16x8 bf = *(LAS const h16x8*)(T + i * UCH + (2 * ks + (h >> 1)) * 32 + (h & 1) * 16);
                if (2 * ks <= t0) acc[0] = __builtin_amdgcn_mfma_f32_16x16x32_f16(ga[0][ks], bf, acc[0], 0, 0, 0);
                acc[1] = __builtin_amdgcn_mfma_f32_16x16x32_f16(ga[1][ks], bf, acc[1], 0, 0, 0);
            }
        }
#pragma unroll
        for (int ks = 0; ks < 4; ++ks) {
            const h16x8 bf = *(LAS const h16x8*)(T + UBUF + i * HCH + (32 * ks + 8 * h) * 2);
            acc[0] = __builtin_amdgcn_mfma_f32_16x16x32_f16(qa[0][ks], bf, acc[0], 0, 0, 0);
            acc[1] = __builtin_amdgcn_mfma_f32_16x16x32_f16(qa[1][ks], bf, acc[1], 0, 0, 0);
        }
#pragma unroll
        for (int rt = 0; rt < 2; ++rt) { const f32x4 y = acc[rt] * (1.f / 64.f);
            u32x2 w; w.x = pk_h16(y[0], y[1]); w.y = pk_h16(y[2], y[3]);
            *(u32x2*)(odir + (size_t)scan_row(d, b, 16 * j + (rt == 0 ? t0 : t1)) * DM + 512 + g * 16 + 4 * h) = w; }
        if (ct + 1 < 33) {
            LAS unsigned char* N = LB + ((ct + 1) & 1) * BUF;
            *(LAS u32x4*)(N + uc * UCH + ut * 32 + uh * 16) = pu; *(LAS u32x2*)(N + UBUF + uc * HCH + hoff) = ph;
            if (ct + 4 < 33) { pu = ldu(ct + 4); ph = ldh(ct + 4); }
        }
        LDS_BARRIER();
    };
#pragma unroll 1
    for (int ct = 0; ct < 33; ct += 3) { step(ct, pu0, ph0); step(ct + 1, pu1, ph1); step(ct + 2, pu2, ph2); }
}

__device__ __forceinline__ void ph_scanA(Frame& F, int layer) {
    if (layer == 0) {
        const h16* P = WSP(h16, WS_BIG); unsigned char* dob = (unsigned char*)F.out;
        if (GLLC) ph_glquads<128, true>(F, true, P, P0LD, (float*)(dob + DO_STH), (float*)(dob + DO_DH), WSP(h16, WS_H16), (h16*)(dob + DO_OBWD), true, (h16*)(F.ws + WS_BIG + B0_QE), 1024);
        else ph_glquads<128, true>(F, false, P, P0LD, (float*)(dob + DO_STH), (float*)(dob + DO_DH), nullptr, nullptr);
        if (RWLC) ph_rwchunks<true, true>(F, P, (float*)(dob + DO_STR), WSP(float, WS_BSP), WSP(h16, WS_H16), (h16*)(dob + DO_OBWD), (h16*)(F.ws + WS_BIG + B0_QE));
        else if (RWMODE & 1) ph_rwchunks<true>(F, P, (float*)(dob + DO_STR), nullptr, nullptr, nullptr);
        if (RWMODE & 8) cg::this_grid().sync();
        if (!(RWMODE & 1) || (RWMODE & 8)) { constexpr int NRW = (NSC - 1) * 64; for (int it = F.gw; it < NRW; it += F.ngw) { const int sc = it / 64, st = it % 64; rw_unit<true>(F, sc, st >> 5, (st >> 3) & 3, st & 7, P, (float*)(dob + DO_STR), nullptr, nullptr); } }
    } else {
        const h16* P = WSP(h16, WS_BIG); unsigned char* big = F.ws + WS_BIG;
        ph_glquads<64, false>(F, false, P, P1LD, (float*)(big + B1_STG), (float*)(big + B1_DG), nullptr, nullptr);
        if (S5WG) { for (int it = blockIdx.x; it < 64 * 4; it += F.G) s5_hloc_wg(F, it >> 2, it & 3, P, (float*)(big + B1_HLOC)); __syncthreads(); }
        else for (int it = F.gw; it < 64 * 4 * 4 * 2; it += F.ngw) s5_hloc(F, it >> 5, (it >> 3) & 3, (it >> 1) & 3, it & 1, P, (float*)(big + B1_HLOC));
    }
}
__device__ __forceinline__ void ph_scanB(Frame& F, int layer) {
    const int gt = blockIdx.x * NTHR + F.tid, ngt = F.G * NTHR;
    if (layer == 0) {
        unsigned char* dob = (unsigned char*)F.out;
        float* ST = (float*)(dob + DO_STH); const float* DH = (const float*)(dob + DO_DH);
        for (int e = gt; e < 32 * 128 * 128; e += ngt) { const int stream = e >> 14, k = (e >> 7) & 127; float carry = 0.f;
            float dv[NSC - 1], sv[NSC - 1];
#pragma unroll
            for (int sc = 0; sc < NSC - 1; ++sc) { dv[sc] = DH[((size_t)sc * 32 + stream) * 128 + k]; sv[sc] = ST[(size_t)sc * 32 * 16384 + e]; }
#pragma unroll
            for (int sc = 0; sc < NSC - 1; ++sc) { carry = dv[sc] * carry + sv[sc]; ST[(size_t)sc * 32 * 16384 + e] = carry; } }
        float* STR = (float*)(dob + DO_STR);
        LAS float* LS = (LAS float*)F.lds;
        LAS float* LP = LS + 64 * 65;
        if (F.G > 64) { if (blockIdx.x >= 64) ph_weights_late(F, (blockIdx.x - 64) * NWAVES + F.wave, (F.G - 64) * NWAVES); }
        else ph_weights_late(F, F.gw, F.ngw);
        for (int stream = blockIdx.x; stream < 64; stream += F.G) {
            __syncthreads();
            for (int i = F.tid; i < 64 * 65; i += NTHR) LS[i] = 0.f;
            float pv[8], uv[8];
            { const float* Ug0 = STR + ((size_t)stream * 2) * 4096; const float* Pg0 = Ug0 + 4096;
#pragma unroll
              for (int q = 0; q < 8; ++q) { pv[q] = Pg0[F.tid + NTHR * q]; uv[q] = Ug0[F.lane * 64 + F.wave * 8 + q]; } }
            for (int sc = 0; sc < NSC - 1; ++sc) {
                float* Ug = STR + (((size_t)sc * 64 + stream) * 2) * 4096;
                __syncthreads();
                float acc[8];
#pragma unroll
                for (int q = 0; q < 8; ++q) { LP[F.tid + NTHR * q] = pv[q]; acc[q] = uv[q]; }
                if (sc + 1 < NSC - 1) { const float* Un = Ug + (size_t)64 * 2 * 4096; const float* Pn = Un + 4096;
#pragma unroll
                    for (int q = 0; q < 8; ++q) { pv[q] = Pn[F.tid + NTHR * q]; uv[q] = Un[F.lane * 64 + F.wave * 8 + q]; } }
                LDS_BARRIER();
                for (int k = 0; k < 64; ++k) { const float s = LS[F.lane * 65 + k]; const f32x4 p0 = *(const LAS f32x4*)(LP + k * 64 + F.wave * 8), p1 = *(const LAS f32x4*)(LP + k * 64 + F.wave * 8 + 4);
                    acc[0] += s * p0.x; acc[1] += s * p0.y; acc[2] += s * p0.z; acc[3] += s * p0.w; acc[4] += s * p1.x; acc[5] += s * p1.y; acc[6] += s * p1.z; acc[7] += s * p1.w; }
                LDS_BARRIER();
#pragma unroll
                for (int e = 0; e < 8; ++e) { LS[F.lane * 65 + F.wave * 8 + e] = acc[e]; Ug[F.lane * 64 + F.wave * 8 + e] = acc[e]; }
            }
        }
        __syncthreads();
    } else {
        unsigned char* big = F.ws + WS_BIG;
        float* ST = (float*)(big + B1_STG); const float* DG = (const float*)(big + B1_DG);
        for (int e = gt; e < 32 * 64 * 128; e += ngt) { const int stream = e >> 13, k = (e >> 7) & 63; float carry = 0.f;
            float dv[NSC - 1], sv[NSC - 1];
#pragma unroll
            for (int sc = 0; sc < NSC - 1; ++sc) { dv[sc] = DG[((size_t)sc * 32 + stream) * 64 + k]; sv[sc] = ST[(size_t)sc * 32 * 8192 + e]; }
#pragma unroll
            for (int sc = 0; sc < NSC - 1; ++sc) { carry = dv[sc] * carry + sv[sc]; ST[(size_t)sc * 32 * 8192 + e] = carry; } }
        const float* HLOC = (const float*)(big + B1_HLOC); h16* HIN = (h16*)(big + B1_ZB); const float* L16 = WSP(float, WS_S5L);
        LAS float* EL = (LAS float*)F.lds;
        for (int stream = blockIdx.x; stream < 256; stream += F.G) {
            const int d = stream >> 7, g = stream & 31, dg = d * 32 + g, w = F.wave;
            const float lr = L16[(dg * 64 + F.lane) * 2], li = L16[(dg * 64 + F.lane) * 2 + 1];
            const float* rec = HLOC + ((size_t)stream * 528 + 66 * w) * 128; h16* o = HIN + ((size_t)stream * 528 + 66 * w) * 128;
            float cr = 0.f, ci = 0.f;
#pragma unroll 6
            for (int j = 0; j < 66; ++j) {
                const float hr = rec[j * 128 + F.lane], hi = rec[j * 128 + 64 + F.lane];
                const float nr = lr * cr - li * ci + hr, ni = lr * ci + li * cr + hi; cr = nr; ci = ni;
            }
            __syncthreads();
            EL[w * 128 + F.lane] = cr; EL[w * 128 + 64 + F.lane] = ci;
            float p2r = lr * lr - li * li, p2i = 2.f * lr * li, pr = p2r, pi = p2i;
#pragma unroll
            for (int q = 0; q < 5; ++q) { const float tr = pr * pr - pi * pi, ti = 2.f * pr * pi; pr = tr; pi = ti; }
            { const float tr = pr * p2r - pi * p2i, ti = pr * p2i + pi * p2r; pr = tr; pi = ti; }
            __syncthreads();
            cr = 0.f; ci = 0.f;
            for (int v = 0; v < w; ++v) { const float er = EL[v * 128 + F.lane], ei = EL[v * 128 + 64 + F.lane];
                const float nr = pr * cr - pi * ci + er, ni = pr * ci + pi * cr + ei; cr = nr; ci = ni; }
#pragma unroll 6
            for (int j = 0; j < 66; ++j) {
                const float hr = rec[j * 128 + F.lane], hi = rec[j * 128 + 64 + F.lane];
                o[j * 128 + F.lane] = (h16)(cr * 64.f); o[j * 128 + 64 + F.lane] = (h16)(ci * 64.f);
                const float nr = lr * cr - li * ci + hr, ni = lr * ci + li * cr + hi; cr = nr; ci = ni;
            }
        }
        __syncthreads();
    }
}
__device__ __forceinline__ void ph_scanC(Frame& F, int layer) {
    if (layer == 0) {
        const h16* P = WSP(h16, WS_BIG); unsigned char* dob = (unsigned char*)F.out;
        if (GLLC) ph_glcorr<128>(F, (const float*)(dob + DO_STH), (const h16*)(F.ws + WS_BIG + B0_QE), 1024, WSP(h16, WS_H16), (h16*)(dob + DO_OBWD));
        else ph_glquads<128, true>(F, true, P, P0LD, (float*)(dob + DO_STH), nullptr, WSP(h16, WS_H16), (h16*)(dob + DO_OBWD));
        if (RWLC) ph_rwcorr(F, (const float*)(dob + DO_STR), (const h16*)(F.ws + WS_BIG + B0_QE), WSP(h16, WS_H16), (h16*)(dob + DO_OBWD));
        else if ((RWMODE & 2) && !(RWMODE & 4)) ph_rwchunks<false>(F, P, (float*)(dob + DO_STR), WSP(float, WS_BSP), WSP(h16, WS_H16), (h16*)(dob + DO_OBWD));
        else { constexpr int NRW = NSC * 64; for (int it = F.gw; it < NRW; it += F.ngw) { const int sc = it / 64, st = it % 64, d = st >> 5; rw_unit<false>(F, sc, d, (st >> 3) & 3, st & 7, P, (float*)(dob + DO_STR), WSP(float, WS_BSP), d == 0 ? WSP(h16, WS_H16) : (h16*)(dob + DO_OBWD)); }
            if (RWMODE & 4) { cg::this_grid().sync(); ph_rwchunks<false>(F, P, (float*)(dob + DO_STR), WSP(float, WS_BSP), WSP(h16, WS_H16), (h16*)(dob + DO_OBWD)); } }
#if DETCHK == 2
        ph_rwlatecheck(F, P, (float*)(dob + DO_STR));
#endif
    } else {
        const h16* P = WSP(h16, WS_BIG); unsigned char* big = F.ws + WS_BIG;
        ph_glquads<64, false>(F, true, P, P1LD, (float*)(big + B1_STG), nullptr, WSP(h16, WS_H16), (h16*)(big + B1_OBWD));
        if (S5WG) { for (int it = blockIdx.x; it < 64 * 4; it += F.G) { const int dg = it >> 2; s5_out_wg(F, dg, it & 3, P, (const h16*)(big + B1_ZB), (dg >> 5) == 0 ? WSP(h16, WS_H16) : (h16*)(big + B1_OBWD)); } __syncthreads(); }
        else for (int it = F.gw; it < 64 * 4 * 8; it += F.ngw) { const int dg = it >> 5; s5_out(F, dg, (it >> 3) & 3, it & 7, P, (const h16*)(big + B1_ZB), (dg >> 5) == 0 ? WSP(h16, WS_H16) : (h16*)(big + B1_OBWD)); }
    }
}

__device__ __forceinline__ void ph_fin0(Frame& F, bool dry = false) {
    LAS h16* SGh = (LAS h16*)F.lds;
    LAS unsigned char* GT = F.lds + 32 * 272;
    const h16* P = WSP(h16, WS_BIG); h16* OF = WSP(h16, WS_H16); const h16* OB = (const h16*)((unsigned char*)F.out + DO_OBWD); const float* BSC = WSP(float, WS_BSP);
    const float* mu = FIN(I_RWMU);
    const int lane = F.lane, c0 = lane * 8, li = lane & 15, lh = lane >> 4;
    h16x8 g2f[4][4];
    { const h16* G2T = WSP(h16, WS_G2T);
#pragma unroll
      for (int ct = 0; ct < 4; ++ct)
#pragma unroll
          for (int ks = 0; ks < 4; ++ks) g2f[ct][ks] = *(const h16x8*)(G2T + (size_t)(64 * F.wave + 16 * ct + li) * 128 + 32 * ks + 8 * lh); }
    const int per = (((MU + F.G - 1) / F.G) + 3) & ~3, ubase = blockIdx.x * per, uend = (ubase + per < MU) ? ubase + per : MU;
    for (int it = 0; it * 32 < per; ++it) {
        const int u0 = ubase + it * 32 + F.wave * 4;
        const bool act = u0 < uend;
        __syncthreads();
#pragma unroll
        for (int tk = 0; tk < 4; ++tk) {
            if (act) { const int u = u0 + tk, s = u % TT; const bool hp = (s != 0 && s != CTXL), hn = (s != CTXL - 1 && s != TT - 1);
                const h16* pc = P + (size_t)u * P0LD + 2560;
#pragma unroll
                for (int i = 0; i < 2; ++i) { const int col = 1792 + lane + 64 * i; const float x = (float)pc[col], xp = (hp ? 1.f : 0.f) * (float)pc[col - (hp ? P0LD : 0)], xn = (hn ? 1.f : 0.f) * (float)pc[col + (hn ? P0LD : 0)];
                    SGh[(F.wave * 4 + tk) * 136 + lane + 64 * i] = (h16)sigm(x + mu[col] * (xp - x) + mu[1920 + col] * (xn - x)); } }
            else { SGh[(F.wave * 4 + tk) * 136 + lane] = (h16)0.f; SGh[(F.wave * 4 + tk) * 136 + lane + 64] = (h16)0.f; }
        }
        __syncthreads();
#pragma unroll
        for (int rt = 0; rt < 2; ++rt) {
            h16x8 sb[4];
#pragma unroll
            for (int ks = 0; ks < 4; ++ks) sb[ks] = *(LAS const h16x8*)(SGh + (16 * rt + li) * 136 + 32 * ks + 8 * lh);
#pragma unroll
            for (int ct = 0; ct < 4; ++ct) { f32x4 acc = (f32x4){0.f, 0.f, 0.f, 0.f};
#pragma unroll
                for (int ks = 0; ks < 4; ++ks) acc = __builtin_amdgcn_mfma_f32_16x16x32_f16(g2f[ct][ks], sb[ks], acc, 0, 0, 0);
                *(LAS u32x2*)(GT + (16 * rt + li) * 1040 + (64 * F.wave + 16 * ct + 4 * lh) * 2) = (u32x2){pk_h16(acc[0], acc[1]), pk_h16(acc[2], acc[3])}; }
        }
        __syncthreads();
        if (!act) continue;
        h16x8 gate[4];
#pragma unroll
        for (int tk = 0; tk < 4; ++tk) gate[tk] = *(LAS const h16x8*)(GT + (F.wave * 4 + tk) * 1040 + 16 * lane);
#pragma unroll
        for (int tk = 0; tk < 4; ++tk) {
            const int u = u0 + tk, s = u % TT; const bool hp = (s != 0 && s != CTXL), hn = (s != CTXL - 1 && s != TT - 1);
            const h16* prow = P + (size_t)u * P0LD;
            { const h16x8 a = *(const h16x8*)(OF + (size_t)u * DM + c0), bb = *(const h16x8*)(OB + (size_t)u * DM + c0), gg = *(const h16x8*)(prow + 2048 + c0);
              float x[8], ss = 0.f;
#pragma unroll
              for (int e = 0; e < 8; ++e) { x[e] = (float)a[e] + (float)bb[e]; ss += x[e] * x[e]; }
              ss = row_sum16(ss);
              const float rinv = rsqrtf(ss * (1.f / 128.f) + 1e-6f); const float* hg = FIN(I_HGNG) + (c0 & 127);
              u32x4 w; float y[8];
#pragma unroll
              for (int e = 0; e < 8; ++e) y[e] = x[e] * rinv * hg[e] * silu((float)gg[e]);
              w.x = pk_h16(y[0], y[1]); w.y = pk_h16(y[2], y[3]); w.z = pk_h16(y[4], y[5]); w.w = pk_h16(y[6], y[7]);
              *(u32x4*)((dry ? (h16*)OB : OF) + (size_t)u * DM + c0) = w; }
            { const h16x8 a = *(const h16x8*)(OF + (size_t)u * DM + 512 + c0), bb = *(const h16x8*)(OB + (size_t)u * DM + 512 + c0);
              float x[8], sm = 0.f;
#pragma unroll
              for (int e = 0; e < 8; ++e) { x[e] = (float)a[e] + (float)bb[e]; sm += x[e]; }
              sm = sum8_dpp(sm);
              const float mean = sm * (1.f / 64.f); float vs = 0.f;
#pragma unroll
              for (int e = 0; e < 8; ++e) { x[e] -= mean; vs += x[e] * x[e]; }
              vs = sum8_dpp(vs);
              const float rinv = rsqrtf(vs * (1.f / 64.f) + 64e-5f);
              const int head = lane >> 3; const f32x4 bp0 = *(const f32x4*)(BSC + ((size_t)u * 8 + head) * 4), bp1 = *(const f32x4*)(BSC + (((size_t)MU + u) * 8 + head) * 4); const float bon = ((bp0.x + bp0.y) + (bp0.z + bp0.w)) + ((bp1.x + bp1.y) + (bp1.z + bp1.w));
              const h16* pc = prow + 2560 + 1024 + c0; const h16x8 vc = *(const h16x8*)pc; const h16x8 vp = *(const h16x8*)(pc - (hp ? P0LD : 0)), vn = *(const h16x8*)(pc + (hn ? P0LD : 0));
              const float fp_ = hp ? 1.f : 0.f, fn_ = hn ? 1.f : 0.f;
              float y[8];
#pragma unroll
              for (int e = 0; e < 8; ++e) { const float xv = (float)vc[e]; const float vsh = xv + mu[1024 + c0 + e] * (fp_ * (float)vp[e] - xv) + mu[1920 + 1024 + c0 + e] * (fn_ * (float)vn[e] - xv);
                  y[e] = (x[e] * rinv * FIN(I_RWLNG)[c0 + e] + FIN(I_RWLNB)[c0 + e] + bon * vsh) * (float)gate[tk][e]; }
              u32x4 w; w.x = pk_h16(y[0], y[1]); w.y = pk_h16(y[2], y[3]); w.z = pk_h16(y[4], y[5]); w.w = pk_h16(y[6], y[7]);
              *(u32x4*)((dry ? (h16*)OB : OF) + (size_t)u * DM + 512 + c0) = w; }
        }
    }
}
__device__ __forceinline__ void ph_fin1(Frame& F) {
    const h16* P = WSP(h16, WS_BIG); h16* OF = WSP(h16, WS_H16); const h16* OB = (const h16*)(F.ws + WS_BIG + B1_OBWD); h16* ZB = (h16*)(F.ws + WS_BIG + B1_ZB);
    const int lane = F.lane, c0 = lane * 8;
    for (int u = F.gw; u < MU; u += F.ngw) {
        const h16* prow = P + (size_t)u * P1LD;
        { const h16x8 a = *(const h16x8*)(OF + (size_t)u * DM + c0), bb = *(const h16x8*)(OB + (size_t)u * DM + c0), gg = *(const h16x8*)(prow + 1024 + c0);
          float x[8], ss = 0.f;
#pragma unroll
          for (int e = 0; e < 8; ++e) { x[e] = (float)a[e] + (float)bb[e]; ss += x[e] * x[e]; }
          ss = row_sum16(ss);
          const float rinv = rsqrtf(ss * (1.f / 128.f) + 1e-6f); const float* hg = FIN(I_GLANG) + (c0 & 127);
          float y[8];
#pragma unroll
          for (int e = 0; e < 8; ++e) y[e] = x[e] * rinv * hg[e] * silu((float)gg[e]);
          u32x4 w; w.x = pk_h16(y[0], y[1]); w.y = pk_h16(y[2], y[3]); w.z = pk_h16(y[4], y[5]); w.w = pk_h16(y[6], y[7]);
          *(u32x4*)(OF + (size_t)u * DM + c0) = w; }
        { const h16x8 a = *(const h16x8*)(OF + (size_t)u * DM + 512 + c0), bb = *(const h16x8*)(OB + (size_t)u * DM + 512 + c0), uu = *(const h16x8*)(prow + 1568 + c0);
          float z[8];
#pragma unroll
          for (int e = 0; e < 8; ++e) z[e] = gelu_tanh((float)a[e] + (float)bb[e] + FIN(I_S5D)[c0 + e] * (float)uu[e]);
          u32x4 w; w.x = pk_h16(z[0], z[1]); w.y = pk_h16(z[2], z[3]); w.z = pk_h16(z[4], z[5]); w.w = pk_h16(z[6], z[7]);
          *(u32x4*)(ZB + (size_t)u * 512 + c0) = w; }
    }
}


#define XB_TMO      128
#define XB_XCNT(j)  (256  + 64 * (j))
#define XB_XSUB(j)  (1280 + 64 * (j))
#define XB_XGEN(j)  (2304 + 64 * (j))
#define XB_TOP      3328
#define XB_TOPGEN   3392
#define XCD_BAR_WORDS 3456
#define XB_SPIN_CAP (1u << 22)
__device__ __forceinline__ unsigned xb_ld(unsigned* p)              { return __hip_atomic_load(p, __ATOMIC_RELAXED, __HIP_MEMORY_SCOPE_AGENT); }
__device__ __forceinline__ unsigned xb_add(unsigned* p, unsigned v) { return __hip_atomic_fetch_add(p, v, __ATOMIC_RELAXED, __HIP_MEMORY_SCOPE_AGENT); }
__device__ __forceinline__ unsigned xb_xcc_id() { return (unsigned)__builtin_amdgcn_s_getreg((3 << 11) | 20) & 0xFu; }
#define XB_SPIN(cond, bar) do { unsigned _sp = 0; while (cond) { __builtin_amdgcn_s_sleep(1); \
    if ((++_sp & 255u) == 0u) { if (xb_ld(&(bar)[XB_TMO])) break; if (_sp > XB_SPIN_CAP) { atomicAdd(&(bar)[XB_TMO], 1u); break; } } } } while (0)
struct XcdBarrier { unsigned* bar; unsigned x; volatile LAS unsigned* st; };
__device__ __forceinline__ XcdBarrier xcd_barrier_post(unsigned* bar, volatile LAS unsigned* st) {
    XcdBarrier b; b.bar = bar; b.x = xb_xcc_id(); b.st = st;
    if (threadIdx.x == 0) (void)xb_add(&bar[XB_XCNT(b.x)], 1u);
    return b;
}
__device__ __forceinline__ void xcd_barrier_complete(unsigned* bar, unsigned x, unsigned& nloc, unsigned& nx) {
    const unsigned G = gridDim.x * gridDim.y * gridDim.z;
    unsigned sum, cnt, mine, sp = 0u;
    for (;;) {
        sum = 0u; cnt = 0u; mine = 0u;
#pragma unroll
        for (unsigned j = 0; j < 16; ++j) { const unsigned c = xb_ld(&bar[XB_XCNT(j)]); sum += c; cnt += (c > 0u) ? 1u : 0u; mine = (j == x) ? c : mine; }
        if (sum == G) break;
        __builtin_amdgcn_s_sleep(1);
        if ((++sp & 255u) == 0u) { if (xb_ld(&bar[XB_TMO])) break; if (sp > XB_SPIN_CAP) { atomicAdd(&bar[XB_TMO], 1u); break; } }
    }
    nloc = mine > 0u ? mine : 1u; nx = cnt > 0u ? cnt : 1u;
}
__device__ __forceinline__ void xcd_barrier(const XcdBarrier& b) {
    asm volatile("s_waitcnt vmcnt(0)" ::: "memory");
    __syncthreads();
    if (threadIdx.x == 0) {
        unsigned* bar = b.bar;
        __builtin_amdgcn_s_waitcnt(0);
        unsigned nloc = b.st[0], nx = b.st[1];
        if (nloc == 0u) { xcd_barrier_complete(bar, b.x, nloc, nx); b.st[0] = nloc; b.st[1] = nx; }
        const unsigned old = xb_add(&bar[XB_XSUB(b.x)], 1u);
        const unsigned gen = old / nloc;
        if (old + 1u == (gen + 1u) * nloc) {
            __builtin_amdgcn_fence(__ATOMIC_RELEASE, "agent");
            asm volatile("s_waitcnt vmcnt(0)" ::: "memory");
            const unsigned og = xb_add(&bar[XB_TOP], 1u);
            const unsigned tg = og / nx;
            if (og + 1u == (tg + 1u) * nx) xb_add(&bar[XB_TOPGEN], 1u);
            else XB_SPIN(xb_ld(&bar[XB_TOPGEN]) == tg, bar);
            __builtin_amdgcn_fence(__ATOMIC_ACQUIRE, "agent");
            xb_add(&bar[XB_XGEN(b.x)], 1u);
            asm volatile("s_waitcnt vmcnt(0)" ::: "memory");
        } else {
            XB_SPIN(xb_ld(&bar[XB_XGEN(b.x)]) == gen, bar);
            __builtin_amdgcn_fence(__ATOMIC_ACQUIRE, "agent");
            asm volatile("s_waitcnt vmcnt(0)" ::: "memory");
        }
    }
    __syncthreads();
}

#ifndef CTXG
#define CTXG 1
#endif
constexpr int N_PHASES = 26;
#define PH_IN(k) (args.ph_lo <= (k) && (k) < args.ph_hi)
#define PH_SYNC(k) do { if ((k) + 1 < args.ph_hi) { if ((k) == 0 || USE_CG_SYNC) grid.sync(); else xcd_barrier(xbar); } } while (0)
#define RUNPH(k, ...) do { if (PH_IN(PB + (k))) { if (((REPM >> (k)) & 1u) && ((REPL >> L) & 1u)) { if (PHM & (1u << (k))) { __VA_ARGS__ } } if (PHM & (1u << (k))) { __VA_ARGS__ } PH_SYNC(PB + (k)); } } while (0)
template <int MODE, int CW>
__device__ __forceinline__ void ctx_gemm(Frame& F, const h16* A, int lda, const h16* Bt, int ldb, int K, int N, h16* O, int ldc, float* ctx, const float* mod, int goff) {
    const int tid = F.tid, lane = F.lane, i = lane & 15, h = lane >> 4, wr = F.wave >> 2, wc = F.wave & 3;
    constexpr int NJ = (64 + CW) / 64, NN = CW / 64;
    const int nct = N / CW, nunits = 16 * nct, nk = K / 64;
    constexpr int RS = 144, TILE = (64 + CW) * RS;
    LAS unsigned char* L0 = F.lds;
    for (int unit = blockIdx.x; unit < nunits; unit += F.G) {
        const int rt = unit / nct, ct = unit % nct, b = rt >> 2, r0 = (rt & 3) * 64;
        const size_t u0 = (size_t)b * TT + r0;
        const int col0 = ct * CW;
        const h16* gp[NJ]; int lo[NJ];
#pragma unroll
        for (int j = 0; j < NJ; ++j) { const int q = tid + 512 * j, row = q >> 3, c16 = q & 7;
            gp[j] = (row < 64 ? A + (u0 + row) * lda : Bt + (size_t)(col0 + row - 64) * ldb) + 8 * c16; lo[j] = row * RS + 16 * c16; }
        f32x4 acc[2][NN];
#pragma unroll
        for (int m = 0; m < 2; ++m)
#pragma unroll
            for (int n = 0; n < NN; ++n) acc[m][n] = (f32x4){0.f, 0.f, 0.f, 0.f};
        constexpr int PD = 4;
        u32x4 st[PD][NJ];
#pragma unroll
        for (int d = 0; d < PD; ++d)
#pragma unroll
            for (int j = 0; j < NJ; ++j) st[d][j] = *(const u32x4*)(gp[j] + 64 * d);
        __syncthreads();
#pragma unroll
        for (int j = 0; j < NJ; ++j) *(LAS u32x4*)(L0 + lo[j]) = st[0][j];
        __syncthreads();
        const int aoff = (wr * 32 + i) * RS + 16 * h, boff = (64 + wc * (CW / 4) + i) * RS + 16 * h;
#pragma unroll 1
        for (int kt0 = 0; kt0 < nk; kt0 += PD) {
#pragma unroll
            for (int d = 0; d < PD; ++d) {
                const int kt = kt0 + d;
                if (kt + PD < nk) {
#pragma unroll
                    for (int j = 0; j < NJ; ++j) st[d][j] = *(const u32x4*)(gp[j] + 64 * (kt + PD)); }
                LAS const unsigned char* T = L0 + (d & 1) * TILE;
#pragma unroll
                for (int ks = 0; ks < 2; ++ks) {
                    const h16x8 a0 = *(LAS const h16x8*)(T + aoff + 64 * ks), a1 = *(LAS const h16x8*)(T + aoff + 16 * RS + 64 * ks);
#pragma unroll
                    for (int n = 0; n < NN; ++n) { const h16x8 bn = *(LAS const h16x8*)(T + boff + n * 16 * RS + 64 * ks);
                        acc[0][n] = __builtin_amdgcn_mfma_f32_16x16x32_f16(bn, a0, acc[0][n], 0, 0, 0); acc[1][n] = __builtin_amdgcn_mfma_f32_16x16x32_f16(bn, a1, acc[1][n], 0, 0, 0); }
                }
                if (kt + 1 < nk) {
#pragma unroll
                    for (int j = 0; j < NJ; ++j) *(LAS u32x4*)(L0 + ((d + 1) & 1) * TILE + lo[j]) = st[(d + 1) % PD][j]; }
                LDS_BARRIER();
            }
        }
#pragma unroll
        for (int m = 0; m < 2; ++m)
#pragma unroll
            for (int n = 0; n < NN; ++n) { const int col = col0 + wc * (CW / 4) + 16 * n + 4 * h, row = wr * 32 + 16 * m + i; const f32x4 v = acc[m][n];
                if (MODE == 0) { *(u32x2*)(O + (u0 + row) * ldc + col) = (u32x2){pk_h16(v[0], v[1]), pk_h16(v[2], v[3])}; }
                else { float* dst = ctx + ((size_t)b * CTXL + r0 + row) * DM + col; const f32x4 g = *(const f32x4*)(mod + 4 * 6144 + goff + col);
                    *(f32x4*)dst = *(const f32x4*)dst + g * v; } }
    }
    __syncthreads();
}

template <int L>
__device__ __forceinline__ void layer_program(Frame& F, const Args& args, cg::grid_group& grid, const XcdBarrier& xbar) {
    constexpr int PB = 1 + 12 * L;
    float* MOD = WSP(float, WS_MOD) + L * 5 * 6144; float* CTX = WSP(float, WS_CTX);
#define XIN_ (L == 0 ? FIN(I_X) : F.out)
    RUNPH(0, ph_norm(F, XIN_, L == 0 ? FIN(I_CTX) : CTX, FIN(I_N1G) + L * DM, MOD, 0, 1024, WSP(h16, WS_H16), L == 0 ? CTX : nullptr););
    RUNPH(1, pg8::Gemm g{WSP(h16, WS_H16), L == 0 ? WSP(h16, WS_WEVIN) : WSP(h16, WS_WODIN), MU, L == 0 ? P0LD : P1LD, DM, DM, DM};
        pg8::StaticOrder S; S.init(g.M, g.N, F.G, blockIdx.x, L == 0 ? CTXG : 0); pg8::EpiH16 E{WSP(h16, WS_BIG), L == 0 ? P0LD : P1LD};
        pg8::gemm_phase<pg8::EpiH16>(F.lds, g, S, E);
        if (L == 0 && CTXG) ctx_gemm<0, 128>(F, g.A, g.lda, g.Bt, g.ldb, g.K, g.N, WSP(h16, WS_BIG), P0LD, nullptr, nullptr, 0););
    RUNPH(2, ph_scanA(F, L););
    RUNPH(3, ph_scanB(F, L););
    RUNPH(4, ph_scanC(F, L););
    RUNPH(5, if (L == 0) ph_fin0(F); else ph_fin1(F););
    if (L == 0 && (REPM & 0x10000u) && PH_IN(PB + 5)) { xcd_barrier(xbar); ph_fin0(F, true); xcd_barrier(xbar); }
    if (L == 1) RUNPH(6, pg8::Gemm g{(const h16*)(F.ws + WS_BIG + B1_ZB), WSP(h16, WS_WGLU), MU, 512, 512, 512, 512};
        pg8::StaticOrder S; S.init(g.M, g.N, F.G, blockIdx.x, 1); pg8::EpiGlu E{(const h16*)(F.ws + WS_BIG + B1_ZB), WSP(h16, WS_H16), FIN(I_S5BGLU)};
        pg8::gemm_phase<pg8::EpiGlu>(F.lds, g, S, E););
    RUNPH(7, pg8::Gemm g{WSP(h16, WS_H16), L == 0 ? WSP(h16, WS_WEVOUT) : WSP(h16, WS_WODOUT), MU, DM, DM, DM, DM};
        pg8::StaticOrder S; S.init(g.M, g.N, F.G, blockIdx.x, (L == 1 || CTXG) ? 1 : 0); pg8::EpiResid E{XIN_, F.out, CTX, MOD, 2048, L == 0 ? 1 : 0};
        pg8::gemm_phase<pg8::EpiResid>(F.lds, g, S, E);
        if (L == 0 && CTXG) ctx_gemm<1, 128>(F, g.A, g.lda, g.Bt, g.ldb, g.K, g.N, nullptr, 0, CTX, MOD, 2048););
    RUNPH(8, ph_norm(F, F.out, CTX, FIN(I_N2G) + L * DM, MOD, 3072, 4096, WSP(h16, WS_H16), nullptr););
    RUNPH(9, pg8::Gemm g{WSP(h16, WS_H16), WSP(h16, WS_WUP + (size_t)L * 11 * MiB), MU, GVLD, DM, DM, DM};
        pg8::StaticOrder S; S.init(g.M, g.N, F.G, blockIdx.x, (L == 1 || CTXG) ? 1 : 0); pg8::EpiH16 E{WSP(h16, WS_BIG), GVLD};
        pg8::gemm_phase<pg8::EpiH16>(F.lds, g, S, E);
        if (L == 0 && CTXG) ctx_gemm<0, 128>(F, g.A, g.lda, g.Bt, g.ldb, g.K, g.N, WSP(h16, WS_BIG), GVLD, nullptr, nullptr, 0););
    RUNPH(10, ph_conv(F, L););
    if ((REPM & 0x20000u) && ((REPL >> L) & 1u) && PH_IN(PB + 10)) { ph_conv(F, L, true); xcd_barrier(xbar); }
    RUNPH(11, pg8::Gemm g{WSP(h16, WS_BIG) + DFF, WSP(h16, WS_WDN + (size_t)L * 6 * MiB), MU, DM, DFF, GVLD, DFF};
        pg8::StaticOrder S; S.init(g.M, g.N, F.G, blockIdx.x, (L == 1 || CTXG) ? 1 : 0); pg8::EpiResid E{F.out, F.out, CTX, MOD, 5120, L == 0 ? 1 : 0};
        pg8::gemm_phase<pg8::EpiResid>(F.lds, g, S, E);
        if (L == 0 && CTXG) ctx_gemm<1, 128>(F, g.A, g.lda, g.Bt, g.ldb, g.K, g.N, nullptr, 0, CTX, MOD, 5120););
}
__global__ void __launch_bounds__(NTHR, 2) __attribute__((amdgpu_flat_work_group_size(512, 512))) mega_fwd(Args args) {
    extern __shared__ __attribute__((aligned(16))) unsigned char lds_raw[];
    cg::grid_group grid = cg::this_grid();
    Frame F;
    F.lds = (LAS unsigned char*)lds_raw; F.out = args.out; F.ws = args.ws;
    { const float** tab = (const float**)(args.ws + WS_TAB);
      if (threadIdx.x == 0) {
#pragma unroll
          for (int i = 0; i < N_IN; ++i) __hip_atomic_store(tab + i, args.in[i], __ATOMIC_RELAXED, __HIP_MEMORY_SCOPE_AGENT);
          __threadfence();
      }
      __syncthreads();
      F.in = tab; }
    F.tid = threadIdx.x; F.lane = F.tid & 63; F.wave = __builtin_amdgcn_readfirstlane(F.tid >> 6);
    F.G = gridDim.x; F.gw = blockIdx.x * NWAVES + F.wave; F.ngw = F.G * NWAVES;
    { volatile LAS unsigned* st_ = (volatile LAS unsigned*)(F.lds + 131072 + 320); if (F.tid < 4) st_[F.tid] = 0u; }
    __syncthreads();
    if (blockIdx.x == 0) { unsigned* bw = (unsigned*)(args.ws + WS_XBAR); for (int i = F.tid; i < XCD_BAR_WORDS; i += NTHR) bw[i] = 0u; }
    if (PH_IN(0)) { if (REPM & 0x40000u) ph_prologue(F); if (PHM & 0x1000u) ph_prologue(F); if (1 < args.ph_hi) grid.sync(); for (int xs_ = 0; xs_ < XSYNC; ++xs_) grid.sync(); }
    const XcdBarrier xbar = xcd_barrier_post((unsigned*)(args.ws + WS_XBAR), (volatile LAS unsigned*)(F.lds + 131072 + 320));
    layer_program<0>(F, args, grid, xbar);
    layer_program<1>(F, args, grid, xbar);
    if (PH_IN(25)) { if (PHM & 0x2000u) ph_final(F); }
}

extern "C" void kernel_launch(void* const* d_in, const int* in_sizes, int n_in, void* d_out, int out_size, void* d_ws, size_t ws_size, hipStream_t stream) {
    static int grid_blocks = 0;
    if (grid_blocks == 0) {
        if (n_in != N_IN || out_size != NB * SEQ * DM || ws_size < WS_END) { fprintf(stderr, "kernel_launch: unexpected shapes (n_in %d, out %d, ws %zu)\n", n_in, out_size, ws_size); grid_blocks = -1; return; }
        int dev = 0, cus = 0, per_cu = 0;
        hipGetDevice(&dev); hipDeviceGetAttribute(&cus, hipDeviceAttributeMultiprocessorCount, dev);
        hipFuncSetAttribute((const void*)mega_fwd, hipFuncAttributeMaxDynamicSharedMemorySize, LDS_BYTES);
        hipOccupancyMaxActiveBlocksPerMultiprocessor(&per_cu, (const void*)mega_fwd, NTHR, LDS_BYTES);
        if (per_cu < 1) { fprintf(stderr, "kernel_launch: occupancy query says %d blocks per CU\n", per_cu); grid_blocks = -1; return; }
        grid_blocks = cus;
    }
    if (grid_blocks < 0) return;
    Args a{};
    for (int i = 0; i < N_IN; ++i) a.in[i] = (const float*)d_in[i];
    a.out = (float*)d_out; a.ws = (unsigned char*)d_ws;
#if MK_PER_PHASE
    for (int ph = 0; ph < N_PHASES; ++ph) {
        if (ph == 7) continue;
        a.ph_lo = ph; a.ph_hi = ph + 1; void* kargs[] = {&a};
        hipError_t e = hipLaunchCooperativeKernel((const void*)mega_fwd, dim3(grid_blocks), dim3(NTHR), kargs, LDS_BYTES, stream);
        if (e != hipSuccess) { fprintf(stderr, "launch of phase %d failed: %s\n", ph, hipGetErrorString(e)); break; }
    }
#else
    a.ph_lo = 0; a.ph_hi = N_PHASES; void* kargs[] = {&a};
    hipError_t e = hipLaunchCooperativeKernel((const void*)mega_fwd, dim3(grid_blocks), dim3(NTHR), kargs, LDS_BYTES, stream);
    if (e != hipSuccess) fprintf(stderr, "cooperative launch failed: %s (grid %d)\n", hipGetErrorString(e), grid_blocks);
#endif
}
```
